# Optimizing an MI355X kernel written in HIP

```python
import math
import jax
import jax.numpy as jnp
from jax import lax
import numpy as np

D_MODEL = 1024
BATCH = 16
SEQ = 2048
DEPTH = 4

GRID_W = 64
CTX_LEN = 256

S5_WIDTH = D_MODEL // 2
S5_GROUP = 16
S5_GROUPS = S5_WIDTH // S5_GROUP
S5_STATE = 64
S5_DT_MIN = 0.001
S5_DT_MAX = 0.1

LRU_WIDTH = D_MODEL
LRU_BLOCKS = 16
LRU_BLOCK = LRU_WIDTH // LRU_BLOCKS
LRU_C = 8.0
CONV_W = 4

IN_WIDTH = S5_WIDTH + 2 * LRU_WIDTH + 2 * D_MODEL
N_STATE_COLS = S5_WIDTH + LRU_WIDTH

N_EXPERTS = 32
TOP_K = 4
D_EXPERT = D_MODEL
SWIGLU_LIMIT = 7.0
SWIGLU_ALPHA = 1.702

EPS = 1e-6

kernel_name = 'hybrid_s5_rglru_moe_diffusion_block'


def rmsnorm(x, g):
    xf = x.astype(jnp.float32)
    y = xf * lax.rsqrt(jnp.mean(xf * xf, axis=-1, keepdims=True) + EPS)
    return (y * g.astype(jnp.float32)).astype(x.dtype)


def modulate(h, shift, scale):
    return h * (1.0 + scale) + shift


def maybe_flip(a, rev):
    return jnp.flip(a, axis=1) if rev else a


def to_colmajor(x, rows):
    b, s, ch = x.shape
    return x.reshape(b, rows, GRID_W, ch).transpose(0, 2, 1, 3).reshape(b, s, ch)


def from_colmajor(x, rows):
    b, s, ch = x.shape
    return x.reshape(b, GRID_W, rows, ch).transpose(0, 2, 1, 3).reshape(b, s, ch)


def dwconv(x, w, bias):
    ch = x.shape[-1]
    y = lax.conv_general_dilated(x.astype(w.dtype), w[:, None, :], window_strides=(1,),
                                 padding=[(1, 2)], dimension_numbers=('NWC', 'WIO', 'NWC'),
                                 feature_group_count=ch)
    return y + bias


def real_scan(a, b, h0):
    b = b.at[:, 0].add(a[:, 0] * h0)
    def combine(e1, e2):
        return (e1[0] * e2[0], e2[0] * e1[1] + e2[1])
    return lax.associative_scan(combine, (a, b), axis=1)[1]


def complex_combine(e1, e2):
    a1r, a1i, b1r, b1i = e1
    a2r, a2i, b2r, b2i = e2
    return (a2r * a1r - a2i * a1i, a2r * a1i + a2i * a1r,
            a2r * b1r - a2i * b1i + b2r, a2r * b1i + a2i * b1r + b2i)


def s5_discretize(lam_re, lam_im, log_dt, b_re, b_im):
    f32 = jnp.float32
    lr, li = lam_re.astype(f32), lam_im.astype(f32)
    dt = jnp.exp(log_dt.astype(f32))[:, None]
    mag = jnp.exp(lr * dt)
    ab_re, ab_im = mag * jnp.cos(li * dt), mag * jnp.sin(li * dt)
    den = lr * lr + li * li
    zr = ab_re - 1.0
    q_re = (zr * lr + ab_im * li) / den
    q_im = (ab_im * lr - zr * li) / den
    br, bi = b_re.astype(f32), b_im.astype(f32)
    bb_re = q_re[..., None] * br - q_im[..., None] * bi
    bb_im = q_re[..., None] * bi + q_im[..., None] * br
    return ab_re, ab_im, bb_re, bb_im


def s5_scan(u, ab_re, ab_im, bb_re, bb_im, h0_re, h0_im):
    t = u.shape[1]
    br = jnp.einsum('btgh,gph->btgp', u, bb_re)
    bi = jnp.einsum('btgh,gph->btgp', u, bb_im)
    br = br.at[:, 0].add(ab_re * h0_re - ab_im * h0_im)
    bi = bi.at[:, 0].add(ab_re * h0_im + ab_im * h0_re)
    a_re = jnp.broadcast_to(ab_re, (1, t) + ab_re.shape)
    a_im = jnp.broadcast_to(ab_im, (1, t) + ab_im.shape)
    _, _, hr, hi = lax.associative_scan(complex_combine, (a_re, a_im, br, bi), axis=1)
    return hr, hi


def s5_readout(hr, hi, c_re, c_im):
    f32 = jnp.float32
    return (jnp.einsum('btgp,ghp->btgh', hr, c_re.astype(f32))
            - jnp.einsum('btgp,ghp->btgh', hi, c_im.astype(f32)))


def s5_post(y, u, d, w_glu, b_glu):
    y = y.reshape(u.shape[0], u.shape[1], S5_WIDTH) + d * u.reshape(u.shape[0], u.shape[1], S5_WIDTH)
    gy = jax.nn.gelu(y)
    return gy * jax.nn.sigmoid(gy @ w_glu + b_glu)


def s5_branch(u_c, u_l, need_ctx, lam_re, lam_im, log_dt, b_re, b_im, c_re, c_im, d, w_glu, b_glu):
    f32 = jnp.float32
    bsz = u_l.shape[0]
    uc = u_c.astype(f32).reshape(bsz, u_c.shape[1], S5_GROUPS, S5_GROUP)
    ul = u_l.astype(f32).reshape(bsz, u_l.shape[1], S5_GROUPS, S5_GROUP)
    h0 = jnp.zeros((bsz, S5_GROUPS, S5_STATE), f32)
    ys_l, ys_c = [], []
    for dr, rev in ((0, False), (1, True)):
        ab_re, ab_im, bb_re, bb_im = s5_discretize(lam_re[dr], lam_im[dr], log_dt[dr], b_re[dr], b_im[dr])
        hc_re, hc_im = s5_scan(maybe_flip(uc, rev), ab_re, ab_im, bb_re, bb_im, h0, h0)
        hl_re, hl_im = s5_scan(maybe_flip(ul, rev), ab_re, ab_im, bb_re, bb_im, hc_re[:, -1], hc_im[:, -1])
        ys_l.append(maybe_flip(s5_readout(hl_re, hl_im, c_re[dr], c_im[dr]), rev))
        if need_ctx:
            ys_c.append(maybe_flip(s5_readout(hc_re, hc_im, c_re[dr], c_im[dr]), rev))
    out_l = s5_post(ys_l[0] + ys_l[1], ul, d, w_glu, b_glu)
    out_c = s5_post(ys_c[0] + ys_c[1], uc, d, w_glu, b_glu) if need_ctx else None
    return out_c, out_l


def rglru_coeffs(x, lam, w_a, b_a, w_x, b_x):
    f32 = jnp.float32
    bsz, t, w = x.shape
    xb = x.reshape(bsz, t, LRU_BLOCKS, LRU_BLOCK)
    r = jax.nn.sigmoid(jnp.einsum('btnh,nhk->btnk', xb, w_a.astype(f32)).reshape(bsz, t, w) + b_a)
    i = jax.nn.sigmoid(jnp.einsum('btnh,nhk->btnk', xb, w_x.astype(f32)).reshape(bsz, t, w) + b_x)
    log_a = -LRU_C * r * jax.nn.softplus(-lam.astype(f32))
    a = jnp.exp(log_a)
    b = jnp.sqrt(-jnp.expm1(2.0 * log_a)) * (i * x)
    return a, b


def rglru_branch(x_c, x_l, g_c, g_l, rows, need_ctx, conv_w, conv_b, lam, w_a, b_a, w_x, b_x):
    f32 = jnp.float32
    xl = dwconv(to_colmajor(x_l, rows), conv_w, conv_b).astype(f32)
    xc = dwconv(x_c, conv_w, conv_b).astype(f32)
    h0 = jnp.zeros((xl.shape[0], LRU_WIDTH), f32)
    ys_l, ys_c = [], []
    for dr, rev in ((0, False), (1, True)):
        a_c, b_c = rglru_coeffs(maybe_flip(xc, rev), lam[dr], w_a[dr], b_a[dr], w_x[dr], b_x[dr])
        h_c = real_scan(a_c, b_c, h0)
        a_l, b_l = rglru_coeffs(maybe_flip(xl, rev), lam[dr], w_a[dr], b_a[dr], w_x[dr], b_x[dr])
        h_l = real_scan(a_l, b_l, h_c[:, -1])
        ys_l.append(maybe_flip(h_l, rev))
        if need_ctx:
            ys_c.append(maybe_flip(h_c, rev))
    out_l = jax.nn.gelu(g_l) * from_colmajor(ys_l[0] + ys_l[1], rows)
    out_c = jax.nn.gelu(g_c) * (ys_c[0] + ys_c[1]) if need_ctx else None
    return out_c, out_l


def mixer(h_c, h_l, rows, need_ctx, w_in, s5_params, lru_params, w_proj_s5, w_proj_lru, w_out):
    splits = [S5_WIDTH, S5_WIDTH + LRU_WIDTH, S5_WIDTH + 2 * LRU_WIDTH, S5_WIDTH + 2 * LRU_WIDTH + D_MODEL]
    u_l, xr_l, g_l, m5_l, ml_l = jnp.split(h_l @ w_in, splits, axis=-1)
    u_c, xr_c = jnp.split(h_c @ w_in[:, :N_STATE_COLS], [S5_WIDTH], axis=-1)
    if need_ctx:
        g_c, m5_c, ml_c = jnp.split(h_c @ w_in[:, N_STATE_COLS:], [LRU_WIDTH, LRU_WIDTH + D_MODEL], axis=-1)
    else:
        g_c = None
    o5_c, o5_l = s5_branch(u_c, u_l, need_ctx, *s5_params)
    ol_c, ol_l = rglru_branch(xr_c, xr_l, g_c, g_l, rows, need_ctx, *lru_params)

    def merge(o5, ol, m5, ml):
        merged = jax.nn.sigmoid(m5) * (o5 @ w_proj_s5) + jax.nn.sigmoid(ml) * (ol @ w_proj_lru)
        return merged @ w_out

    out_l = merge(o5_l, ol_l, m5_l, ml_l)
    out_c = merge(o5_c, ol_c, m5_c, ml_c) if need_ctx else None
    return out_c, out_l


def moe(h, w_router, b_router, w_up, b_up, w_down, b_down):
    f32 = jnp.float32
    logits = (h @ w_router + b_router).astype(f32)
    top_v, top_i = lax.top_k(logits, TOP_K)
    top_w = jax.nn.softmax(top_v, axis=-1)
    combine = jnp.sum(jax.nn.one_hot(top_i, N_EXPERTS, dtype=f32) * top_w[..., None], axis=1)

    def expert(acc, e):
        w1, b1, w2, b2, ce = e
        gu = h @ w1 + b1
        gate = jnp.minimum(gu[..., ::2], SWIGLU_LIMIT)
        up = jnp.clip(gu[..., 1::2], -SWIGLU_LIMIT, SWIGLU_LIMIT)
        act = gate * jax.nn.sigmoid(SWIGLU_ALPHA * gate) * (up + 1.0)
        out = act @ w2 + b2
        return acc + ce[:, None] * out.astype(f32), None

    acc0 = jnp.zeros((h.shape[0], D_MODEL), f32)
    acc, _ = lax.scan(expert, acc0, (w_up, b_up, w_down, b_down, combine.T))
    return acc


def setup_inputs(seed: int = 0) -> dict:
    key = jax.random.key(seed)
    keys = iter(jax.random.split(key, 48))
    f32 = jnp.float32

    def rnd(shape, scale):
        return scale * jax.random.normal(next(keys), shape, f32)

    L, D = DEPTH, D_MODEL
    G, P, H = S5_GROUPS, S5_STATE, S5_GROUP
    x = rnd((BATCH, SEQ, D), 1.0)
    c = rnd((BATCH, D), 1.0)
    ctx = rnd((BATCH, CTX_LEN, D), 1.0)
    c_ctx = rnd((D,), 1.0)
    w_ada = rnd((L, D, 6 * D), 0.5 * D ** -0.5)
    b_ada = rnd((L, 6 * D), 0.02)
    g_mix = 1.0 + rnd((L, D), 0.05)
    g_ffn = 1.0 + rnd((L, D), 0.05)
    w_in = rnd((L, D, IN_WIDTH), D ** -0.5)
    n_idx = jnp.arange(P, dtype=f32)
    s5_lam_re = -0.5 + rnd((L, 2, G, P), 0.01)
    s5_lam_im = math.pi * n_idx + rnd((L, 2, G, P), 0.01)
    u_dt = jax.random.uniform(next(keys), (L, 2, G), f32)
    s5_log_dt = math.log(S5_DT_MIN) + u_dt * (math.log(S5_DT_MAX) - math.log(S5_DT_MIN))
    s5_b_re = rnd((L, 2, G, P, H), (2 * H) ** -0.5)
    s5_b_im = rnd((L, 2, G, P, H), (2 * H) ** -0.5)
    s5_c_re = rnd((L, 2, G, H, P), P ** -0.5)
    s5_c_im = rnd((L, 2, G, H, P), P ** -0.5)
    s5_d = rnd((L, S5_WIDTH), 1.0)
    s5_w_glu = rnd((L, S5_WIDTH, S5_WIDTH), S5_WIDTH ** -0.5)
    s5_b_glu = rnd((L, S5_WIDTH), 0.02)
    lru_conv_w = rnd((L, CONV_W, LRU_WIDTH), CONV_W ** -0.5)
    lru_conv_b = rnd((L, LRU_WIDTH), 0.02)
    a0 = jax.random.uniform(next(keys), (L, 2, LRU_WIDTH), f32, minval=0.9, maxval=0.999)
    p = a0 ** (1.0 / LRU_C)
    lru_lam = jnp.log(p) - jnp.log1p(-p)
    lru_w_a = rnd((L, 2, LRU_BLOCKS, LRU_BLOCK, LRU_BLOCK), LRU_BLOCK ** -0.5)
    lru_b_a = rnd((L, 2, LRU_WIDTH), 0.02)
    lru_w_x = rnd((L, 2, LRU_BLOCKS, LRU_BLOCK, LRU_BLOCK), LRU_BLOCK ** -0.5)
    lru_b_x = rnd((L, 2, LRU_WIDTH), 0.02)
    w_proj_s5 = rnd((L, S5_WIDTH, D), S5_WIDTH ** -0.5)
    w_proj_lru = rnd((L, LRU_WIDTH, D), LRU_WIDTH ** -0.5)
    w_out = rnd((L, D, D), D ** -0.5)
    w_router = rnd((L, D, N_EXPERTS), D ** -0.5)
    b_router = rnd((L, N_EXPERTS), 0.01)
    w_up = rnd((L, N_EXPERTS, D, 2 * D_EXPERT), D ** -0.5)
    b_up = rnd((L, N_EXPERTS, 2 * D_EXPERT), 0.02)
    w_down = rnd((L, N_EXPERTS, D_EXPERT, D), D_EXPERT ** -0.5)
    b_down = rnd((L, N_EXPERTS, D), 0.02)
    g_final = 1.0 + rnd((D,), 0.05)
    return {'x': x, 'c': c, 'ctx': ctx, 'c_ctx': c_ctx, 'w_ada': w_ada, 'b_ada': b_ada,
            'g_mix': g_mix, 'g_ffn': g_ffn, 'w_in': w_in,
            's5_lam_re': s5_lam_re, 's5_lam_im': s5_lam_im, 's5_log_dt': s5_log_dt,
            's5_b_re': s5_b_re, 's5_b_im': s5_b_im, 's5_c_re': s5_c_re, 's5_c_im': s5_c_im,
            's5_d': s5_d, 's5_w_glu': s5_w_glu, 's5_b_glu': s5_b_glu,
            'lru_conv_w': lru_conv_w, 'lru_conv_b': lru_conv_b, 'lru_lam': lru_lam,
            'lru_w_a': lru_w_a, 'lru_b_a': lru_b_a, 'lru_w_x': lru_w_x, 'lru_b_x': lru_b_x,
            'w_proj_s5': w_proj_s5, 'w_proj_lru': w_proj_lru, 'w_out': w_out,
            'w_router': w_router, 'b_router': b_router, 'w_up': w_up, 'b_up': b_up,
            'w_down': w_down, 'b_down': b_down, 'g_final': g_final}


def reference(x, c, ctx, c_ctx, w_ada, b_ada, g_mix, g_ffn, w_in,
              s5_lam_re, s5_lam_im, s5_log_dt, s5_b_re, s5_b_im, s5_c_re, s5_c_im,
              s5_d, s5_w_glu, s5_b_glu, lru_conv_w, lru_conv_b, lru_lam,
              lru_w_a, lru_b_a, lru_w_x, lru_b_x, w_proj_s5, w_proj_lru, w_out,
              w_router, b_router, w_up, b_up, w_down, b_down, g_final):
    out_dtype = x.dtype
    seq = x.shape[1]
    rows = seq // GRID_W
    cond_l = jax.nn.silu(c)
    cond_c = jax.nn.silu(c_ctx)
    h_ctx = ctx
    for l in range(DEPTH):
        need_ctx = l < DEPTH - 1
        ada_l = cond_l @ w_ada[l] + b_ada[l]
        sh1, sc1, g1, sh2, sc2, g2 = jnp.split(ada_l[:, None, :], 6, axis=-1)
        n_c = 6 if need_ctx else 2
        ada_c = cond_c @ w_ada[l][:, :n_c * D_MODEL] + b_ada[l][:n_c * D_MODEL]
        mods_c = jnp.split(ada_c, n_c)

        hn_l = modulate(rmsnorm(x, g_mix[l]), sh1, sc1)
        hn_c = modulate(rmsnorm(h_ctx, g_mix[l]), mods_c[0], mods_c[1])
        s5_params = (s5_lam_re[l], s5_lam_im[l], s5_log_dt[l], s5_b_re[l], s5_b_im[l],
                     s5_c_re[l], s5_c_im[l], s5_d[l], s5_w_glu[l], s5_b_glu[l])
        lru_params = (lru_conv_w[l], lru_conv_b[l], lru_lam[l], lru_w_a[l], lru_b_a[l],
                      lru_w_x[l], lru_b_x[l])
        mix_c, mix_l = mixer(hn_c, hn_l, rows, need_ctx, w_in[l], s5_params, lru_params,
                             w_proj_s5[l], w_proj_lru[l], w_out[l])
        x = x + g1 * mix_l

        moe_params = (w_router[l], b_router[l], w_up[l], b_up[l], w_down[l], b_down[l])
        hn_l = modulate(rmsnorm(x, g_ffn[l]), sh2, sc2)
        if need_ctx:
            h_ctx = h_ctx + mods_c[2] * mix_c
            hn_c = modulate(rmsnorm(h_ctx, g_ffn[l]), mods_c[3], mods_c[4])
            n_ctx_tok = hn_c.shape[0] * hn_c.shape[1]
            tok = jnp.concatenate([hn_c.reshape(-1, D_MODEL), hn_l.reshape(-1, D_MODEL)], axis=0)
            f = moe(tok, *moe_params)
            h_ctx = h_ctx + mods_c[5] * f[:n_ctx_tok].reshape(h_ctx.shape)
            x = x + g2 * f[n_ctx_tok:].reshape(x.shape)
        else:
            x = x + g2 * moe(hn_l.reshape(-1, D_MODEL), *moe_params).reshape(x.shape)
    return rmsnorm(x, g_final).astype(out_dtype)
```

```cpp
#define MK_SPLIT 1
#include <hip/hip_runtime.h>
#include <cstdio>
#include <cstdint>

#define LAS __attribute__((address_space(3)))
typedef unsigned short bf16_t;
typedef short bf16x8 __attribute__((ext_vector_type(8)));
typedef float f32x4 __attribute__((ext_vector_type(4)));
typedef float f32x2 __attribute__((ext_vector_type(2)));
typedef float f32x16 __attribute__((ext_vector_type(16)));
typedef unsigned u32x4 __attribute__((ext_vector_type(4)));
typedef unsigned u32x2 __attribute__((ext_vector_type(2)));

constexpr int D = 1024, NB = 16, SEQ = 2048, CTXL = 256, DEPTH = 4;
constexpr int NLAT = NB * SEQ, NCTX = NB * CTXL, NTOK = NLAT + NCTX;
constexpr int INW = 4608, NEXP = 32;
constexpr int NCH = 144;
constexpr int NROW3 = NB * NCH;
constexpr int MAXSLOT = NTOK * 4 + NEXP * 256;

__device__ __forceinline__ float bf2f(unsigned short b) { return __uint_as_float(((unsigned)b) << 16); }
__device__ __forceinline__ float bflo(unsigned w) { return __uint_as_float(w << 16); }
__device__ __forceinline__ float bfhi(unsigned w) { return __uint_as_float(w & 0xffff0000u); }
__device__ __forceinline__ unsigned cvt_pk_bf16(float lo, float hi) { unsigned r; asm volatile("v_cvt_pk_bf16_f32 %0, %1, %2" : "=v"(r) : "v"(lo), "v"(hi)); return r; }
__device__ __forceinline__ unsigned short f2bf(float f) { return (unsigned short)(cvt_pk_bf16(f, 0.f) & 0xffffu); }
__device__ __forceinline__ float sigmoidf_(float x) { return 1.0f / (1.0f + __expf(-x)); }
__device__ __forceinline__ float gelu_tanh(float x) { const float z = 1.5957691216f * (x + 0.044715f * x * x * x); return x / (1.0f + __expf(-z)); }
__device__ __forceinline__ float wave_sum(float v) {
#pragma unroll
    for (int o = 1; o < 64; o <<= 1) v += __shfl_xor(v, o);
    return v;
}

namespace pg8 {
constexpr int BM = 256, BK = 64, HALF = 128, HTB = HALF * BK * 2, STAGE_BYTES = 8 * HTB, NXCD = 8, WGM = 8;
__host__ __device__ __forceinline__ int lds_byte(int r, int c) { const int st = (r >> 4) * 2 + (c >> 5), rr = r & 15, cc = c & 31, ob = rr * 64 + cc * 2; return st * 1024 + (ob ^ (((ob >> 9) & 1) << 5)); }
__host__ __device__ __forceinline__ void stage_rc(int b, int& R, int& C) { const int st = b / 1024, sb = b % 1024, swz = sb ^ (((sb >> 9) & 1) << 5); R = (st >> 1) * 16 + swz / 64; C = (st & 1) * 32 + (swz % 64) / 2; }
__host__ __device__ __forceinline__ int perm32(int rho) { const int n = rho >> 4, i = rho & 15; return 8 * (i >> 2) + 4 * n + (i & 3); }

struct Unit { int pm, pn, grp; const char* a; const char* b; };
struct Gemm { int lda, ldb, K; };

struct StaticOrder {
    int nM, nN, nwg, G, c;
    __device__ void init(int nM_, int nN_, int G_, int c_) { nM = nM_; nN = nN_; nwg = nM * nN; G = G_; c = c_; }
    __device__ bool next(int i, int& pm, int& pn) const {
        const long L = (long)i * G + c; if (L >= nwg) return false;
        int wgid = (int)L; { const int q = nwg / NXCD, r = nwg % NXCD, xcd = wgid % NXCD, off = wgid / NXCD; wgid = (xcd < r ? xcd * (q + 1) : r * (q + 1) + (xcd - r) * q) + off; }
        const int nig = WGM * nN, gid = wgid / nig, fm = gid * WGM, gsz = (nM - fm) < WGM ? (nM - fm) : WGM;
        pm = fm + ((wgid % nig) % gsz); pn = (wgid % nig) / gsz; return true;
    }
};

template <class Epi, class Sched>
__device__ __forceinline__ void gemm_phase(LAS unsigned char* lds, const int tid, const Gemm g, const Sched& S, const Epi& E) {
    const int wid = __builtin_amdgcn_readfirstlane(tid >> 6), lane = tid & 63, wr = wid >> 2, wc = wid & 3, fr = lane & 15, fq = lane >> 4;
    const int K = g.K, nt = K / BK;
    unsigned voffA[2], voffB[2];
#pragma unroll
    for (int i = 0; i < 2; ++i) { int R, C; stage_rc(tid * 16 + i * 8192, R, C); const int Rb = Epi::PERM ? ((R & ~31) + perm32(R & 31)) : R;
        voffA[i] = (unsigned)(R * g.lda + C) * 2u; voffB[i] = (unsigned)(Rb * g.ldb + C) * 2u; }
    const size_t kstep = (size_t)(BK * 2);
    const size_t hstepA = (size_t)HALF * g.lda * 2, hstepB = (size_t)HALF * g.ldb * 2;
    const unsigned ldsw = (unsigned)wid * 1024u;
    const int aoff = lds_byte(wr * 64 + fr, fq * 8), boff = lds_byte(wc * 32 + fr, fq * 8);
#define PG8_SA(b, h) (((b) * 2 + (h)) * HTB)
#define PG8_SB(b, h) ((4 + (b) * 2 + (h)) * HTB)
#define PG8_STAGE(bufoff, gbase, voff) do { _Pragma("unroll") for (int _i = 0; _i < 2; ++_i) \
        __builtin_amdgcn_global_load_lds((const unsigned*)((const char*)(gbase) + (voff)[_i]), (LAS unsigned*)(lds + (bufoff) + ldsw + _i * 8192), 16, 0, 0); } while (0)
#define PG8_LDA(dst, b, h) do { _Pragma("unroll") for (int m = 0; m < 4; ++m) _Pragma("unroll") for (int k = 0; k < 2; ++k) dst[m][k] = *(const LAS bf16x8*)(lds + PG8_SA(b, h) + aoff + m * 2048 + k * 1024); } while (0)
#define PG8_LDB(dst, b, h) do { _Pragma("unroll") for (int n = 0; n < 2; ++n) _Pragma("unroll") for (int k = 0; k < 2; ++k) dst[n][k] = *(const LAS bf16x8*)(lds + PG8_SB(b, h) + boff + n * 2048 + k * 1024); } while (0)
#define PG8_MMA(ai, bj, At, Bt) do { __builtin_amdgcn_s_setprio(1); _Pragma("unroll") for (int m = 0; m < 4; ++m) _Pragma("unroll") for (int n = 0; n < 2; ++n) _Pragma("unroll") for (int k = 0; k < 2; ++k) \
        acc[ai][bj][m][n] = __builtin_amdgcn_mfma_f32_16x16x32_bf16(Bt[n][k], At[m][k], acc[ai][bj][m][n], 0, 0, 0); __builtin_amdgcn_s_setprio(0); } while (0)
#define PG8_WAIT_V(n) asm volatile("s_waitcnt vmcnt(" #n ")" ::: "memory")
#define PG8_WAIT_L(n) asm volatile("s_waitcnt lgkmcnt(" #n ")" ::: "memory")
#define PG8_BAR __builtin_amdgcn_s_barrier()
#define PG8_SCHED __builtin_amdgcn_sched_barrier(0)
    Unit cur, nxt; int ui = 0;
    if (!S.next(0, cur)) return;
    f32x4 acc[2][2][4][2];
#pragma unroll
    for (int a = 0; a < 2; ++a)
#pragma unroll
        for (int b = 0; b < 2; ++b)
#pragma unroll
            for (int m = 0; m < 4; ++m)
#pragma unroll
                for (int n = 0; n < 2; ++n) acc[a][b][m][n] = (f32x4){0.f, 0.f, 0.f, 0.f};
    bf16x8 At[4][2], B0[2][2], B1[2][2];
    const char* cA = cur.a; const char* cB = cur.b;
    PG8_STAGE(PG8_SB(0, 0), cB, voffB); PG8_STAGE(PG8_SB(0, 1), cB + hstepB, voffB); PG8_STAGE(PG8_SA(0, 0), cA, voffA); PG8_STAGE(PG8_SA(0, 1), cA + hstepA, voffA);
    if (wr == 1) PG8_BAR;
    PG8_WAIT_V(2); PG8_BAR;
    PG8_STAGE(PG8_SB(1, 0), cB + kstep, voffB); PG8_STAGE(PG8_SA(1, 0), cA + kstep, voffA); PG8_STAGE(PG8_SB(1, 1), cB + hstepB + kstep, voffB);
    PG8_WAIT_V(6); PG8_BAR;
    for (;;) {
        const bool has_next = S.next(ui + 1, nxt);
        const char* nA = has_next ? nxt.a : cA; const char* nB = has_next ? nxt.b : cB;
#pragma unroll 1
        for (int t = 0; t < nt; t += 2) {
            const bool last = (t == nt - 2);
            const char* a1 = cA + (size_t)(t + 1) * kstep;
            const char* a2 = last ? nA : cA + (size_t)(t + 2) * kstep; const char* b2 = last ? nB : cB + (size_t)(t + 2) * kstep;
            const char* a3 = a2 + kstep; const char* b3 = b2 + kstep;
            PG8_LDB(B0, 0, 0); PG8_LDB(B1, 0, 1); PG8_SCHED; PG8_LDA(At, 0, 0); PG8_STAGE(PG8_SA(1, 1), a1 + hstepA, voffA);
            PG8_WAIT_V(8); PG8_WAIT_L(0); PG8_BAR; PG8_MMA(0, 0, At, B0); PG8_MMA(0, 1, At, B1); PG8_BAR; PG8_SCHED;
            PG8_LDA(At, 0, 1); PG8_STAGE(PG8_SB(0, 0), b2, voffB); PG8_STAGE(PG8_SB(0, 1), b2 + hstepB, voffB); PG8_STAGE(PG8_SA(0, 0), a2, voffA);
            PG8_WAIT_V(8); PG8_WAIT_L(0); PG8_BAR; PG8_MMA(1, 0, At, B0); PG8_MMA(1, 1, At, B1); PG8_BAR; PG8_SCHED;
            PG8_LDB(B0, 1, 0); PG8_LDB(B1, 1, 1); PG8_SCHED; PG8_LDA(At, 1, 0); PG8_STAGE(PG8_SA(0, 1), a2 + hstepA, voffA);
            PG8_WAIT_V(8); PG8_WAIT_L(0); PG8_BAR; PG8_MMA(0, 0, At, B0); PG8_MMA(0, 1, At, B1); PG8_BAR; PG8_SCHED;
            PG8_LDA(At, 1, 1); PG8_STAGE(PG8_SB(1, 0), b3, voffB); PG8_STAGE(PG8_SB(1, 1), b3 + hstepB, voffB); PG8_STAGE(PG8_SA(1, 0), a3, voffA);
            PG8_WAIT_V(8); PG8_WAIT_L(0); PG8_BAR; PG8_MMA(1, 0, At, B0); PG8_MMA(1, 1, At, B1); PG8_BAR; PG8_SCHED;
        }
        if (wr == 0) PG8_BAR;
        E(acc, cur, wr, wc, fr, fq);
        if (!has_next) break;
#pragma unroll
        for (int a = 0; a < 2; ++a)
#pragma unroll
            for (int b = 0; b < 2; ++b)
#pragma unroll
                for (int m = 0; m < 4; ++m)
#pragma unroll
                    for (int n = 0; n < 2; ++n) acc[a][b][m][n] = (f32x4){0.f, 0.f, 0.f, 0.f};
        cur = nxt; cA = nA; cB = nB; ++ui;
        if (wr == 1) PG8_BAR;
    }
    PG8_WAIT_V(0);
    PG8_BAR;
#undef PG8_SA
#undef PG8_SB
#undef PG8_STAGE
#undef PG8_LDA
#undef PG8_LDB
#undef PG8_MMA
#undef PG8_WAIT_V
#undef PG8_WAIT_L
#undef PG8_BAR
#undef PG8_SCHED
}
}
using pg8::Unit;

#define XB_TMO      128
#define XB_XCNT(j)  (256  + 64 * (j))
#define XB_XSUB(j)  (1280 + 64 * (j))
#define XB_XGEN(j)  (2304 + 64 * (j))
#define XB_TOP      3328
#define XB_TOPGEN   3392
#define XCD_BAR_WORDS 3456
#define XB_SPIN_CAP (1u << 18)
__device__ __forceinline__ unsigned xb_ld(unsigned* p)              { return __hip_atomic_load(p, __ATOMIC_RELAXED, __HIP_MEMORY_SCOPE_AGENT); }
__device__ __forceinline__ unsigned xb_add(unsigned* p, unsigned v) { return __hip_atomic_fetch_add(p, v, __ATOMIC_RELAXED, __HIP_MEMORY_SCOPE_AGENT); }
__device__ __forceinline__ unsigned xb_xcc_id() { return (unsigned)__builtin_amdgcn_s_getreg((3 << 11) | 20) & 0xFu; }
#define XB_SPIN(cond, bar) do { unsigned _sp = 0; while (cond) { __builtin_amdgcn_s_sleep(1); \
    if ((++_sp & 255u) == 0u) { if (xb_ld(&(bar)[XB_TMO])) break; if (_sp > XB_SPIN_CAP) { atomicAdd(&(bar)[XB_TMO], 1u); break; } } } } while (0)
struct XcdBarrier { unsigned* bar; unsigned x; volatile LAS unsigned* st; };
__device__ __forceinline__ XcdBarrier xcd_barrier_post(unsigned* bar, volatile LAS unsigned* st) {
    XcdBarrier b; b.bar = bar; b.x = xb_xcc_id(); b.st = st;
    if (threadIdx.x == 0) (void)xb_add(&bar[XB_XCNT(b.x)], 1u);
    return b;
}
__device__ __forceinline__ void xcd_barrier_complete(unsigned* bar, unsigned x, unsigned& nloc, unsigned& nx) {
    const unsigned G = gridDim.x * gridDim.y * gridDim.z;
    unsigned sum, cnt, mine, sp = 0u;
    for (;;) {
        sum = 0u; cnt = 0u; mine = 0u;
#pragma unroll
        for (unsigned j = 0; j < 16; ++j) { const unsigned c = xb_ld(&bar[XB_XCNT(j)]); sum += c; cnt += (c > 0u) ? 1u : 0u; mine = (j == x) ? c : mine; }
        if (sum == G) break;
        __builtin_amdgcn_s_sleep(1);
        if ((++sp & 255u) == 0u) { if (xb_ld(&bar[XB_TMO])) break; if (sp > XB_SPIN_CAP) { atomicAdd(&bar[XB_TMO], 1u); break; } }
    }
    nloc = mine > 0u ? mine : 1u; nx = cnt > 0u ? cnt : 1u;
}
__device__ __forceinline__ void xcd_barrier(const XcdBarrier& b) {
    asm volatile("s_waitcnt vmcnt(0)" ::: "memory");
    __syncthreads();
    if (threadIdx.x == 0) {
        unsigned* bar = b.bar;
        __builtin_amdgcn_s_waitcnt(0);
        unsigned nloc = b.st[0], nx = b.st[1];
        if (nloc == 0u) { xcd_barrier_complete(bar, b.x, nloc, nx); b.st[0] = nloc; b.st[1] = nx; }
        const unsigned old = xb_add(&bar[XB_XSUB(b.x)], 1u);
        const unsigned gen = old / nloc;
        if (old + 1u == (gen + 1u) * nloc) {
            __builtin_amdgcn_fence(__ATOMIC_RELEASE, "agent");
            asm volatile("s_waitcnt vmcnt(0)" ::: "memory");
            const unsigned og = xb_add(&bar[XB_TOP], 1u);
            const unsigned tg = og / nx;
            if (og + 1u == (tg + 1u) * nx) xb_add(&bar[XB_TOPGEN], 1u);
            else XB_SPIN(xb_ld(&bar[XB_TOPGEN]) == tg, bar);
            __builtin_amdgcn_fence(__ATOMIC_ACQUIRE, "agent");
            xb_add(&bar[XB_XGEN(b.x)], 1u);
            asm volatile("s_waitcnt vmcnt(0)" ::: "memory");
        } else {
            XB_SPIN(xb_ld(&bar[XB_XGEN(b.x)]) == gen, bar);
            __builtin_amdgcn_fence(__ATOMIC_ACQUIRE, "agent");
            asm volatile("s_waitcnt vmcnt(0)" ::: "memory");
        }
    }
    __syncthreads();
}

constexpr size_t al256(size_t x) { return (x + 255) & ~(size_t)255; }
constexpr size_t WS_CTL = 0, CTL_ZERO_BYTES = 1u << 20;
constexpr int CW_CNT = 1024;
constexpr int CW_BAR = 4096;
constexpr size_t WS_ADA   = CTL_ZERO_BYTES;
constexpr size_t WS_DEC   = al256(WS_ADA + (size_t)DEPTH * 17 * 6144 * 4);
constexpr size_t WS_W3T   = al256(WS_DEC + (size_t)DEPTH * 2 * 32 * 64 * 2 * 4);
constexpr size_t WS_FT    = al256(WS_W3T + (size_t)DEPTH * 32 * 256 * 512 * 2);
constexpr size_t WS_WINT  = al256(WS_FT + (size_t)DEPTH * 32 * 256 * 256 * 2);
constexpr size_t WS_WGLUT = al256(WS_WINT + (size_t)DEPTH * INW * D * 2);
constexpr size_t WS_WP5T  = al256(WS_WGLUT + (size_t)DEPTH * 512 * 512 * 2);
constexpr size_t WS_WPLT  = al256(WS_WP5T + (size_t)DEPTH * D * 512 * 2);
constexpr size_t WS_WOUTT = al256(WS_WPLT + (size_t)DEPTH * D * D * 2);
constexpr size_t WS_WUPT  = al256(WS_WOUTT + (size_t)DEPTH * D * D * 2);
constexpr size_t WS_WDNT  = al256(WS_WUPT + (size_t)DEPTH * NEXP * 2048 * D * 2);
constexpr size_t WS_X     = al256(WS_WDNT + (size_t)DEPTH * NEXP * D * D * 2);
constexpr size_t WS_HN    = al256(WS_X + (size_t)NTOK * D * 4);
constexpr size_t WS_A3    = al256(WS_HN + (size_t)NTOK * D * 2);
constexpr size_t WS_SB    = al256(WS_A3 + (size_t)NROW3 * 32 * 512 * 2);
constexpr size_t WS_XR    = al256(WS_SB + (size_t)NROW3 * 32 * 256 * 4);
constexpr size_t WS_GG    = al256(WS_XR + (size_t)NTOK * D * 2);
constexpr size_t WS_M5    = al256(WS_GG + (size_t)NTOK * D * 2);
constexpr size_t WS_ML    = al256(WS_M5 + (size_t)NTOK * D * 2);
constexpr size_t WS_HF    = al256(WS_ML + (size_t)NTOK * D * 2);
constexpr size_t WS_HB    = al256(WS_HF + (size_t)NTOK * D * 2);
constexpr size_t WS_OL    = al256(WS_HB + (size_t)NTOK * D * 2);
constexpr size_t WS_GY    = al256(WS_OL + (size_t)NTOK * D * 2);
constexpr size_t WS_O5    = al256(WS_GY + (size_t)NTOK * 512 * 2);
constexpr size_t WS_T1    = al256(WS_O5 + (size_t)NTOK * 512 * 2);
constexpr size_t WS_MG    = al256(WS_T1 + (size_t)NTOK * D * 2);
constexpr size_t WS_TOKE  = al256(WS_MG + (size_t)NTOK * D * 2);
constexpr size_t WS_TOKP  = al256(WS_TOKE + (size_t)NTOK * 4 * 4);
constexpr size_t WS_TOKW  = al256(WS_TOKP + (size_t)NTOK * 4 * 4);
constexpr size_t WS_SLOT  = al256(WS_TOKW + (size_t)NTOK * 4 * 4);
constexpr size_t WS_XS    = al256(WS_SLOT + (size_t)NTOK * 4 * 4);
constexpr size_t WS_ACT   = al256(WS_XS + (size_t)MAXSLOT * D * 2);
constexpr size_t WS_Y     = al256(WS_ACT + (size_t)MAXSLOT * D * 2);
constexpr size_t WS_END   = al256(WS_Y + (size_t)MAXSLOT * D * 2);

constexpr int LDS_BYTES = 147456;
constexpr int LDS_CTL = 143360;
constexpr int LC_MISC = LDS_CTL;
constexpr int LC_OFFS = LDS_CTL + 256;
constexpr int LC_LCNT = LDS_CTL + 512;
constexpr int LC_GB   = LDS_CTL + 768;
constexpr int LC_TILE = LDS_CTL + 1024;
constexpr int LC_PTRS = LDS_CTL + 2048;

struct Args { const float* in[36]; float* out; unsigned char* ws; int ph_lo, ph_hi; };

struct Ctx {
    float* out; unsigned char* ws; LAS unsigned char* lds; int tid, lane, wave, G;
    template <class T> __device__ __forceinline__ T* p(size_t off) const { return (T*)(ws + off); }
    __device__ __forceinline__ const float* in(int k) const { const LAS unsigned* t = (const LAS unsigned*)(lds + LC_PTRS) + 2 * k;
        const unsigned lo = __builtin_amdgcn_readfirstlane(t[0]), hi = __builtin_amdgcn_readfirstlane(t[1]); return (const float*)(((unsigned long long)hi << 32) | lo); }
};

struct SchedGrid {
    pg8::StaticOrder so; const char* A; const char* B; size_t atile, btile;
    __device__ __forceinline__ bool next(int i, Unit& u) const { if (!so.next(i, u.pm, u.pn)) return false; u.grp = 0; u.a = A + (size_t)u.pm * atile; u.b = B + (size_t)u.pn * btile; return true; }
};
struct SchedS5 {
    int G, c; const char* A; const char* B; size_t bgrp;
    __device__ __forceinline__ bool next(int i, Unit& u) const { const int L = i * G + c; if (L >= 288) return false; const int g = L / 9, pm = L - g * 9; u.pm = pm; u.pn = 0; u.grp = g;
        u.a = A + ((size_t)pm * 256 * 16384 + (size_t)g * 512) * 2; u.b = B + (size_t)g * bgrp; return true; }
};
struct SchedMoe {
    pg8::StaticOrder so; const char* A; const char* B; size_t atile, btile, bexp; const LAS unsigned char* tile_e;
    __device__ __forceinline__ bool next(int i, Unit& u) const { if (!so.next(i, u.pm, u.pn)) return false; u.grp = tile_e[u.pm]; u.a = A + (size_t)u.pm * atile; u.b = B + (size_t)u.grp * bexp + (size_t)u.pn * btile; return true; }
};

#define EPI_ROWS_BEGIN  _Pragma("unroll") for (int ai = 0; ai < 2; ++ai) _Pragma("unroll") for (int m = 0; m < 4; ++m) { const int row = u.pm * 256 + ai * 128 + wr * 64 + m * 16 + fr;
#define EPI_ROWS_END    asm volatile("" ::: "memory"); }
__device__ __forceinline__ u32x4 pack8(const f32x4 a, const f32x4 b) { u32x4 w; w.x = cvt_pk_bf16(a[0], a[1]); w.y = cvt_pk_bf16(a[2], a[3]); w.z = cvt_pk_bf16(b[0], b[1]); w.w = cvt_pk_bf16(b[2], b[3]); return w; }
__device__ __forceinline__ void unpack8(const u32x4 w, f32x4& a, f32x4& b) { a = (f32x4){bflo(w.x), bfhi(w.x), bflo(w.y), bfhi(w.y)}; b = (f32x4){bflo(w.z), bfhi(w.z), bflo(w.w), bfhi(w.w)}; }

struct EpiInProj {
    static constexpr bool PERM = true;
    bf16_t *A3, *XR, *GG, *M5, *ML;
    __device__ __forceinline__ void operator()(const f32x4 (&acc)[2][2][4][2], const Unit& u, int wr, int wc, int fr, int fq) const {
        const int pn = u.pn;
        EPI_ROWS_BEGIN
#pragma unroll
            for (int bj = 0; bj < 2; ++bj) {
                const int col = pn * 256 + bj * 128 + wc * 32 + 8 * fq; f32x4 v0 = acc[ai][bj][m][0], v1 = acc[ai][bj][m][1];
                if (pn < 2) {
                    int b, cidx, j; if (row < NLAT) { b = row >> 11; const int t = row & 2047; cidx = 16 + (t >> 4); j = t & 15; } else { const int rr = row - NLAT; b = rr >> 8; const int tc = rr & 255; cidx = tc >> 4; j = tc & 15; }
                    const int g = col >> 4, h = col & 15;
                    *(u32x4*)(A3 + ((size_t)((b * NCH + cidx) * 32 + g)) * 512 + j * 16 + h) = pack8(v0, v1);
                } else if (pn < 6) {
                    *(u32x4*)(XR + (size_t)row * D + (col - 512)) = pack8(v0, v1);
                } else if (pn < 10) {
#pragma unroll
                    for (int q = 0; q < 4; ++q) { v0[q] = gelu_tanh(v0[q]); v1[q] = gelu_tanh(v1[q]); }
                    *(u32x4*)(GG + (size_t)row * D + (col - 1536)) = pack8(v0, v1);
                } else {
#pragma unroll
                    for (int q = 0; q < 4; ++q) { v0[q] = sigmoidf_(v0[q]); v1[q] = sigmoidf_(v1[q]); }
                    bf16_t* dst = pn < 14 ? M5 + (size_t)row * D + (col - 2560) : ML + (size_t)row * D + (col - 3584);
                    *(u32x4*)dst = pack8(v0, v1);
                }
            }
        EPI_ROWS_END
    }
};
struct EpiS5L1 {
    static constexpr bool PERM = false;
    float* S;
    __device__ __forceinline__ void operator()(const f32x4 (&acc)[2][2][4][2], const Unit& u, int wr, int wc, int fr, int fq) const {
        EPI_ROWS_BEGIN
            float* rowp = S + ((size_t)row * 32 + u.grp) * 256 + wc * 32 + 4 * fq;
#pragma unroll
            for (int bj = 0; bj < 2; ++bj)
#pragma unroll
                for (int n = 0; n < 2; ++n) *(f32x4*)(rowp + bj * 128 + n * 16) = acc[ai][bj][m][n];
        EPI_ROWS_END
    }
};
struct EpiS5Y {
    static constexpr bool PERM = true;
    bf16_t* GY;
    __device__ __forceinline__ void operator()(const f32x4 (&acc)[2][2][4][2], const Unit& u, int wr, int wc, int fr, int fq) const {
        EPI_ROWS_BEGIN
            const int b = row / NCH, cidx = row - b * NCH;
            const int tok0 = cidx < 16 ? NLAT + b * 256 + cidx * 16 : b * 2048 + (cidx - 16) * 16;
#pragma unroll
            for (int bj = 0; bj < 2; ++bj) {
                const int col = bj * 128 + wc * 32 + 8 * fq, j = col >> 4, h = col & 15; f32x4 v0 = acc[ai][bj][m][0], v1 = acc[ai][bj][m][1];
#pragma unroll
                for (int q = 0; q < 4; ++q) { v0[q] = gelu_tanh(v0[q]); v1[q] = gelu_tanh(v1[q]); }
                *(u32x4*)(GY + (size_t)(tok0 + j) * 512 + u.grp * 16 + h) = pack8(v0, v1);
            }
        EPI_ROWS_END
    }
};
struct EpiGlu {
    static constexpr bool PERM = true;
    const bf16_t* GY; bf16_t* O5; const float* bias;
    __device__ __forceinline__ void operator()(const f32x4 (&acc)[2][2][4][2], const Unit& u, int wr, int wc, int fr, int fq) const {
        EPI_ROWS_BEGIN
#pragma unroll
            for (int bj = 0; bj < 2; ++bj) {
                const int col = u.pn * 256 + bj * 128 + wc * 32 + 8 * fq; f32x4 v0 = acc[ai][bj][m][0], v1 = acc[ai][bj][m][1];
                const f32x4 b0 = *(const f32x4*)(bias + col), b1 = *(const f32x4*)(bias + col + 4);
                f32x4 g0, g1; unpack8(*(const u32x4*)(GY + (size_t)row * 512 + col), g0, g1);
#pragma unroll
                for (int q = 0; q < 4; ++q) { v0[q] = g0[q] * sigmoidf_(v0[q] + b0[q]); v1[q] = g1[q] * sigmoidf_(v1[q] + b1[q]); }
                *(u32x4*)(O5 + (size_t)row * 512 + col) = pack8(v0, v1);
            }
        EPI_ROWS_END
    }
};
struct EpiMulGate {
    static constexpr bool PERM = true;
    const bf16_t* GATE; const bf16_t* ADD; bf16_t* O;
    __device__ __forceinline__ void operator()(const f32x4 (&acc)[2][2][4][2], const Unit& u, int wr, int wc, int fr, int fq) const {
        EPI_ROWS_BEGIN
#pragma unroll
            for (int bj = 0; bj < 2; ++bj) {
                const size_t off = (size_t)row * D + u.pn * 256 + bj * 128 + wc * 32 + 8 * fq; f32x4 v0 = acc[ai][bj][m][0], v1 = acc[ai][bj][m][1];
                f32x4 g0, g1; unpack8(*(const u32x4*)(GATE + off), g0, g1);
                v0 = v0 * g0; v1 = v1 * g1;
                if (ADD) { f32x4 a0, a1; unpack8(*(const u32x4*)(ADD + off), a0, a1); v0 = v0 + a0; v1 = v1 + a1; }
                *(u32x4*)(O + off) = pack8(v0, v1);
            }
        EPI_ROWS_END
    }
};
struct EpiOut {
    static constexpr bool PERM = false;
    const float* xlat; const float* xctx; float* X; const float* ada; int l;
    __device__ __forceinline__ void operator()(const f32x4 (&acc)[2][2][4][2], const Unit& u, int wr, int wc, int fr, int fq) const {
        const int bsel = u.pm < 128 ? (u.pm >> 3) : 16;
        const float* gate = ada + ((size_t)(l * 17 + bsel) * 6 + 2) * D;
        const int col0 = u.pn * 256 + wc * 32 + 4 * fq;
        f32x4 gv[2][2];
#pragma unroll
        for (int bj = 0; bj < 2; ++bj)
#pragma unroll
            for (int n = 0; n < 2; ++n) gv[bj][n] = *(const f32x4*)(gate + col0 + bj * 128 + n * 16);
        EPI_ROWS_BEGIN
            const float* src = row < NLAT ? xlat + (size_t)row * D : xctx + (size_t)(row - NLAT) * D;
            float* dst = X + (size_t)row * D;
#pragma unroll
            for (int bj = 0; bj < 2; ++bj)
#pragma unroll
                for (int n = 0; n < 2; ++n) { const int c = col0 + bj * 128 + n * 16; *(f32x4*)(dst + c) = *(const f32x4*)(src + c) + gv[bj][n] * acc[ai][bj][m][n]; }
        EPI_ROWS_END
    }
};
struct EpiUp {
    static constexpr bool PERM = true;
    bf16_t* ACT; const float* bup;
    __device__ __forceinline__ void operator()(const f32x4 (&acc)[2][2][4][2], const Unit& u, int wr, int wc, int fr, int fq) const {
        const int a0 = u.pn * 128 + wc * 32 + 8 * fq;
        const float* bp = bup + (size_t)u.grp * 2048 + 2 * a0;
        float bg[8], bu[8];
#pragma unroll
        for (int q = 0; q < 4; ++q) { const f32x4 t = *(const f32x4*)(bp + 4 * q); bg[2 * q] = t[0]; bu[2 * q] = t[1]; bg[2 * q + 1] = t[2]; bu[2 * q + 1] = t[3]; }
        EPI_ROWS_BEGIN
            f32x4 o0, o1;
#pragma unroll
            for (int q = 0; q < 4; ++q) {
                float gt = fminf(acc[ai][0][m][0][q] + bg[q], 7.0f), up = fminf(fmaxf(acc[ai][1][m][0][q] + bu[q], -7.0f), 7.0f);
                o0[q] = gt * sigmoidf_(1.702f * gt) * (up + 1.0f);
                gt = fminf(acc[ai][0][m][1][q] + bg[4 + q], 7.0f); up = fminf(fmaxf(acc[ai][1][m][1][q] + bu[4 + q], -7.0f), 7.0f);
                o1[q] = gt * sigmoidf_(1.702f * gt) * (up + 1.0f);
            }
            *(u32x4*)(ACT + (size_t)row * D + a0) = pack8(o0, o1);
        EPI_ROWS_END
    }
};
struct EpiDown {
    static constexpr bool PERM = true;
    bf16_t* Y; const float* bdn;
    __device__ __forceinline__ void operator()(const f32x4 (&acc)[2][2][4][2], const Unit& u, int wr, int wc, int fr, int fq) const {
        EPI_ROWS_BEGIN
#pragma unroll
            for (int bj = 0; bj < 2; ++bj) {
                const int col = u.pn * 256 + bj * 128 + wc * 32 + 8 * fq;
                const f32x4 b0 = *(const f32x4*)(bdn + (size_t)u.grp * D + col), b1 = *(const f32x4*)(bdn + (size_t)u.grp * D + col + 4);
                *(u32x4*)(Y + (size_t)row * D + col) = pack8(acc[ai][bj][m][0] + b0, acc[ai][bj][m][1] + b1);
            }
        EPI_ROWS_END
    }
};

template <bool UPMAP>
__device__ __forceinline__ void transpose_item(const float* W, int K, int N, bf16_t* WT, LAS float* scr, int item, int lane) {
    const int nblk = N / 32, kb = item / nblk, nb = item % nblk, k0 = 64 * kb, n0 = 32 * nb;
#pragma unroll 8
    for (int i = 0; i < 32; ++i) { const int kk = 2 * i + (lane >> 5); scr[kk * 33 + (lane & 31)] = W[(size_t)(k0 + kk) * N + n0 + (lane & 31)]; }
    asm volatile("s_waitcnt lgkmcnt(0)" ::: "memory");
    const int c = lane & 7;
#pragma unroll
    for (int j = 0; j < 4; ++j) { const int n = (lane >> 3) + 8 * j; const LAS float* s = scr + (8 * c) * 33 + n;
        u32x4 o; o.x = cvt_pk_bf16(s[0 * 33], s[1 * 33]); o.y = cvt_pk_bf16(s[2 * 33], s[3 * 33]); o.z = cvt_pk_bf16(s[4 * 33], s[5 * 33]); o.w = cvt_pk_bf16(s[6 * 33], s[7 * 33]);
        int orow = n0 + n; if (UPMAP) { const int a = orow >> 1, sft = orow & 1; orow = (a >> 7) * 256 + sft * 128 + (a & 127); }
        *(u32x4*)(WT + (size_t)orow * K + k0 + 8 * c) = o; }
    asm volatile("s_waitcnt lgkmcnt(0)" ::: "memory");
}
__device__ __forceinline__ void phase_transposes(const Ctx& C) {
    LAS float* scr = (LAS float*)(C.lds + C.wave * 16384);
    const int gw = blockIdx.x * 8 + C.wave, NGW = C.G * 8;
    constexpr int I_IN = 16 * 144, I_GLU = 8 * 16, I_P5 = 8 * 32, I_PL = 16 * 32, I_OUT = 16 * 32, I_UP1 = 16 * 64, I_UP = 32 * I_UP1, I_DN1 = 16 * 32, I_DN = 32 * I_DN1;
    constexpr int PER_L = I_IN + I_GLU + I_P5 + I_PL + I_OUT + I_UP + I_DN;
    for (int it = gw; it < DEPTH * PER_L; it += NGW) {
        const int l = it / PER_L; int r = it - l * PER_L;
        if (r < I_IN) { transpose_item<false>(C.in(8) + (size_t)l * D * INW, D, INW, C.p<bf16_t>(WS_WINT) + (size_t)l * INW * D, scr, r, C.lane); continue; } r -= I_IN;
        if (r < I_GLU) { transpose_item<false>(C.in(17) + (size_t)l * 512 * 512, 512, 512, C.p<bf16_t>(WS_WGLUT) + (size_t)l * 512 * 512, scr, r, C.lane); continue; } r -= I_GLU;
        if (r < I_P5) { transpose_item<false>(C.in(26) + (size_t)l * 512 * D, 512, D, C.p<bf16_t>(WS_WP5T) + (size_t)l * D * 512, scr, r, C.lane); continue; } r -= I_P5;
        if (r < I_PL) { transpose_item<false>(C.in(27) + (size_t)l * D * D, D, D, C.p<bf16_t>(WS_WPLT) + (size_t)l * D * D, scr, r, C.lane); continue; } r -= I_PL;
        if (r < I_OUT) { transpose_item<false>(C.in(28) + (size_t)l * D * D, D, D, C.p<bf16_t>(WS_WOUTT) + (size_t)l * D * D, scr, r, C.lane); continue; } r -= I_OUT;
        if (r < I_UP) { const int e = r / I_UP1; transpose_item<true>(C.in(31) + ((size_t)l * NEXP + e) * D * 2048, D, 2048, C.p<bf16_t>(WS_WUPT) + ((size_t)l * NEXP + e) * 2048 * D, scr, r - e * I_UP1, C.lane); continue; } r -= I_UP;
        { const int e = r / I_DN1; transpose_item<false>(C.in(33) + ((size_t)l * NEXP + e) * D * D, D, D, C.p<bf16_t>(WS_WDNT) + ((size_t)l * NEXP + e) * D * D, scr, r - e * I_DN1, C.lane); }
    }
}

__device__ __forceinline__ void phase_s5prep(const Ctx& C) {
    LAS float* PW = (LAS float*)(C.lds);
    LAS float* BB = (LAS float*)(C.lds + 17408);
    LAS float* CC = (LAS float*)(C.lds + 17408 + 16384);
    LAS float* KT = (LAS float*)(C.lds + 17408 + 32768);
    const int tid = C.tid;
    for (int item = blockIdx.x; item < DEPTH * 32; item += C.G) {
        const int l = item >> 5, g = item & 31;
        __syncthreads();
        if (tid < 128) {
            const int dr = tid >> 6, p = tid & 63; const size_t ix = ((size_t)(l * 2 + dr) * 32 + g) * 64 + p;
            const double lr = (double)C.in(9)[ix], li = (double)C.in(10)[ix], dt = exp((double)C.in(11)[(l * 2 + dr) * 32 + g]);
            for (int k = 0; k <= 16; ++k) { const double mag = exp(lr * dt * k), ang = li * dt * k; PW[((dr * 17 + k) * 64 + p) * 2] = (float)(mag * cos(ang)); PW[((dr * 17 + k) * 64 + p) * 2 + 1] = (float)(mag * sin(ang)); }
            const double m1 = exp(lr * dt), abr = m1 * cos(li * dt), abi = m1 * sin(li * dt), den = lr * lr + li * li, zr = abr - 1.0;
            const double qr = (zr * lr + abi * li) / den, qi = (abi * lr - zr * li) / den;
            for (int h = 0; h < 16; ++h) { const double br = (double)C.in(12)[ix * 16 + h], bi = (double)C.in(13)[ix * 16 + h];
                BB[((dr * 64 + p) * 16 + h) * 2] = (float)(qr * br - qi * bi); BB[((dr * 64 + p) * 16 + h) * 2 + 1] = (float)(qr * bi + qi * br); }
            float* dec = C.p<float>(WS_DEC) + ix * 2; const double m16 = exp(lr * dt * 16), a16 = li * dt * 16; dec[0] = (float)(m16 * cos(a16)); dec[1] = (float)(m16 * sin(a16));
        }
        for (int e = tid; e < 2 * 16 * 64; e += 512) { const int dr = e >> 10, h = (e >> 6) & 15, p = e & 63; const size_t ix = (((size_t)(l * 2 + dr) * 32 + g) * 16 + h) * 64 + p;
            CC[e * 2] = C.in(14)[ix]; CC[e * 2 + 1] = C.in(15)[ix]; }
        __syncthreads();
        for (int e = tid; e < 8192; e += 512) { const int dr = e >> 12, tau = (e >> 8) & 15, i = (e >> 4) & 15, ip = e & 15; float s = 0.f;
            for (int p = 0; p < 64; ++p) { const float cr = CC[((dr * 16 + i) * 64 + p) * 2], ci = CC[((dr * 16 + i) * 64 + p) * 2 + 1], pr = PW[((dr * 17 + tau) * 64 + p) * 2], pi = PW[((dr * 17 + tau) * 64 + p) * 2 + 1];
                const float xr = cr * pr - ci * pi, xi = cr * pi + ci * pr; s += xr * BB[((dr * 64 + p) * 16 + ip) * 2] - xi * BB[((dr * 64 + p) * 16 + ip) * 2 + 1]; }
            KT[e] = s; }
        __syncthreads();
        bf16_t* W3 = C.p<bf16_t>(WS_W3T) + (size_t)item * 256 * 512; bf16_t* FT = C.p<bf16_t>(WS_FT) + (size_t)item * 256 * 256;
        const float* dvec = C.in(16) + (size_t)l * 512 + g * 16;
        for (int e2 = tid; e2 < 256 * 256; e2 += 512) {
            const int row = e2 >> 8, col0 = (e2 & 255) * 2, j = row >> 4, i = row & 15; float v[2];
#pragma unroll
            for (int q = 0; q < 2; ++q) { const int col = col0 + q;
                if (col < 256) { const int jp = col >> 4, ip = col & 15; float s = 0.f; if (j >= jp) s += KT[((0 * 16 + (j - jp)) * 16 + i) * 16 + ip]; if (jp >= j) s += KT[((1 * 16 + (jp - j)) * 16 + i) * 16 + ip]; if (row == col) s += dvec[i]; v[q] = s; }
                else { const int cc = col - 256, dr = cc >> 7, isim = (cc >> 6) & 1, p = cc & 63, pw = dr ? 16 - j : j + 1;
                    const float cr = CC[((dr * 16 + i) * 64 + p) * 2], ci = CC[((dr * 16 + i) * 64 + p) * 2 + 1], pr = PW[((dr * 17 + pw) * 64 + p) * 2], pi = PW[((dr * 17 + pw) * 64 + p) * 2 + 1];
                    v[q] = isim ? -(cr * pi + ci * pr) : (cr * pr - ci * pi); } }
            *(unsigned*)(W3 + (size_t)row * 512 + col0) = cvt_pk_bf16(v[0], v[1]);
        }
        for (int e2 = tid; e2 < 256 * 128; e2 += 512) {
            const int n = e2 >> 7, col0 = (e2 & 127) * 2, blk = n >> 6, p = n & 63, dr = blk >> 1; float v[2];
#pragma unroll
            for (int q = 0; q < 2; ++q) { const int col = col0 + q, jp = col >> 4, ip = col & 15, pw = dr ? jp : 15 - jp;
                const float pr = PW[((dr * 17 + pw) * 64 + p) * 2], pi = PW[((dr * 17 + pw) * 64 + p) * 2 + 1], br = BB[((dr * 64 + p) * 16 + ip) * 2], bi = BB[((dr * 64 + p) * 16 + ip) * 2 + 1];
                v[q] = (blk & 1) ? (pr * bi + pi * br) : (pr * br - pi * bi); }
            *(unsigned*)(FT + (size_t)n * 256 + col0) = cvt_pk_bf16(v[0], v[1]);
        }
    }
    __syncthreads();
}

__device__ __forceinline__ void phase_ada(const Ctx& C) {
    LAS float* cond = (LAS float*)(C.lds);
    LAS float* red = (LAS float*)(C.lds + 17 * 1024 * 4);
    const int tid = C.tid;
    for (int e = tid; e < 17 * 1024; e += 512) { const float v = e < 16 * 1024 ? C.in(1)[e] : C.in(3)[e - 16 * 1024]; cond[e] = v * sigmoidf_(v); }
    __syncthreads();
    const int c = tid & 63, ks = tid >> 6;
    for (int item = blockIdx.x; item < DEPTH * 96; item += C.G) {
        const int l = item / 96, cb = item - l * 96, col = cb * 64 + c;
        const float* W = C.in(4) + (size_t)l * D * 6144 + col;
        float acc[17];
#pragma unroll
        for (int r = 0; r < 17; ++r) acc[r] = 0.f;
        for (int k = ks * 128; k < ks * 128 + 128; k += 4) {
            const float w0 = W[(size_t)k * 6144], w1 = W[(size_t)(k + 1) * 6144], w2 = W[(size_t)(k + 2) * 6144], w3 = W[(size_t)(k + 3) * 6144];
#pragma unroll
            for (int r = 0; r < 17; ++r) { const f32x4 cv = *(const LAS f32x4*)(cond + r * 1024 + k); acc[r] += cv[0] * w0 + cv[1] * w1 + cv[2] * w2 + cv[3] * w3; }
        }
#pragma unroll
        for (int r = 0; r < 17; ++r) red[(ks * 17 + r) * 64 + c] = acc[r];
        __syncthreads();
        for (int e = tid; e < 17 * 64; e += 512) { const int r = e >> 6, cc = e & 63; float s = 0.f;
#pragma unroll
            for (int q = 0; q < 8; ++q) s += red[(q * 17 + r) * 64 + cc];
            C.p<float>(WS_ADA)[(size_t)(l * 17 + r) * 6144 + cb * 64 + cc] = s + C.in(5)[(size_t)l * 6144 + cb * 64 + cc]; }
        __syncthreads();
    }
}

__device__ __forceinline__ void load_row(const Ctx& C, bool from_input, int m, bool combine, int lc  , f32x4 (&v)[4]) {
    const float* src;
    if (from_input) src = m < NLAT ? C.in(0) + (size_t)m * D : C.in(2) + (size_t)(m - NLAT) * D; else src = C.p<float>(WS_X) + (size_t)m * D;
#pragma unroll
    for (int j = 0; j < 4; ++j) v[j] = *(const f32x4*)(src + 4 * C.lane + 256 * j);
    if (combine) {
        const int bsel = m < NLAT ? (m >> 11) : 16;
        const float* g2 = C.p<float>(WS_ADA) + ((size_t)(lc * 17 + bsel) * 6 + 5) * D;
        f32x4 s[4];
#pragma unroll
        for (int j = 0; j < 4; ++j) s[j] = (f32x4){0.f, 0.f, 0.f, 0.f};
#pragma unroll
        for (int k = 0; k < 4; ++k) {
            const int slot = C.p<int>(WS_SLOT)[m * 4 + k]; const float w = C.p<float>(WS_TOKW)[m * 4 + k];
            const bf16_t* y = C.p<bf16_t>(WS_Y) + (size_t)slot * D;
#pragma unroll
            for (int j = 0; j < 4; ++j) { const u32x2 t = *(const u32x2*)(y + 4 * C.lane + 256 * j); s[j] += w * (f32x4){bflo(t.x), bfhi(t.x), bflo(t.y), bfhi(t.y)}; }
        }
#pragma unroll
        for (int j = 0; j < 4; ++j) v[j] += *(const f32x4*)(g2 + 4 * C.lane + 256 * j) * s[j];
    }
}
__device__ __forceinline__ float row_rstd(const f32x4 (&v)[4]) {
    float s = 0.f;
#pragma unroll
    for (int j = 0; j < 4; ++j) s += (v[j][0] * v[j][0] + v[j][1] * v[j][1]) + (v[j][2] * v[j][2] + v[j][3] * v[j][3]);
    return rsqrtf(wave_sum(s) * (1.0f / D) + 1e-6f);
}
__device__ __forceinline__ void norm_mod(const Ctx& C, f32x4 (&v)[4], const float* gain, const float* shift, const float* scale) {
    const float rstd = row_rstd(v);
#pragma unroll
    for (int j = 0; j < 4; ++j) { const int c = 4 * C.lane + 256 * j; const f32x4 gn = *(const f32x4*)(gain + c), sh = *(const f32x4*)(shift + c), sc = *(const f32x4*)(scale + c);
        v[j] = (v[j] * rstd * gn) * (sc + 1.0f) + sh; }
}
__device__ __forceinline__ void phase_norm1(const Ctx& C, int l) {
    const int gw = blockIdx.x * 8 + C.wave, NGW = C.G * 8;
    for (int m = gw; m < NTOK; m += NGW) {
        f32x4 v[4]; load_row(C, l == 0, m, l > 0, l - 1, v);
        if (l > 0) {
#pragma unroll
            for (int j = 0; j < 4; ++j) *(f32x4*)(C.p<float>(WS_X) + (size_t)m * D + 4 * C.lane + 256 * j) = v[j];
        }
        const int bsel = m < NLAT ? (m >> 11) : 16; const float* ada = C.p<float>(WS_ADA) + (size_t)(l * 17 + bsel) * 6 * D;
        norm_mod(C, v, C.in(6) + (size_t)l * D, ada, ada + D);
#pragma unroll
        for (int j = 0; j < 4; ++j) { u32x2 o; o.x = cvt_pk_bf16(v[j][0], v[j][1]); o.y = cvt_pk_bf16(v[j][2], v[j][3]); *(u32x2*)(C.p<bf16_t>(WS_HN) + (size_t)m * D + 4 * C.lane + 256 * j) = o; }
    }
}
__device__ __forceinline__ void phase_norm2(const Ctx& C, int l, int ntok) {
    LAS float* T = (LAS float*)C.lds;
    LAS float* LG = (LAS float*)(C.lds + 131584);
    LAS int* lcnt = (LAS int*)(C.lds + LC_LCNT); LAS int* gb = (LAS int*)(C.lds + LC_GB);
    unsigned* CNT = C.p<unsigned>(WS_CTL) + CW_CNT + l * 32;
    const float* wr = C.in(29) + (size_t)l * D * 32; const float* br = C.in(30) + l * 32;
    const int tid = C.tid;
    for (int blk = blockIdx.x; blk < ntok / 32; blk += C.G) {
#pragma unroll 1
        for (int rr = 0; rr < 4; ++rr) {
            const int r = C.wave * 4 + rr, m = blk * 32 + r;
            f32x4 v[4]; load_row(C, false, m, false, 0, v);
            const int bsel = m < NLAT ? (m >> 11) : 16; const float* ada = C.p<float>(WS_ADA) + (size_t)(l * 17 + bsel) * 6 * D;
            norm_mod(C, v, C.in(7) + (size_t)l * D, ada + 3 * D, ada + 4 * D);
#pragma unroll
            for (int j = 0; j < 4; ++j) { u32x2 o; o.x = cvt_pk_bf16(v[j][0], v[j][1]); o.y = cvt_pk_bf16(v[j][2], v[j][3]); *(u32x2*)(C.p<bf16_t>(WS_HN) + (size_t)m * D + 4 * C.lane + 256 * j) = o;
                *(LAS f32x4*)(T + r * 1028 + 4 * C.lane + 256 * j) = v[j]; }
        }
        if (tid < 32) lcnt[tid] = 0;
        __syncthreads();
        {
            const int r = tid >> 4, eg = tid & 15; float a0 = 0.f, a1 = 0.f;
#pragma unroll 4
            for (int k4 = 0; k4 < 256; ++k4) { const f32x4 t = *(const LAS f32x4*)(T + r * 1028 + 4 * k4);
#pragma unroll
                for (int kk = 0; kk < 4; ++kk) { const f32x2 w = *(const f32x2*)(wr + (size_t)(4 * k4 + kk) * 32 + 2 * eg); a0 += t[kk] * w.x; a1 += t[kk] * w.y; } }
            LG[r * 33 + 2 * eg] = a0 + br[2 * eg]; LG[r * 33 + 2 * eg + 1] = a1 + br[2 * eg + 1];
        }
        __syncthreads();
        int te[4]; float tw[4]; int tp[4];
        if (tid < 32) {
            unsigned used = 0u; float tv[4];
#pragma unroll
            for (int k = 0; k < 4; ++k) { float best = -3.0e38f; int bi = 0;
                for (int e = 0; e < 32; ++e) { const float x = LG[tid * 33 + e]; if (!((used >> e) & 1u) && x > best) { best = x; bi = e; } }
                used |= 1u << bi; te[k] = bi; tv[k] = best; }
            float s = 0.f;
#pragma unroll
            for (int k = 0; k < 4; ++k) { tw[k] = __expf(tv[k] - tv[0]); s += tw[k]; }
#pragma unroll
            for (int k = 0; k < 4; ++k) { tw[k] /= s; tp[k] = atomicAdd((int*)&lcnt[te[k]], 1); }
        }
        __syncthreads();
        if (tid < 32) { const int n = lcnt[tid]; gb[tid] = n > 0 ? (int)atomicAdd(CNT + tid, (unsigned)n) : 0; }
        __syncthreads();
        if (tid < 32) { const int m = blk * 32 + tid;
#pragma unroll
            for (int k = 0; k < 4; ++k) { C.p<int>(WS_TOKE)[m * 4 + k] = te[k]; C.p<int>(WS_TOKP)[m * 4 + k] = gb[te[k]] + tp[k]; C.p<float>(WS_TOKW)[m * 4 + k] = tw[k]; } }
        __syncthreads();
    }
}
__device__ __forceinline__ int moe_offsets(const Ctx& C, int l, bool tiles) {
    LAS int* offs = (LAS int*)(C.lds + LC_OFFS); LAS unsigned char* tile_e = (LAS unsigned char*)(C.lds + LC_TILE);
    unsigned* CNT = C.p<unsigned>(WS_CTL) + CW_CNT + l * 32;
    __syncthreads();
    if (C.tid == 0) { int o = 0; for (int e = 0; e < 32; ++e) { offs[e] = o; const int n = (int)__hip_atomic_load(CNT + e, __ATOMIC_RELAXED, __HIP_MEMORY_SCOPE_AGENT); o += (n + 255) & ~255; } offs[32] = o; }
    __syncthreads();
    const int tt = offs[32] >> 8;
    if (tiles) { for (int t = C.tid; t < tt; t += 512) { int e = 0; while (e < 31 && offs[e + 1] <= t * 256) ++e; tile_e[t] = (unsigned char)e; } __syncthreads(); }
    return tt;
}
__device__ __forceinline__ void phase_slots(const Ctx& C, int l, int ntok) {
    moe_offsets(C, l, false);
    LAS int* offs = (LAS int*)(C.lds + LC_OFFS);
    unsigned* CNT = C.p<unsigned>(WS_CTL) + CW_CNT + l * 32;
    const int gw = blockIdx.x * 8 + C.wave, NGW = C.G * 8;
    for (int idx = gw; idx < ntok * 4; idx += NGW) {
        const int e = C.p<int>(WS_TOKE)[idx], slot = offs[e] + C.p<int>(WS_TOKP)[idx];
        if (C.lane == 0) C.p<int>(WS_SLOT)[idx] = slot;
        const u32x4* src = (const u32x4*)(C.p<bf16_t>(WS_HN) + (size_t)(idx >> 2) * D); u32x4* dst = (u32x4*)(C.p<bf16_t>(WS_XS) + (size_t)slot * D);
        const u32x4 a = src[C.lane], b = src[C.lane + 64]; dst[C.lane] = a; dst[C.lane + 64] = b;
    }
    for (int e = 0; e < 32; ++e) { const int n = (int)__hip_atomic_load(CNT + e, __ATOMIC_RELAXED, __HIP_MEMORY_SCOPE_AGENT), p0 = offs[e] + n, p1 = offs[e + 1];
        for (int r = p0 + gw; r < p1; r += NGW) { u32x4* dst = (u32x4*)(C.p<bf16_t>(WS_XS) + (size_t)r * D); const u32x4 z = (u32x4){0u, 0u, 0u, 0u}; dst[C.lane] = z; dst[C.lane + 64] = z; } }
}
__device__ __forceinline__ void phase_final(const Ctx& C) {
    const int gw = blockIdx.x * 8 + C.wave, NGW = C.G * 8;
    for (int m = gw; m < NLAT; m += NGW) {
        f32x4 v[4]; load_row(C, false, m, true, DEPTH - 1, v);
        const float rstd = row_rstd(v);
#pragma unroll
        for (int j = 0; j < 4; ++j) { const int c = 4 * C.lane + 256 * j; *(f32x4*)(C.out + (size_t)m * D + c) = v[j] * rstd * *(const f32x4*)(C.in(35) + c); }
    }
}

__device__ __forceinline__ void phase_s5carry_ol(const Ctx& C, int l) {
    if (C.tid < 256) {
        for (int gid = blockIdx.x * 256 + C.tid; gid < 65536; gid += C.G * 256) {
            const int p = gid & 63, dr = (gid >> 6) & 1, g = (gid >> 7) & 31, b = gid >> 12;
            const f32x2 dec = *(const f32x2*)(C.p<float>(WS_DEC) + (((size_t)(l * 2 + dr) * 32 + g) * 64 + p) * 2);
            float hr = 0.f, hi = 0.f;
#pragma unroll 8
            for (int k = 0; k < NCH; ++k) {
                const int cidx = dr == 0 ? k : (k < 16 ? 15 - k : 159 - k);
                const size_t rg = (size_t)(b * NCH + cidx) * 32 + g;
                const float* s = C.p<float>(WS_SB) + rg * 256 + dr * 128 + p; bf16_t* a3 = C.p<bf16_t>(WS_A3) + rg * 512 + 256 + dr * 128 + p;
                const float sr = s[0], si = s[64];
                a3[0] = f2bf(hr); a3[64] = f2bf(hi);
                const float nr = dec.x * hr - dec.y * hi + sr, ni = dec.x * hi + dec.y * hr + si; hr = nr; hi = ni;
            }
        }
    }
    const size_t n8 = (size_t)NTOK * D / 8;
    for (size_t i = (size_t)blockIdx.x * 512 + C.tid; i < n8; i += (size_t)C.G * 512) {
        f32x4 g0, g1, f0, f1, b0, b1; unpack8(((const u32x4*)C.p<bf16_t>(WS_GG))[i], g0, g1); unpack8(((const u32x4*)C.p<bf16_t>(WS_HF))[i], f0, f1); unpack8(((const u32x4*)C.p<bf16_t>(WS_HB))[i], b0, b1);
        ((u32x4*)C.p<bf16_t>(WS_OL))[i] = pack8(g0 * (f0 + b0), g1 * (f1 + b1));
    }
}

__device__ __forceinline__ int lru_row(int b, bool isctx, int p) { return isctx ? NLAT + b * 256 + p : b * 2048 + (p & 31) * 64 + (p >> 5); }
__device__ __forceinline__ void phase_lru(const Ctx& C, int l) {
    const int tid = C.tid, dir = tid >> 8, lt = tid & 255, lw = (tid >> 6) & 3, lane = tid & 63;
    LAS unsigned char* R = C.lds + dir * 65536;
    LAS unsigned char* XT = R;
    LAS unsigned char* XC = R + 8704;
    LAS float* GT = (LAS float*)(R + 17920);
    LAS float* SEG = (LAS float*)(R + 51712);
    const bf16_t* XR = C.p<bf16_t>(WS_XR); bf16_t* HOUT = C.p<bf16_t>(dir ? WS_HB : WS_HF);
    for (int task = blockIdx.x; task < 256; task += C.G) {
        const int b = task >> 4, n = task & 15;
        const int c = lt & 63, seg = lt >> 6;
        const float lam = C.in(21)[(size_t)(l * 2 + dir) * D + n * 64 + c];
        const float coef = -8.0f * log1pf(__expf(-lam));
        const int c2 = lt & 31, pg = lt >> 5;
        float cw[4][2], cb[2];
#pragma unroll
        for (int j = 0; j < 4; ++j) { cw[j][0] = C.in(19)[((size_t)l * 4 + j) * D + n * 64 + 2 * c2]; cw[j][1] = C.in(19)[((size_t)l * 4 + j) * D + n * 64 + 2 * c2 + 1]; }
        cb[0] = C.in(20)[(size_t)l * D + n * 64 + 2 * c2]; cb[1] = C.in(20)[(size_t)l * D + n * 64 + 2 * c2 + 1];
        const int gcol = (lw & 1) * 32 + (lane & 31);
        const float* Wg = (lw < 2 ? C.in(22) : C.in(24)) + ((size_t)((l * 2 + dir) * 16 + n) * 64) * 64;
        bf16x8 bfr[4];
#pragma unroll
        for (int s = 0; s < 4; ++s) {
            unsigned w[4];
#pragma unroll
            for (int jj = 0; jj < 4; ++jj) { const int k = 16 * s + 8 * (lane >> 5) + 2 * jj; w[jj] = cvt_pk_bf16(Wg[(size_t)k * 64 + gcol], Wg[(size_t)(k + 1) * 64 + gcol]); }
            u32x4 t = (u32x4){w[0], w[1], w[2], w[3]}; bfr[s] = __builtin_bit_cast(bf16x8, t);
        }
        const float bias_g = (lw < 2 ? C.in(23) : C.in(25))[(size_t)(l * 2 + dir) * D + n * 64 + gcol];
        float hrun = 0.f;
        u32x4 pf[3];
        auto issue_tile = [&](int it) {
            const bool isctx = it < 4; const int p0 = dir == 0 ? (isctx ? 64 * it : 64 * (it - 4)) : (isctx ? 64 * (3 - it) : 64 * (35 - it)); const int slen = isctx ? 256 : 2048;
#pragma unroll
            for (int r = 0; r < 3; ++r) { const int q = lt + 256 * r, rr = q >> 3, pc = q & 7, p = p0 - 1 + rr;
                pf[r] = (u32x4){0u, 0u, 0u, 0u};
                if (rr < 67 && p >= 0 && p < slen) pf[r] = *(const u32x4*)(XR + (size_t)lru_row(b, isctx, p) * D + n * 64 + pc * 8); }
        };
        issue_tile(0);
#pragma unroll 1
        for (int it = 0; it < 36; ++it) {
            const bool isctx = it < 4; const int p0 = dir == 0 ? (isctx ? 64 * it : 64 * (it - 4)) : (isctx ? 64 * (3 - it) : 64 * (35 - it));
#pragma unroll
            for (int r = 0; r < 3; ++r) { const int q = lt + 256 * r, rr = q >> 3, pc = q & 7; if (rr < 67) *(LAS u32x4*)(XT + rr * 128 + pc * 16) = pf[r]; }
            __syncthreads();
            if (it + 1 < 36) issue_tile(it + 1);
            {
                float x0[11], x1[11];
#pragma unroll
                for (int r = 0; r < 11; ++r) { const unsigned w = *(const LAS unsigned*)(XT + (8 * pg + r) * 128 + c2 * 4); x0[r] = bflo(w); x1[r] = bfhi(w); }
#pragma unroll
                for (int q = 0; q < 8; ++q) { float y0 = cb[0], y1 = cb[1];
#pragma unroll
                    for (int j = 0; j < 4; ++j) { y0 += cw[j][0] * x0[q + j]; y1 += cw[j][1] * x1[q + j]; }
                    *(LAS unsigned*)(XC + (8 * pg + q) * 144 + c2 * 4) = cvt_pk_bf16(y0, y1); }
            }
            __syncthreads();
            {
                f32x16 acc0, acc1;
#pragma unroll
                for (int q = 0; q < 16; ++q) { acc0[q] = 0.f; acc1[q] = 0.f; }
#pragma unroll
                for (int s = 0; s < 4; ++s) {
                    const bf16x8 a0 = *(const LAS bf16x8*)(XC + (lane & 31) * 144 + (16 * s + 8 * (lane >> 5)) * 2);
                    const bf16x8 a1 = *(const LAS bf16x8*)(XC + (32 + (lane & 31)) * 144 + (16 * s + 8 * (lane >> 5)) * 2);
                    acc0 = __builtin_amdgcn_mfma_f32_32x32x16_bf16(a0, bfr[s], acc0, 0, 0, 0);
                    acc1 = __builtin_amdgcn_mfma_f32_32x32x16_bf16(a1, bfr[s], acc1, 0, 0, 0);
                }
#pragma unroll
                for (int q = 0; q < 16; ++q) { const int rowq = (q & 3) + 8 * (q >> 2) + 4 * (lane >> 5);
                    GT[rowq * 132 + lw * 32 + (lane & 31)] = acc0[q] + bias_g; GT[(32 + rowq) * 132 + lw * 32 + (lane & 31)] = acc1[q] + bias_g; }
            }
            __syncthreads();
            float av[16], bv[16]; float P = 1.f, H = 0.f;
#pragma unroll
            for (int i = 0; i < 16; ++i) { const int s = 16 * seg + i, q = dir ? 63 - s : s;
                const float r = sigmoidf_(GT[q * 132 + c]), ig = sigmoidf_(GT[q * 132 + 64 + c]), xc = bf2f(*(const LAS unsigned short*)(XC + q * 144 + c * 2));
                const float la = coef * r, a = __expf(la), bb = sqrtf(-expm1f(2.0f * la)) * (ig * xc);
                av[i] = a; bv[i] = bb; P *= a; H = a * H + bb; }
            SEG[(seg * 64 + c) * 2] = P; SEG[(seg * 64 + c) * 2 + 1] = H;
            __syncthreads();
            float carry = hrun, mine = 0.f;
#pragma unroll
            for (int s2 = 0; s2 < 4; ++s2) { if (s2 == seg) mine = carry; carry = SEG[(s2 * 64 + c) * 2] * carry + SEG[(s2 * 64 + c) * 2 + 1]; }
            hrun = carry;
            float h = mine;
#pragma unroll
            for (int i = 0; i < 16; ++i) { const int s = 16 * seg + i, q = dir ? 63 - s : s; h = av[i] * h + bv[i];
                HOUT[(size_t)lru_row(b, isctx, p0 + q) * D + n * 64 + c] = f2bf(h); }
        }
        __syncthreads();
    }
}

__global__ void __launch_bounds__(512, 2) fwd_kernel(Args args) {
    extern __shared__ __attribute__((aligned(16))) unsigned char lds_raw[];
    Ctx C0; C0.out = args.out; C0.ws = args.ws; C0.lds = (LAS unsigned char*)lds_raw;
    C0.tid = threadIdx.x; C0.lane = C0.tid & 63; C0.wave = __builtin_amdgcn_readfirstlane(C0.tid >> 6); C0.G = gridDim.x;
    for (int u = C0.tid; u < (LDS_BYTES - LDS_CTL) / 4; u += 512) ((LAS unsigned*)(C0.lds + LDS_CTL))[u] = 0u;
    __syncthreads();
    if (C0.tid < 36) { const unsigned long long pv = (unsigned long long)args.in[C0.tid]; LAS unsigned* t = (LAS unsigned*)(C0.lds + LC_PTRS) + 2 * C0.tid; t[0] = (unsigned)pv; t[1] = (unsigned)(pv >> 32); }
    __syncthreads();
    const Ctx& C = C0;
    XcdBarrier bar = xcd_barrier_post(C.p<unsigned>(WS_CTL) + CW_BAR, (volatile LAS unsigned*)(C.lds + LC_MISC) + 8);
    const int lo = args.ph_lo, hi = args.ph_hi;
    int ph = 0;
#ifndef PHMASK
#define PHMASK 0xffffffffu
#endif
#define PH_ON(id) (((PHMASK) >> (id)) & 1u)
#define PHASE_BEGIN(id) if (PH_ON(id) && lo <= ph && ph < hi) { Ctx C = C0; asm volatile("" : "+s"(C.ws), "+s"(C.out), "+v"(C.tid)); C.lane = C.tid & 63; C.wave = __builtin_amdgcn_readfirstlane(C.tid >> 6);
#define PHASE_END(last) if (ph + 1 < hi && !(last)) xcd_barrier(bar); } ++ph;
#define PHASE_JOIN __syncthreads(); }
    const int cid = (int)blockIdx.x;

    PHASE_BEGIN(0)
        phase_transposes(C);
        __syncthreads();
        phase_s5prep(C);
        phase_ada(C);
    PHASE_END(false)

#pragma unroll 1
    for (int l = 0; l < DEPTH; ++l) {
        const int nMtok = (l == DEPTH - 1) ? 128 : 144;
        const int ntok = nMtok * 256;
        PHASE_BEGIN(1) phase_norm1(C, l); PHASE_END(false)
        PHASE_BEGIN(2)
            pg8::Gemm g{D, D, D}; SchedGrid S; S.so.init(144, 18, C.G, cid); S.A = (const char*)C.p<bf16_t>(WS_HN); S.B = (const char*)(C.p<bf16_t>(WS_WINT) + (size_t)l * INW * D); S.atile = (size_t)256 * D * 2; S.btile = (size_t)256 * D * 2;
            EpiInProj E{C.p<bf16_t>(WS_A3), C.p<bf16_t>(WS_XR), C.p<bf16_t>(WS_GG), C.p<bf16_t>(WS_M5), C.p<bf16_t>(WS_ML)};
            pg8::gemm_phase(C.lds, C.tid, g, S, E);
        PHASE_END(false)
        PHASE_BEGIN(3)
            pg8::Gemm g{16384, 256, 256}; SchedS5 S{C.G, cid, (const char*)C.p<bf16_t>(WS_A3), (const char*)(C.p<bf16_t>(WS_FT) + (size_t)l * 32 * 256 * 256), (size_t)256 * 256 * 2};
            EpiS5L1 E{C.p<float>(WS_SB)};
            pg8::gemm_phase(C.lds, C.tid, g, S, E);
        PHASE_JOIN
        PHASE_BEGIN(15) phase_lru(C, l); PHASE_END(false)
        PHASE_BEGIN(4) phase_s5carry_ol(C, l); PHASE_END(false)
        PHASE_BEGIN(5)
            pg8::Gemm g{16384, 512, 512}; SchedS5 S{C.G, cid, (const char*)C.p<bf16_t>(WS_A3), (const char*)(C.p<bf16_t>(WS_W3T) + (size_t)l * 32 * 256 * 512), (size_t)256 * 512 * 2};
            EpiS5Y E{C.p<bf16_t>(WS_GY)};
            pg8::gemm_phase(C.lds, C.tid, g, S, E);
        PHASE_END(false)
        PHASE_BEGIN(6)
            pg8::Gemm g{512, 512, 512}; SchedGrid S; S.so.init(nMtok, 2, C.G, cid); S.A = (const char*)C.p<bf16_t>(WS_GY); S.B = (const char*)(C.p<bf16_t>(WS_WGLUT) + (size_t)l * 512 * 512); S.atile = (size_t)256 * 512 * 2; S.btile = (size_t)256 * 512 * 2;
            EpiGlu E{C.p<bf16_t>(WS_GY), C.p<bf16_t>(WS_O5), C.in(18) + (size_t)l * 512};
            pg8::gemm_phase(C.lds, C.tid, g, S, E);
        PHASE_END(false)
        PHASE_BEGIN(7)
            pg8::Gemm g{512, 512, 512}; SchedGrid S; S.so.init(nMtok, 4, C.G, cid); S.A = (const char*)C.p<bf16_t>(WS_O5); S.B = (const char*)(C.p<bf16_t>(WS_WP5T) + (size_t)l * D * 512); S.atile = (size_t)256 * 512 * 2; S.btile = (size_t)256 * 512 * 2;
            EpiMulGate E{C.p<bf16_t>(WS_M5), nullptr, C.p<bf16_t>(WS_T1)};
            pg8::gemm_phase(C.lds, C.tid, g, S, E);
        PHASE_END(false)
        PHASE_BEGIN(8)
            pg8::Gemm g{D, D, D}; SchedGrid S; S.so.init(nMtok, 4, C.G, cid); S.A = (const char*)C.p<bf16_t>(WS_OL); S.B = (const char*)(C.p<bf16_t>(WS_WPLT) + (size_t)l * D * D); S.atile = (size_t)256 * D * 2; S.btile = (size_t)256 * D * 2;
            EpiMulGate E{C.p<bf16_t>(WS_ML), C.p<bf16_t>(WS_T1), C.p<bf16_t>(WS_MG)};
            pg8::gemm_phase(C.lds, C.tid, g, S, E);
        PHASE_END(false)
        PHASE_BEGIN(9)
            pg8::Gemm g{D, D, D}; SchedGrid S; S.so.init(nMtok, 4, C.G, cid); S.A = (const char*)C.p<bf16_t>(WS_MG); S.B = (const char*)(C.p<bf16_t>(WS_WOUTT) + (size_t)l * D * D); S.atile = (size_t)256 * D * 2; S.btile = (size_t)256 * D * 2;
            EpiOut E{l == 0 ? C.in(0) : C.p<float>(WS_X), l == 0 ? C.in(2) : C.p<float>(WS_X) + (size_t)NLAT * D, C.p<float>(WS_X), C.p<float>(WS_ADA), l};
            pg8::gemm_phase(C.lds, C.tid, g, S, E);
        PHASE_END(false)
        PHASE_BEGIN(10) phase_norm2(C, l, ntok); PHASE_END(false)
        PHASE_BEGIN(11) phase_slots(C, l, ntok); PHASE_END(false)
        PHASE_BEGIN(12)
            const int tt = moe_offsets(C, l, true);
            pg8::Gemm g{D, D, D}; SchedMoe S; S.so.init(tt, 8, C.G, cid); S.A = (const char*)C.p<bf16_t>(WS_XS); S.B = (const char*)(C.p<bf16_t>(WS_WUPT) + (size_t)l * NEXP * 2048 * D);
            S.atile = (size_t)256 * D * 2; S.btile = (size_t)256 * D * 2; S.bexp = (size_t)2048 * D * 2; S.tile_e = (const LAS unsigned char*)(C.lds + LC_TILE);
            EpiUp E{C.p<bf16_t>(WS_ACT), C.in(32) + (size_t)l * NEXP * 2048};
            pg8::gemm_phase(C.lds, C.tid, g, S, E);
        PHASE_END(false)
        PHASE_BEGIN(13)
            const int tt = moe_offsets(C, l, true);
            pg8::Gemm g{D, D, D}; SchedMoe S; S.so.init(tt, 4, C.G, cid); S.A = (const char*)C.p<bf16_t>(WS_ACT); S.B = (const char*)(C.p<bf16_t>(WS_WDNT) + (size_t)l * NEXP * D * D);
            S.atile = (size_t)256 * D * 2; S.btile = (size_t)256 * D * 2; S.bexp = (size_t)D * D * 2; S.tile_e = (const LAS unsigned char*)(C.lds + LC_TILE);
            EpiDown E{C.p<bf16_t>(WS_Y), C.in(34) + (size_t)l * NEXP * D};
            pg8::gemm_phase(C.lds, C.tid, g, S, E);
        PHASE_END(false)
    }
    PHASE_BEGIN(14) phase_final(C); PHASE_END(true)
}

constexpr int N_PHASES = 1 + DEPTH * 13 + 1;
extern "C" void kernel_launch(void* const* d_in, const int* in_sizes, int n_in, void* d_out, int out_size, void* d_ws, size_t ws_size, hipStream_t stream) {
    static int grid = 0;
    if (grid == 0) {
        if (n_in != 36 || ws_size < WS_END) { fprintf(stderr, "kernel_launch: need 36 inputs and >= %zu bytes of workspace; got %d, %zu\n", (size_t)WS_END, n_in, ws_size); grid = -1; return; }
        int dev = 0, cus = 0, per_cu = 0;
        if (hipGetDevice(&dev) != hipSuccess || hipDeviceGetAttribute(&cus, hipDeviceAttributeMultiprocessorCount, dev) != hipSuccess) { grid = -1; return; }
        if (hipFuncSetAttribute((const void*)fwd_kernel, hipFuncAttributeMaxDynamicSharedMemorySize, LDS_BYTES) != hipSuccess) { fprintf(stderr, "kernel_launch: hipFuncSetAttribute failed\n"); grid = -1; return; }
        if (hipOccupancyMaxActiveBlocksPerMultiprocessor(&per_cu, (const void*)fwd_kernel, 512, LDS_BYTES) != hipSuccess || per_cu < 1) fprintf(stderr, "kernel_launch: occupancy query says %d\n", per_cu);
        (void)hipGetLastError();
        grid = cus;
    }
    if (grid < 0) return;
    (void)hipMemsetAsync((char*)d_ws + WS_CTL, 0, CTL_ZERO_BYTES, stream);
    Args a{};
    for (int i = 0; i < 36; ++i) a.in[i] = (const float*)d_in[i];
    a.out = (float*)d_out; a.ws = (unsigned char*)d_ws;
#ifndef MK_SPLIT
    a.ph_lo = 0; a.ph_hi = N_PHASES;
    hipLaunchKernelGGL(fwd_kernel, dim3(grid), dim3(512), LDS_BYTES, stream, a);
#else
    for (int p = 0; p < N_PHASES; ++p) { a.ph_lo = p; a.ph_hi = p + 1; hipLaunchKernelGGL(fwd_kernel, dim3(grid), dim3(512), LDS_BYTES, stream, a); }
#endif
}
```

```cpp
#include <hip/hip_runtime.h>
#include <cstdio>
#include <cstdint>

#define LAS __attribute__((address_space(3)))
typedef unsigned short bf16_t;
typedef short bf16x8 __attribute__((ext_vector_type(8)));
typedef float f32x4 __attribute__((ext_vector_type(4)));
typedef float f32x2 __attribute__((ext_vector_type(2)));
typedef float f32x16 __attribute__((ext_vector_type(16)));
typedef unsigned u32x4 __attribute__((ext_vector_type(4)));
typedef unsigned u32x2 __attribute__((ext_vector_type(2)));

constexpr int D = 1024, NB = 16, SEQ = 2048, CTXL = 256, DEPTH = 4;
constexpr int NLAT = NB * SEQ, NCTX = NB * CTXL, NTOK = NLAT + NCTX;
constexpr int INW = 4608, NEXP = 32;
constexpr int NCH = 144;
constexpr int NROW3 = NB * NCH;
constexpr int MAXSLOT = NTOK * 4 + NEXP * 256;

__device__ __forceinline__ float bf2f(unsigned short b) { return __uint_as_float(((unsigned)b) << 16); }
__device__ __forceinline__ float bflo(unsigned w) { return __uint_as_float(w << 16); }
__device__ __forceinline__ float bfhi(unsigned w) { return __uint_as_float(w & 0xffff0000u); }
__device__ __forceinline__ unsigned cvt_pk_bf16(float lo, float hi) { unsigned r; asm volatile("v_cvt_pk_bf16_f32 %0, %1, %2" : "=v"(r) : "v"(lo), "v"(hi)); return r; }
__device__ __forceinline__ unsigned short f2bf(float f) { return (unsigned short)(cvt_pk_bf16(f, 0.f) & 0xffffu); }
__device__ __forceinline__ float sigmoidf_(float x) { return 1.0f / (1.0f + __expf(-x)); }
__device__ __forceinline__ float gelu_tanh(float x) { const float z = 1.5957691216f * (x + 0.044715f * x * x * x); return x / (1.0f + __expf(-z)); }
__device__ __forceinline__ float wave_sum(float v) {
#pragma unroll
    for (int o = 1; o < 64; o <<= 1) v += __shfl_xor(v, o);
    return v;
}

namespace pg8 {
constexpr int BM = 256, BK = 64, HALF = 128, HTB = HALF * BK * 2, STAGE_BYTES = 8 * HTB, NXCD = 8, WGM = 8;
__host__ __device__ __forceinline__ int lds_byte(int r, int c) { const int st = (r >> 4) * 2 + (c >> 5), rr = r & 15, cc = c & 31, ob = rr * 64 + cc * 2; return st * 1024 + (ob ^ (((ob >> 9) & 1) << 5)); }
__host__ __device__ __forceinline__ void stage_rc(int b, int& R, int& C) { const int st = b / 1024, sb = b % 1024, swz = sb ^ (((sb >> 9) & 1) << 5); R = (st >> 1) * 16 + swz / 64; C = (st & 1) * 32 + (swz % 64) / 2; }
__host__ __device__ __forceinline__ int perm32(int rho) { const int n = rho >> 4, i = rho & 15; return 8 * (i >> 2) + 4 * n + (i & 3); }

struct Unit { int pm, pn, grp; const char* a; const char* b; };
struct Gemm { int lda, ldb, K; };

struct StaticOrder {
    int nM, nN, nwg, G, c;
    __device__ void init(int nM_, int nN_, int G_, int c_) { nM = nM_; nN = nN_; nwg = nM * nN; G = G_; c = c_; }
    __device__ bool next(int i, int& pm, int& pn) const {
        const long L = (long)i * G + c; if (L >= nwg) return false;
        int wgid = (int)L; { const int q = nwg / NXCD, r = nwg % NXCD, xcd = wgid % NXCD, off = wgid / NXCD; wgid = (xcd < r ? xcd * (q + 1) : r * (q + 1) + (xcd - r) * q) + off; }
        const int nig = WGM * nN, gid = wgid / nig, fm = gid * WGM, gsz = (nM - fm) < WGM ? (nM - fm) : WGM;
        pm = fm + ((wgid % nig) % gsz); pn = (wgid % nig) / gsz; return true;
    }
};

template <class Epi, class Sched>
__device__ __forceinline__ void gemm_phase(LAS unsigned char* lds, const int tid, const Gemm g, const Sched& S, const Epi& E) {
    const int wid = __builtin_amdgcn_readfirstlane(tid >> 6), lane = tid & 63, wr = wid >> 2, wc = wid & 3, fr = lane & 15, fq = lane >> 4;
    const int K = g.K, nt = K / BK;
    unsigned voffA[2], voffB[2];
#pragma unroll
    for (int i = 0; i < 2; ++i) { int R, C; stage_rc(tid * 16 + i * 8192, R, C); const int Rb = Epi::PERM ? ((R & ~31) + perm32(R & 31)) : R;
        voffA[i] = (unsigned)(R * g.lda + C) * 2u; voffB[i] = (unsigned)(Rb * g.ldb + C) * 2u; }
    const size_t kstep = (size_t)(BK * 2);
    const size_t hstepA = (size_t)HALF * g.lda * 2, hstepB = (size_t)HALF * g.ldb * 2;
    const unsigned ldsw = (unsigned)wid * 1024u;
    const int aoff = lds_byte(wr * 64 + fr, fq * 8), boff = lds_byte(wc * 32 + fr, fq * 8);
#define PG8_SA(b, h) (((b) * 2 + (h)) * HTB)
#define PG8_SB(b, h) ((4 + (b) * 2 + (h)) * HTB)
#define PG8_STAGE(bufoff, gbase, voff) do { _Pragma("unroll") for (int _i = 0; _i < 2; ++_i) \
        __builtin_amdgcn_global_load_lds((const unsigned*)((const char*)(gbase) + (voff)[_i]), (LAS unsigned*)(lds + (bufoff) + ldsw + _i * 8192), 16, 0, 0); } while (0)
#define PG8_LDA(dst, b, h) do { _Pragma("unroll") for (int m = 0; m < 4; ++m) _Pragma("unroll") for (int k = 0; k < 2; ++k) dst[m][k] = *(const LAS bf16x8*)(lds + PG8_SA(b, h) + aoff + m * 2048 + k * 1024); } while (0)
#define PG8_LDB(dst, b, h) do { _Pragma("unroll") for (int n = 0; n < 2; ++n) _Pragma("unroll") for (int k = 0; k < 2; ++k) dst[n][k] = *(const LAS bf16x8*)(lds + PG8_SB(b, h) + boff + n * 2048 + k * 1024); } while (0)
#define PG8_MMA(ai, bj, At, Bt) do { __builtin_amdgcn_s_setprio(1); _Pragma("unroll") for (int m = 0; m < 4; ++m) _Pragma("unroll") for (int n = 0; n < 2; ++n) _Pragma("unroll") for (int k = 0; k < 2; ++k) \
        acc[ai][bj][m][n] = __builtin_amdgcn_mfma_f32_16x16x32_bf16(Bt[n][k], At[m][k], acc[ai][bj][m][n], 0, 0, 0); __builtin_amdgcn_s_setprio(0); } while (0)
#define PG8_WAIT_V(n) asm volatile("s_waitcnt vmcnt(" #n ")" ::: "memory")
#define PG8_WAIT_L(n) asm volatile("s_waitcnt lgkmcnt(" #n ")" ::: "memory")
#define PG8_BAR __builtin_amdgcn_s_barrier()
#define PG8_SCHED __builtin_amdgcn_sched_barrier(0)
    Unit cur, nxt; int ui = 0;
    if (!S.next(0, cur)) return;
    f32x4 acc[2][2][4][2];
#pragma unroll
    for (int a = 0; a < 2; ++a)
#pragma unroll
        for (int b = 0; b < 2; ++b)
#pragma unroll
            for (int m = 0; m < 4; ++m)
#pragma unroll
                for (int n = 0; n < 2; ++n) acc[a][b][m][n] = (f32x4){0.f, 0.f, 0.f, 0.f};
    bf16x8 At[4][2], B0[2][2], B1[2][2];
    const char* cA = cur.a; const char* cB = cur.b;
    PG8_STAGE(PG8_SB(0, 0), cB, voffB); PG8_STAGE(PG8_SB(0, 1), cB + hstepB, voffB); PG8_STAGE(PG8_SA(0, 0), cA, voffA); PG8_STAGE(PG8_SA(0, 1), cA + hstepA, voffA);
    if (wr == 1) PG8_BAR;
    PG8_WAIT_V(2); PG8_BAR;
    PG8_STAGE(PG8_SB(1, 0), cB + kstep, voffB); PG8_STAGE(PG8_SA(1, 0), cA + kstep, voffA); PG8_STAGE(PG8_SB(1, 1), cB + hstepB + kstep, voffB);
    PG8_WAIT_V(6); PG8_BAR;
    for (;;) {
        const bool has_next = S.next(ui + 1, nxt);
        const char* nA = has_next ? nxt.a : cA; const char* nB = has_next ? nxt.b : cB;
#pragma unroll 1
        for (int t = 0; t < nt; t += 2) {
            const bool last = (t == nt - 2);
            const char* a1 = cA + (size_t)(t + 1) * kstep;
            const char* a2 = last ? nA : cA + (size_t)(t + 2) * kstep; const char* b2 = last ? nB : cB + (size_t)(t + 2) * kstep;
            const char* a3 = a2 + kstep; const char* b3 = b2 + kstep;
            PG8_LDB(B0, 0, 0); PG8_LDB(B1, 0, 1); PG8_SCHED; PG8_LDA(At, 0, 0); PG8_STAGE(PG8_SA(1, 1), a1 + hstepA, voffA);
            PG8_WAIT_V(8); PG8_WAIT_L(0); PG8_BAR; PG8_MMA(0, 0, At, B0); PG8_MMA(0, 1, At, B1); PG8_BAR; PG8_SCHED;
            PG8_LDA(At, 0, 1); PG8_STAGE(PG8_SB(0, 0), b2, voffB); PG8_STAGE(PG8_SB(0, 1), b2 + hstepB, voffB); PG8_STAGE(PG8_SA(0, 0), a2, voffA);
            PG8_WAIT_V(8); PG8_WAIT_L(0); PG8_BAR; PG8_MMA(1, 0, At, B0); PG8_MMA(1, 1, At, B1); PG8_BAR; PG8_SCHED;
            PG8_LDB(B0, 1, 0); PG8_LDB(B1, 1, 1); PG8_SCHED; PG8_LDA(At, 1, 0); PG8_STAGE(PG8_SA(0, 1), a2 + hstepA, voffA);
            PG8_WAIT_V(8); PG8_WAIT_L(0); PG8_BAR; PG8_MMA(0, 0, At, B0); PG8_MMA(0, 1, At, B1); PG8_BAR; PG8_SCHED;
            PG8_LDA(At, 1, 1); PG8_STAGE(PG8_SB(1, 0), b3, voffB); PG8_STAGE(PG8_SB(1, 1), b3 + hstepB, voffB); PG8_STAGE(PG8_SA(1, 0), a3, voffA);
            PG8_WAIT_V(8); PG8_WAIT_L(0); PG8_BAR; PG8_MMA(1, 0, At, B0); PG8_MMA(1, 1, At, B1); PG8_BAR; PG8_SCHED;
        }
        if (wr == 0) PG8_BAR;
        E(acc, cur, wr, wc, fr, fq);
        if (!has_next) break;
#pragma unroll
        for (int a = 0; a < 2; ++a)
#pragma unroll
            for (int b = 0; b < 2; ++b)
#pragma unroll
                for (int m = 0; m < 4; ++m)
#pragma unroll
                    for (int n = 0; n < 2; ++n) acc[a][b][m][n] = (f32x4){0.f, 0.f, 0.f, 0.f};
        cur = nxt; cA = nA; cB = nB; ++ui;
        if (wr == 1) PG8_BAR;
    }
    PG8_WAIT_V(0);
    PG8_BAR;
#undef PG8_SA
#undef PG8_SB
#undef PG8_STAGE
#undef PG8_LDA
#undef PG8_LDB
#undef PG8_MMA
#undef PG8_WAIT_V
#undef PG8_WAIT_L
#undef PG8_BAR
#undef PG8_SCHED
}
}
using pg8::Unit;

#define XB_TMO      128
#define XB_XCNT(j)  (256  + 64 * (j))
#define XB_XSUB(j)  (1280 + 64 * (j))
#define XB_XGEN(j)  (2304 + 64 * (j))
#define XB_TOP      3328
#define XB_TOPGEN   3392
#define XCD_BAR_WORDS 3456
#define XB_SPIN_CAP (1u << 18)
__device__ __forceinline__ unsigned xb_ld(unsigned* p)              { return __hip_atomic_load(p, __ATOMIC_RELAXED, __HIP_MEMORY_SCOPE_AGENT); }
__device__ __forceinline__ unsigned xb_add(unsigned* p, unsigned v) { return __hip_atomic_fetch_add(p, v, __ATOMIC_RELAXED, __HIP_MEMORY_SCOPE_AGENT); }
__device__ __forceinline__ unsigned xb_xcc_id() { return (unsigned)__builtin_amdgcn_s_getreg((3 << 11) | 20) & 0xFu; }
#define XB_SPIN(cond, bar) do { unsigned _sp = 0; while (cond) { __builtin_amdgcn_s_sleep(1); \
    if ((++_sp & 255u) == 0u) { if (xb_ld(&(bar)[XB_TMO])) break; if (_sp > XB_SPIN_CAP) { atomicAdd(&(bar)[XB_TMO], 1u); break; } } } } while (0)
struct XcdBarrier { unsigned* bar; unsigned x; volatile LAS unsigned* st; };
__device__ __forceinline__ XcdBarrier xcd_barrier_post(unsigned* bar, volatile LAS unsigned* st) {
    XcdBarrier b; b.bar = bar; b.x = xb_xcc_id(); b.st = st;
    if (threadIdx.x == 0) (void)xb_add(&bar[XB_XCNT(b.x)], 1u);
    return b;
}
__device__ __forceinline__ void xcd_barrier_complete(unsigned* bar, unsigned x, unsigned& nloc, unsigned& nx) {
    const unsigned G = gridDim.x * gridDim.y * gridDim.z;
    unsigned sum, cnt, mine, sp = 0u;
    for (;;) {
        sum = 0u; cnt = 0u; mine = 0u;
#pragma unroll
        for (unsigned j = 0; j < 16; ++j) { const unsigned c = xb_ld(&bar[XB_XCNT(j)]); sum += c; cnt += (c > 0u) ? 1u : 0u; mine = (j == x) ? c : mine; }
        if (sum == G) break;
        __builtin_amdgcn_s_sleep(1);
        if ((++sp & 255u) == 0u) { if (xb_ld(&bar[XB_TMO])) break; if (sp > XB_SPIN_CAP) { atomicAdd(&bar[XB_TMO], 1u); break; } }
    }
    nloc = mine > 0u ? mine : 1u; nx = cnt > 0u ? cnt : 1u;
}
__device__ __forceinline__ void xcd_barrier(const XcdBarrier& b) {
    asm volatile("s_waitcnt vmcnt(0)" ::: "memory");
    __syncthreads();
    if (threadIdx.x == 0) {
        unsigned* bar = b.bar;
        __builtin_amdgcn_s_waitcnt(0);
        unsigned nloc = b.st[0], nx = b.st[1];
        if (nloc == 0u) { xcd_barrier_complete(bar, b.x, nloc, nx); b.st[0] = nloc; b.st[1] = nx; }
        const unsigned old = xb_add(&bar[XB_XSUB(b.x)], 1u);
        const unsigned gen = old / nloc;
        if (old + 1u == (gen + 1u) * nloc) {
            __builtin_amdgcn_fence(__ATOMIC_RELEASE, "agent");
            asm volatile("s_waitcnt vmcnt(0)" ::: "memory");
            const unsigned og = xb_add(&bar[XB_TOP], 1u);
            const unsigned tg = og / nx;
            if (og + 1u == (tg + 1u) * nx) xb_add(&bar[XB_TOPGEN], 1u);
            else XB_SPIN(xb_ld(&bar[XB_TOPGEN]) == tg, bar);
            __builtin_amdgcn_fence(__ATOMIC_ACQUIRE, "agent");
            xb_add(&bar[XB_XGEN(b.x)], 1u);
            asm volatile("s_waitcnt vmcnt(0)" ::: "memory");
        } else {
            XB_SPIN(xb_ld(&bar[XB_XGEN(b.x)]) == gen, bar);
            __builtin_amdgcn_fence(__ATOMIC_ACQUIRE, "agent");
            asm volatile("s_waitcnt vmcnt(0)" ::: "memory");
        }
    }
    __syncthreads();
}

constexpr size_t al256(size_t x) { return (x + 255) & ~(size_t)255; }
constexpr size_t WS_CTL = 0, CTL_ZERO_BYTES = 1u << 20;
constexpr int CW_CNT = 1024;
constexpr int CW_BAR = 4096;
constexpr size_t WS_ADA   = CTL_ZERO_BYTES;
constexpr size_t WS_DEC   = al256(WS_ADA + (size_t)DEPTH * 17 * 6144 * 4);
constexpr size_t WS_W3T   = al256(WS_DEC + (size_t)DEPTH * 2 * 32 * 64 * 2 * 4);
constexpr size_t WS_FT    = al256(WS_W3T + (size_t)DEPTH * 32 * 256 * 512 * 2);
constexpr size_t WS_WINT  = al256(WS_FT + (size_t)DEPTH * 32 * 256 * 256 * 2);
constexpr size_t WS_WGLUT = al256(WS_WINT + (size_t)DEPTH * INW * D * 2);
constexpr size_t WS_WP5T  = al256(WS_WGLUT + (size_t)DEPTH * 512 * 512 * 2);
constexpr size_t WS_WPLT  = al256(WS_WP5T + (size_t)DEPTH * D * 512 * 2);
constexpr size_t WS_WOUTT = al256(WS_WPLT + (size_t)DEPTH * D * D * 2);
constexpr size_t WS_WUPT  = al256(WS_WOUTT + (size_t)DEPTH * D * D * 2);
constexpr size_t WS_WDNT  = al256(WS_WUPT + (size_t)DEPTH * NEXP * 2048 * D * 2);
constexpr size_t WS_X     = al256(WS_WDNT + (size_t)DEPTH * NEXP * D * D * 2);
constexpr size_t WS_HN    = al256(WS_X + (size_t)NTOK * D * 4);
constexpr size_t WS_A3    = al256(WS_HN + (size_t)NTOK * D * 2);
constexpr size_t WS_SB    = al256(WS_A3 + (size_t)NROW3 * 32 * 512 * 2);
constexpr size_t WS_XR    = al256(WS_SB + (size_t)NROW3 * 32 * 256 * 4);
constexpr size_t WS_GG    = al256(WS_XR + (size_t)NTOK * D * 2);
constexpr size_t WS_M5    = al256(WS_GG + (size_t)NTOK * D * 2);
constexpr size_t WS_ML    = al256(WS_M5 + (size_t)NTOK * D * 2);
constexpr size_t WS_HF    = al256(WS_ML + (size_t)NTOK * D * 2);
constexpr size_t WS_HB    = al256(WS_HF + (size_t)NTOK * D * 2);
constexpr size_t WS_OL    = al256(WS_HB + (size_t)NTOK * D * 2);
constexpr size_t WS_GY    = al256(WS_OL + (size_t)NTOK * D * 2);
constexpr size_t WS_O5    = al256(WS_GY + (size_t)NTOK * 512 * 2);
constexpr size_t WS_T1    = al256(WS_O5 + (size_t)NTOK * 512 * 2);
constexpr size_t WS_MG    = al256(WS_T1 + (size_t)NTOK * D * 2);
constexpr size_t WS_TOKE  = al256(WS_MG + (size_t)NTOK * D * 2);
constexpr size_t WS_TOKP  = al256(WS_TOKE + (size_t)NTOK * 4 * 4);
constexpr size_t WS_TOKW  = al256(WS_TOKP + (size_t)NTOK * 4 * 4);
constexpr size_t WS_SLOT  = al256(WS_TOKW + (size_t)NTOK * 4 * 4);
constexpr size_t WS_XS    = al256(WS_SLOT + (size_t)NTOK * 4 * 4);
constexpr size_t WS_ACT   = al256(WS_XS + (size_t)MAXSLOT * D * 2);
constexpr size_t WS_Y     = al256(WS_ACT + (size_t)MAXSLOT * D * 2);
constexpr size_t WS_END   = al256(WS_Y + (size_t)MAXSLOT * D * 2);

constexpr int LDS_BYTES = 147456;
constexpr int LDS_CTL = 143360;
constexpr int LC_MISC = LDS_CTL;
constexpr int LC_OFFS = LDS_CTL + 256;
constexpr int LC_LCNT = LDS_CTL + 512;
constexpr int LC_GB   = LDS_CTL + 768;
constexpr int LC_TILE = LDS_CTL + 1024;
constexpr int LC_PTRS = LDS_CTL + 2048;

struct Args { const float* in[36]; float* out; unsigned char* ws; int ph_lo, ph_hi; };

struct Ctx {
    float* out; unsigned char* ws; LAS unsigned char* lds; int tid, lane, wave, G;
    template <class T> __device__ __forceinline__ T* p(size_t off) const { return (T*)(ws + off); }
    __device__ __forceinline__ const float* in(int k) const { const LAS unsigned* t = (const LAS unsigned*)(lds + LC_PTRS) + 2 * k;
        const unsigned lo = __builtin_amdgcn_readfirstlane(t[0]), hi = __builtin_amdgcn_readfirstlane(t[1]); return (const float*)(((unsigned long long)hi << 32) | lo); }
};

struct SchedGrid {
    pg8::StaticOrder so; const char* A; const char* B; size_t atile, btile;
    __device__ __forceinline__ bool next(int i, Unit& u) const { if (!so.next(i, u.pm, u.pn)) return false; u.grp = 0; u.a = A + (size_t)u.pm * atile; u.b = B + (size_t)u.pn * btile; return true; }
};
struct SchedS5 {
    int G, c; const char* A; const char* B; size_t bgrp;
    __device__ __forceinline__ bool next(int i, Unit& u) const { const int L = i * G + c; if (L >= 288) return false; const int g = L / 9, pm = L - g * 9; u.pm = pm; u.pn = 0; u.grp = g;
        u.a = A + ((size_t)pm * 256 * 16384 + (size_t)g * 512) * 2; u.b = B + (size_t)g * bgrp; return true; }
};
struct SchedMoe {
    pg8::StaticOrder so; const char* A; const char* B; size_t atile, btile, bexp; const LAS unsigned char* tile_e;
    __device__ __forceinline__ bool next(int i, Unit& u) const { if (!so.next(i, u.pm, u.pn)) return false; u.grp = tile_e[u.pm]; u.a = A + (size_t)u.pm * atile; u.b = B + (size_t)u.grp * bexp + (size_t)u.pn * btile; return true; }
};

#define EPI_ROWS_BEGIN  _Pragma("unroll") for (int ai = 0; ai < 2; ++ai) _Pragma("unroll") for (int m = 0; m < 4; ++m) { const int row = u.pm * 256 + ai * 128 + wr * 64 + m * 16 + fr;
#define EPI_ROWS_END    asm volatile("" ::: "memory"); }
__device__ __forceinline__ u32x4 pack8(const f32x4 a, const f32x4 b) { u32x4 w; w.x = cvt_pk_bf16(a[0], a[1]); w.y = cvt_pk_bf16(a[2], a[3]); w.z = cvt_pk_bf16(b[0], b[1]); w.w = cvt_pk_bf16(b[2], b[3]); return w; }
__device__ __forceinline__ void unpack8(const u32x4 w, f32x4& a, f32x4& b) { a = (f32x4){bflo(w.x), bfhi(w.x), bflo(w.y), bfhi(w.y)}; b = (f32x4){bflo(w.z), bfhi(w.z), bflo(w.w), bfhi(w.w)}; }

struct EpiInProj {
    static constexpr bool PERM = true;
    bf16_t *A3, *XR, *GG, *M5, *ML;
    __device__ __forceinline__ void operator()(const f32x4 (&acc)[2][2][4][2], const Unit& u, int wr, int wc, int fr, int fq) const {
        const int pn = u.pn;
        EPI_ROWS_BEGIN
#pragma unroll
            for (int bj = 0; bj < 2; ++bj) {
                const int col = pn * 256 + bj * 128 + wc * 32 + 8 * fq; f32x4 v0 = acc[ai][bj][m][0], v1 = acc[ai][bj][m][1];
                if (pn < 2) {
                    int b, cidx, j; if (row < NLAT) { b = row >> 11; const int t = row & 2047; cidx = 16 + (t >> 4); j = t & 15; } else { const int rr = row - NLAT; b = rr >> 8; const int tc = rr & 255; cidx = tc >> 4; j = tc & 15; }
                    const int g = col >> 4, h = col & 15;
                    *(u32x4*)(A3 + ((size_t)((b * NCH + cidx) * 32 + g)) * 512 + j * 16 + h) = pack8(v0, v1);
                } else if (pn < 6) {
                    *(u32x4*)(XR + (size_t)row * D + (col - 512)) = pack8(v0, v1);
                } else if (pn < 10) {
#pragma unroll
                    for (int q = 0; q < 4; ++q) { v0[q] = gelu_tanh(v0[q]); v1[q] = gelu_tanh(v1[q]); }
                    *(u32x4*)(GG + (size_t)row * D + (col - 1536)) = pack8(v0, v1);
                } else {
#pragma unroll
                    for (int q = 0; q < 4; ++q) { v0[q] = sigmoidf_(v0[q]); v1[q] = sigmoidf_(v1[q]); }
                    bf16_t* dst = pn < 14 ? M5 + (size_t)row * D + (col - 2560) : ML + (size_t)row * D + (col - 3584);
                    *(u32x4*)dst = pack8(v0, v1);
                }
            }
        EPI_ROWS_END
    }
};
struct EpiS5L1 {
    static constexpr bool PERM = false;
    float* S;
    __device__ __forceinline__ void operator()(const f32x4 (&acc)[2][2][4][2], const Unit& u, int wr, int wc, int fr, int fq) const {
        EPI_ROWS_BEGIN
            float* rowp = S + ((size_t)row * 32 + u.grp) * 256 + wc * 32 + 4 * fq;
#pragma unroll
            for (int bj = 0; bj < 2; ++bj)
#pragma unroll
                for (int n = 0; n < 2; ++n) *(f32x4*)(rowp + bj * 128 + n * 16) = acc[ai][bj][m][n];
        EPI_ROWS_END
    }
};
struct EpiS5Y {
    static constexpr bool PERM = true;
    bf16_t* GY;
    __device__ __forceinline__ void operator()(const f32x4 (&acc)[2][2][4][2], const Unit& u, int wr, int wc, int fr, int fq) const {
        EPI_ROWS_BEGIN
            const int b = row / NCH, cidx = row - b * NCH;
            const int tok0 = cidx < 16 ? NLAT + b * 256 + cidx * 16 : b * 2048 + (cidx - 16) * 16;
#pragma unroll
            for (int bj = 0; bj < 2; ++bj) {
                const int col = bj * 128 + wc * 32 + 8 * fq, j = col >> 4, h = col & 15; f32x4 v0 = acc[ai][bj][m][0], v1 = acc[ai][bj][m][1];
#pragma unroll
                for (int q = 0; q < 4; ++q) { v0[q] = gelu_tanh(v0[q]); v1[q] = gelu_tanh(v1[q]); }
                *(u32x4*)(GY + (size_t)(tok0 + j) * 512 + u.grp * 16 + h) = pack8(v0, v1);
            }
        EPI_ROWS_END
    }
};
struct EpiGlu {
    static constexpr bool PERM = true;
    const bf16_t* GY; bf16_t* O5; const float* bias;
    __device__ __forceinline__ void operator()(const f32x4 (&acc)[2][2][4][2], const Unit& u, int wr, int wc, int fr, int fq) const {
        EPI_ROWS_BEGIN
#pragma unroll
            for (int bj = 0; bj < 2; ++bj) {
                const int col = u.pn * 256 + bj * 128 + wc * 32 + 8 * fq; f32x4 v0 = acc[ai][bj][m][0], v1 = acc[ai][bj][m][1];
                const f32x4 b0 = *(const f32x4*)(bias + col), b1 = *(const f32x4*)(bias + col + 4);
                f32x4 g0, g1; unpack8(*(const u32x4*)(GY + (size_t)row * 512 + col), g0, g1);
#pragma unroll
                for (int q = 0; q < 4; ++q) { v0[q] = g0[q] * sigmoidf_(v0[q] + b0[q]); v1[q] = g1[q] * sigmoidf_(v1[q] + b1[q]); }
                *(u32x4*)(O5 + (size_t)row * 512 + col) = pack8(v0, v1);
            }
        EPI_ROWS_END
    }
};
struct EpiMulGate {
    static constexpr bool PERM = true;
    const bf16_t* GATE; const bf16_t* ADD; bf16_t* O;
    __device__ __forceinline__ void operator()(const f32x4 (&acc)[2][2][4][2], const Unit& u, int wr, int wc, int fr, int fq) const {
        EPI_ROWS_BEGIN
#pragma unroll
            for (int bj = 0; bj < 2; ++bj) {
                const size_t off = (size_t)row * D + u.pn * 256 + bj * 128 + wc * 32 + 8 * fq; f32x4 v0 = acc[ai][bj][m][0], v1 = acc[ai][bj][m][1];
                f32x4 g0, g1; unpack8(*(const u32x4*)(GATE + off), g0, g1);
                v0 = v0 * g0; v1 = v1 * g1;
                if (ADD) { f32x4 a0, a1; unpack8(*(const u32x4*)(ADD + off), a0, a1); v0 = v0 + a0; v1 = v1 + a1; }
                *(u32x4*)(O + off) = pack8(v0, v1);
            }
        EPI_ROWS_END
    }
};
struct EpiOut {
    static constexpr bool PERM = false;
    const float* xlat; const float* xctx; float* X; const float* ada; int l;
    __device__ __forceinline__ void operator()(const f32x4 (&acc)[2][2][4][2], const Unit& u, int wr, int wc, int fr, int fq) const {
        const int bsel = u.pm < 128 ? (u.pm >> 3) : 16;
        const float* gate = ada + ((size_t)(l * 17 + bsel) * 6 + 2) * D;
        const int col0 = u.pn * 256 + wc * 32 + 4 * fq;
        f32x4 gv[2][2];
#pragma unroll
        for (int bj = 0; bj < 2; ++bj)
#pragma unroll
            for (int n = 0; n < 2; ++n) gv[bj][n] = *(const f32x4*)(gate + col0 + bj * 128 + n * 16);
        EPI_ROWS_BEGIN
            const float* src = row < NLAT ? xlat + (size_t)row * D : xctx + (size_t)(row - NLAT) * D;
            float* dst = X + (size_t)row * D;
#pragma unroll
            for (int bj = 0; bj < 2; ++bj)
#pragma unroll
                for (int n = 0; n < 2; ++n) { const int c = col0 + bj * 128 + n * 16; *(f32x4*)(dst + c) = *(const f32x4*)(src + c) + gv[bj][n] * acc[ai][bj][m][n]; }
        EPI_ROWS_END
    }
};
struct EpiUp {
    static constexpr bool PERM = true;
    bf16_t* ACT; const float* bup;
    __device__ __forceinline__ void operator()(const f32x4 (&acc)[2][2][4][2], const Unit& u, int wr, int wc, int fr, int fq) const {
        const int a0 = u.pn * 128 + wc * 32 + 8 * fq;
        const float* bp = bup + (size_t)u.grp * 2048 + 2 * a0;
        float bg[8], bu[8];
#pragma unroll
        for (int q = 0; q < 4; ++q) { const f32x4 t = *(const f32x4*)(bp + 4 * q); bg[2 * q] = t[0]; bu[2 * q] = t[1]; bg[2 * q + 1] = t[2]; bu[2 * q + 1] = t[3]; }
        EPI_ROWS_BEGIN
            f32x4 o0, o1;
#pragma unroll
            for (int q = 0; q < 4; ++q) {
                float gt = fminf(acc[ai][0][m][0][q] + bg[q], 7.0f), up = fminf(fmaxf(acc[ai][1][m][0][q] + bu[q], -7.0f), 7.0f);
                o0[q] = gt * sigmoidf_(1.702f * gt) * (up + 1.0f);
                gt = fminf(acc[ai][0][m][1][q] + bg[4 + q], 7.0f); up = fminf(fmaxf(acc[ai][1][m][1][q] + bu[4 + q], -7.0f), 7.0f);
                o1[q] = gt * sigmoidf_(1.702f * gt) * (up + 1.0f);
            }
            *(u32x4*)(ACT + (size_t)row * D + a0) = pack8(o0, o1);
        EPI_ROWS_END
    }
};
struct EpiDown {
    static constexpr bool PERM = true;
    bf16_t* Y; const float* bdn;
    __device__ __forceinline__ void operator()(const f32x4 (&acc)[2][2][4][2], const Unit& u, int wr, int wc, int fr, int fq) const {
        EPI_ROWS_BEGIN
#pragma unroll
            for (int bj = 0; bj < 2; ++bj) {
                const int col = u.pn * 256 + bj * 128 + wc * 32 + 8 * fq;
                const f32x4 b0 = *(const f32x4*)(bdn + (size_t)u.grp * D + col), b1 = *(const f32x4*)(bdn + (size_t)u.grp * D + col + 4);
                *(u32x4*)(Y + (size_t)row * D + col) = pack8(acc[ai][bj][m][0] + b0, acc[ai][bj][m][1] + b1);
            }
        EPI_ROWS_END
    }
};

template <bool UPMAP>
__device__ __forceinline__ void transpose_item(const float* W, int K, int N, bf16_t* WT, LAS float* scr, int item, int lane) {
    const int nblk = N / 32, kb = item / nblk, nb = item % nblk, k0 = 64 * kb, n0 = 32 * nb;
#pragma unroll 8
    for (int i = 0; i < 32; ++i) { const int kk = 2 * i + (lane >> 5); scr[kk * 33 + (lane & 31)] = W[(size_t)(k0 + kk) * N + n0 + (lane & 31)]; }
    asm volatile("s_waitcnt lgkmcnt(0)" ::: "memory");
    const int c = lane & 7;
#pragma unroll
    for (int j = 0; j < 4; ++j) { const int n = (lane >> 3) + 8 * j; const LAS float* s = scr + (8 * c) * 33 + n;
        u32x4 o; o.x = cvt_pk_bf16(s[0 * 33], s[1 * 33]); o.y = cvt_pk_bf16(s[2 * 33], s[3 * 33]); o.z = cvt_pk_bf16(s[4 * 33], s[5 * 33]); o.w = cvt_pk_bf16(s[6 * 33], s[7 * 33]);
        int orow = n0 + n; if (UPMAP) { const int a = orow >> 1, sft = orow & 1; orow = (a >> 7) * 256 + sft * 128 + (a & 127); }
        *(u32x4*)(WT + (size_t)orow * K + k0 + 8 * c) = o; }
    asm volatile("s_waitcnt lgkmcnt(0)" ::: "memory");
}
__device__ __forceinline__ void phase_transposes(const Ctx& C) {
    LAS float* scr = (LAS float*)(C.lds + C.wave * 16384);
    const int gw = blockIdx.x * 8 + C.wave, NGW = C.G * 8;
    constexpr int I_IN = 16 * 144, I_GLU = 8 * 16, I_P5 = 8 * 32, I_PL = 16 * 32, I_OUT = 16 * 32, I_UP1 = 16 * 64, I_UP = 32 * I_UP1, I_DN1 = 16 * 32, I_DN = 32 * I_DN1;
    constexpr int PER_L = I_IN + I_GLU + I_P5 + I_PL + I_OUT + I_UP + I_DN;
    for (int it = gw; it < DEPTH * PER_L; it += NGW) {
        const int l = it / PER_L; int r = it - l * PER_L;
        if (r < I_IN) { transpose_item<false>(C.in(8) + (size_t)l * D * INW, D, INW, C.p<bf16_t>(WS_WINT) + (size_t)l * INW * D, scr, r, C.lane); continue; } r -= I_IN;
        if (r < I_GLU) { transpose_item<false>(C.in(17) + (size_t)l * 512 * 512, 512, 512, C.p<bf16_t>(WS_WGLUT) + (size_t)l * 512 * 512, scr, r, C.lane); continue; } r -= I_GLU;
        if (r < I_P5) { transpose_item<false>(C.in(26) + (size_t)l * 512 * D, 512, D, C.p<bf16_t>(WS_WP5T) + (size_t)l * D * 512, scr, r, C.lane); continue; } r -= I_P5;
        if (r < I_PL) { transpose_item<false>(C.in(27) + (size_t)l * D * D, D, D, C.p<bf16_t>(WS_WPLT) + (size_t)l * D * D, scr, r, C.lane); continue; } r -= I_PL;
        if (r < I_OUT) { transpose_item<false>(C.in(28) + (size_t)l * D * D, D, D, C.p<bf16_t>(WS_WOUTT) + (size_t)l * D * D, scr, r, C.lane); continue; } r -= I_OUT;
        if (r < I_UP) { const int e = r / I_UP1; transpose_item<true>(C.in(31) + ((size_t)l * NEXP + e) * D * 2048, D, 2048, C.p<bf16_t>(WS_WUPT) + ((size_t)l * NEXP + e) * 2048 * D, scr, r - e * I_UP1, C.lane); continue; } r -= I_UP;
        { const int e = r / I_DN1; transpose_item<false>(C.in(33) + ((size_t)l * NEXP + e) * D * D, D, D, C.p<bf16_t>(WS_WDNT) + ((size_t)l * NEXP + e) * D * D, scr, r - e * I_DN1, C.lane); }
    }
}

__device__ __forceinline__ void phase_s5prep(const Ctx& C) {
    LAS float* PW = (LAS float*)(C.lds);
    LAS float* BB = (LAS float*)(C.lds + 17408);
    LAS float* CC = (LAS float*)(C.lds + 17408 + 16384);
    LAS float* KT = (LAS float*)(C.lds + 17408 + 32768);
    const int tid = C.tid;
    for (int item = blockIdx.x; item < DEPTH * 32; item += C.G) {
        const int l = item >> 5, g = item & 31;
        __syncthreads();
        if (tid < 128) {
            const int dr = tid >> 6, p = tid & 63; const size_t ix = ((size_t)(l * 2 + dr) * 32 + g) * 64 + p;
            const double lr = (double)C.in(9)[ix], li = (double)C.in(10)[ix], dt = exp((double)C.in(11)[(l * 2 + dr) * 32 + g]);
            for (int k = 0; k <= 16; ++k) { const double mag = exp(lr * dt * k), ang = li * dt * k; PW[((dr * 17 + k) * 64 + p) * 2] = (float)(mag * cos(ang)); PW[((dr * 17 + k) * 64 + p) * 2 + 1] = (float)(mag * sin(ang)); }
            const double m1 = exp(lr * dt), abr = m1 * cos(li * dt), abi = m1 * sin(li * dt), den = lr * lr + li * li, zr = abr - 1.0;
            const double qr = (zr * lr + abi * li) / den, qi = (abi * lr - zr * li) / den;
            for (int h = 0; h < 16; ++h) { const double br = (double)C.in(12)[ix * 16 + h], bi = (double)C.in(13)[ix * 16 + h];
                BB[((dr * 64 + p) * 16 + h) * 2] = (float)(qr * br - qi * bi); BB[((dr * 64 + p) * 16 + h) * 2 + 1] = (float)(qr * bi + qi * br); }
            float* dec = C.p<float>(WS_DEC) + ix * 2; const double m16 = exp(lr * dt * 16), a16 = li * dt * 16; dec[0] = (float)(m16 * cos(a16)); dec[1] = (float)(m16 * sin(a16));
        }
        for (int e = tid; e < 2 * 16 * 64; e += 512) { const int dr = e >> 10, h = (e >> 6) & 15, p = e & 63; const size_t ix = (((size_t)(l * 2 + dr) * 32 + g) * 16 + h) * 64 + p;
            CC[e * 2] = C.in(14)[ix]; CC[e * 2 + 1] = C.in(15)[ix]; }
        __syncthreads();
        for (int e = tid; e < 8192; e += 512) { const int dr = e >> 12, tau = (e >> 8) & 15, i = (e >> 4) & 15, ip = e & 15; float s = 0.f;
            for (int p = 0; p < 64; ++p) { const float cr = CC[((dr * 16 + i) * 64 + p) * 2], ci = CC[((dr * 16 + i) * 64 + p) * 2 + 1], pr = PW[((dr * 17 + tau) * 64 + p) * 2], pi = PW[((dr * 17 + tau) * 64 + p) * 2 + 1];
                const float xr = cr * pr - ci * pi, xi = cr * pi + ci * pr; s += xr * BB[((dr * 64 + p) * 16 + ip) * 2] - xi * BB[((dr * 64 + p) * 16 + ip) * 2 + 1]; }
            KT[e] = s; }
        __syncthreads();
        bf16_t* W3 = C.p<bf16_t>(WS_W3T) + (size_t)item * 256 * 512; bf16_t* FT = C.p<bf16_t>(WS_FT) + (size_t)item * 256 * 256;
        const float* dvec = C.in(16) + (size_t)l * 512 + g * 16;
        for (int e2 = tid; e2 < 256 * 256; e2 += 512) {
            const int row = e2 >> 8, col0 = (e2 & 255) * 2, j = row >> 4, i = row & 15; float v[2];
#pragma unroll
            for (int q = 0; q < 2; ++q) { const int col = col0 + q;
                if (col < 256) { const int jp = col >> 4, ip = col & 15; float s = 0.f; if (j >= jp) s += KT[((0 * 16 + (j - jp)) * 16 + i) * 16 + ip]; if (jp >= j) s += KT[((1 * 16 + (jp - j)) * 16 + i) * 16 + ip]; if (row == col) s += dvec[i]; v[q] = s; }
                else { const int cc = col - 256, dr = cc >> 7, isim = (cc >> 6) & 1, p = cc & 63, pw = dr ? 16 - j : j + 1;
                    const float cr = CC[((dr * 16 + i) * 64 + p) * 2], ci = CC[((dr * 16 + i) * 64 + p) * 2 + 1], pr = PW[((dr * 17 + pw) * 64 + p) * 2], pi = PW[((dr * 17 + pw) * 64 + p) * 2 + 1];
                    v[q] = isim ? -(cr * pi + ci * pr) : (cr * pr - ci * pi); } }
            *(unsigned*)(W3 + (size_t)row * 512 + col0) = cvt_pk_bf16(v[0], v[1]);
        }
        for (int e2 = tid; e2 < 256 * 128; e2 += 512) {
            const int n = e2 >> 7, col0 = (e2 & 127) * 2, blk = n >> 6, p = n & 63, dr = blk >> 1; float v[2];
#pragma unroll
            for (int q = 0; q < 2; ++q) { const int col = col0 + q, jp = col >> 4, ip = col & 15, pw = dr ? jp : 15 - jp;
                const float pr = PW[((dr * 17 + pw) * 64 + p) * 2], pi = PW[((dr * 17 + pw) * 64 + p) * 2 + 1], br = BB[((dr * 64 + p) * 16 + ip) * 2], bi = BB[((dr * 64 + p) * 16 + ip) * 2 + 1];
                v[q] = (blk & 1) ? (pr * bi + pi * br) : (pr * br - pi * bi); }
            *(unsigned*)(FT + (size_t)n * 256 + col0) = cvt_pk_bf16(v[0], v[1]);
        }
    }
    __syncthreads();
}

__device__ __forceinline__ void phase_ada(const Ctx& C) {
    LAS float* cond = (LAS float*)(C.lds);
    LAS float* red = (LAS float*)(C.lds + 17 * 1024 * 4);
    const int tid = C.tid;
    for (int e = tid; e < 17 * 1024; e += 512) { const float v = e < 16 * 1024 ? C.in(1)[e] : C.in(3)[e - 16 * 1024]; cond[e] = v * sigmoidf_(v); }
    __syncthreads();
    const int c = tid & 63, ks = tid >> 6;
    for (int item = blockIdx.x; item < DEPTH * 96; item += C.G) {
        const int l = item / 96, cb = item - l * 96, col = cb * 64 + c;
        const float* W = C.in(4) + (size_t)l * D * 6144 + col;
        float acc[17];
#pragma unroll
        for (int r = 0; r < 17; ++r) acc[r] = 0.f;
        for (int k = ks * 128; k < ks * 128 + 128; k += 4) {
            const float w0 = W[(size_t)k * 6144], w1 = W[(size_t)(k + 1) * 6144], w2 = W[(size_t)(k + 2) * 6144], w3 = W[(size_t)(k + 3) * 6144];
#pragma unroll
            for (int r = 0; r < 17; ++r) { const f32x4 cv = *(const LAS f32x4*)(cond + r * 1024 + k); acc[r] += cv[0] * w0 + cv[1] * w1 + cv[2] * w2 + cv[3] * w3; }
        }
#pragma unroll
        for (int r = 0; r < 17; ++r) red[(ks * 17 + r) * 64 + c] = acc[r];
        __syncthreads();
        for (int e = tid; e < 17 * 64; e += 512) { const int r = e >> 6, cc = e & 63; float s = 0.f;
#pragma unroll
            for (int q = 0; q < 8; ++q) s += red[(q * 17 + r) * 64 + cc];
            C.p<float>(WS_ADA)[(size_t)(l * 17 + r) * 6144 + cb * 64 + cc] = s + C.in(5)[(size_t)l * 6144 + cb * 64 + cc]; }
        __syncthreads();
    }
}

__device__ __forceinline__ void load_row(const Ctx& C, bool from_input, int m, bool combine, int lc  , f32x4 (&v)[4]) {
    const float* src;
    if (from_input) src = m < NLAT ? C.in(0) + (size_t)m * D : C.in(2) + (size_t)(m - NLAT) * D; else src = C.p<float>(WS_X) + (size_t)m * D;
#pragma unroll
    for (int j = 0; j < 4; ++j) v[j] = *(const f32x4*)(src + 4 * C.lane + 256 * j);
    if (combine) {
        const int bsel = m < NLAT ? (m >> 11) : 16;
        const float* g2 = C.p<float>(WS_ADA) + ((size_t)(lc * 17 + bsel) * 6 + 5) * D;
        f32x4 s[4];
#pragma unroll
        for (int j = 0; j < 4; ++j) s[j] = (f32x4){0.f, 0.f, 0.f, 0.f};
#pragma unroll
        for (int k = 0; k < 4; ++k) {
            const int slot = C.p<int>(WS_SLOT)[m * 4 + k]; const float w = C.p<float>(WS_TOKW)[m * 4 + k];
            const bf16_t* y = C.p<bf16_t>(WS_Y) + (size_t)slot * D;
#pragma unroll
            for (int j = 0; j < 4; ++j) { const u32x2 t = *(const u32x2*)(y + 4 * C.lane + 256 * j); s[j] += w * (f32x4){bflo(t.x), bfhi(t.x), bflo(t.y), bfhi(t.y)}; }
        }
#pragma unroll
        for (int j = 0; j < 4; ++j) v[j] += *(const f32x4*)(g2 + 4 * C.lane + 256 * j) * s[j];
    }
}
__device__ __forceinline__ float row_rstd(const f32x4 (&v)[4]) {
    float s = 0.f;
#pragma unroll
    for (int j = 0; j < 4; ++j) s += (v[j][0] * v[j][0] + v[j][1] * v[j][1]) + (v[j][2] * v[j][2] + v[j][3] * v[j][3]);
    return rsqrtf(wave_sum(s) * (1.0f / D) + 1e-6f);
}
__device__ __forceinline__ void norm_mod(const Ctx& C, f32x4 (&v)[4], const float* gain, const float* shift, const float* scale) {
    const float rstd = row_rstd(v);
#pragma unroll
    for (int j = 0; j < 4; ++j) { const int c = 4 * C.lane + 256 * j; const f32x4 gn = *(const f32x4*)(gain + c), sh = *(const f32x4*)(shift + c), sc = *(const f32x4*)(scale + c);
        v[j] = (v[j] * rstd * gn) * (sc + 1.0f) + sh; }
}
__device__ __forceinline__ void phase_norm1(const Ctx& C, int l) {
    const int gw = blockIdx.x * 8 + C.wave, NGW = C.G * 8;
    for (int m = gw; m < NTOK; m += NGW) {
        f32x4 v[4]; load_row(C, l == 0, m, l > 0, l - 1, v);
        if (l > 0) {
#pragma unroll
            for (int j = 0; j < 4; ++j) *(f32x4*)(C.p<float>(WS_X) + (size_t)m * D + 4 * C.lane + 256 * j) = v[j];
        }
        const int bsel = m < NLAT ? (m >> 11) : 16; const float* ada = C.p<float>(WS_ADA) + (size_t)(l * 17 + bsel) * 6 * D;
        norm_mod(C, v, C.in(6) + (size_t)l * D, ada, ada + D);
#pragma unroll
        for (int j = 0; j < 4; ++j) { u32x2 o; o.x = cvt_pk_bf16(v[j][0], v[j][1]); o.y = cvt_pk_bf16(v[j][2], v[j][3]); *(u32x2*)(C.p<bf16_t>(WS_HN) + (size_t)m * D + 4 * C.lane + 256 * j) = o; }
    }
}
__device__ __forceinline__ void phase_norm2(const Ctx& C, int l, int ntok) {
    LAS float* T = (LAS float*)C.lds;
    LAS float* LG = (LAS float*)(C.lds + 131584);
    LAS int* lcnt = (LAS int*)(C.lds + LC_LCNT); LAS int* gb = (LAS int*)(C.lds + LC_GB);
    unsigned* CNT = C.p<unsigned>(WS_CTL) + CW_CNT + l * 32;
    const float* wr = C.in(29) + (size_t)l * D * 32; const float* br = C.in(30) + l * 32;
    const int tid = C.tid;
    for (int blk = blockIdx.x; blk < ntok / 32; blk += C.G) {
#pragma unroll 1
        for (int rr = 0; rr < 4; ++rr) {
            const int r = C.wave * 4 + rr, m = blk * 32 + r;
            f32x4 v[4]; load_row(C, false, m, false, 0, v);
            const int bsel = m < NLAT ? (m >> 11) : 16; const float* ada = C.p<float>(WS_ADA) + (size_t)(l * 17 + bsel) * 6 * D;
            norm_mod(C, v, C.in(7) + (size_t)l * D, ada + 3 * D, ada + 4 * D);
#pragma unroll
            for (int j = 0; j < 4; ++j) { u32x2 o; o.x = cvt_pk_bf16(v[j][0], v[j][1]); o.y = cvt_pk_bf16(v[j][2], v[j][3]); *(u32x2*)(C.p<bf16_t>(WS_HN) + (size_t)m * D + 4 * C.lane + 256 * j) = o;
                *(LAS f32x4*)(T + r * 1028 + 4 * C.lane + 256 * j) = v[j]; }
        }
        if (tid < 32) lcnt[tid] = 0;
        __syncthreads();
        {
            const int r = tid >> 4, eg = tid & 15; float a0 = 0.f, a1 = 0.f;
#pragma unroll 4
            for (int k4 = 0; k4 < 256; ++k4) { const f32x4 t = *(const LAS f32x4*)(T + r * 1028 + 4 * k4);
#pragma unroll
                for (int kk = 0; kk < 4; ++kk) { const f32x2 w = *(const f32x2*)(wr + (size_t)(4 * k4 + kk) * 32 + 2 * eg); a0 += t[kk] * w.x; a1 += t[kk] * w.y; } }
            LG[r * 33 + 2 * eg] = a0 + br[2 * eg]; LG[r * 33 + 2 * eg + 1] = a1 + br[2 * eg + 1];
        }
        __syncthreads();
        int te[4]; float tw[4]; int tp[4];
        if (tid < 32) {
            unsigned used = 0u; float tv[4];
#pragma unroll
            for (int k = 0; k < 4; ++k) { float best = -3.0e38f; int bi = 0;
                for (int e = 0; e < 32; ++e) { const float x = LG[tid * 33 + e]; if (!((used >> e) & 1u) && x > best) { best = x; bi = e; } }
                used |= 1u << bi; te[k] = bi; tv[k] = best; }
            float s = 0.f;
#pragma unroll
            for (int k = 0; k < 4; ++k) { tw[k] = __expf(tv[k] - tv[0]); s += tw[k]; }
#pragma unroll
            for (int k = 0; k < 4; ++k) { tw[k] /= s; tp[k] = atomicAdd((int*)&lcnt[te[k]], 1); }
        }
        __syncthreads();
        if (tid < 32) { const int n = lcnt[tid]; gb[tid] = n > 0 ? (int)atomicAdd(CNT + tid, (unsigned)n) : 0; }
        __syncthreads();
        if (tid < 32) { const int m = blk * 32 + tid;
#pragma unroll
            for (int k = 0; k < 4; ++k) { C.p<int>(WS_TOKE)[m * 4 + k] = te[k]; C.p<int>(WS_TOKP)[m * 4 + k] = gb[te[k]] + tp[k]; C.p<float>(WS_TOKW)[m * 4 + k] = tw[k]; } }
        __syncthreads();
    }
}
__device__ __forceinline__ int moe_offsets(const Ctx& C, int l, bool tiles) {
    LAS int* offs = (LAS int*)(C.lds + LC_OFFS); LAS unsigned char* tile_e = (LAS unsigned char*)(C.lds + LC_TILE);
    unsigned* CNT = C.p<unsigned>(WS_CTL) + CW_CNT + l * 32;
    __syncthreads();
    if (C.tid == 0) { int o = 0; for (int e = 0; e < 32; ++e) { offs[e] = o; const int n = (int)__hip_atomic_load(CNT + e, __ATOMIC_RELAXED, __HIP_MEMORY_SCOPE_AGENT); o += (n + 255) & ~255; } offs[32] = o; }
    __syncthreads();
    const int tt = offs[32] >> 8;
    if (tiles) { for (int t = C.tid; t < tt; t += 512) { int e = 0; while (e < 31 && offs[e + 1] <= t * 256) ++e; tile_e[t] = (unsigned char)e; } __syncthreads(); }
    return tt;
}
__device__ __forceinline__ void phase_slots(const Ctx& C, int l, int ntok) {
    moe_offsets(C, l, false);
    LAS int* offs = (LAS int*)(C.lds + LC_OFFS);
    unsigned* CNT = C.p<unsigned>(WS_CTL) + CW_CNT + l * 32;
    const int gw = blockIdx.x * 8 + C.wave, NGW = C.G * 8;
    for (int idx = gw; idx < ntok * 4; idx += NGW) {
        const int e = C.p<int>(WS_TOKE)[idx], slot = offs[e] + C.p<int>(WS_TOKP)[idx];
        if (C.lane == 0) C.p<int>(WS_SLOT)[idx] = slot;
        const u32x4* src = (const u32x4*)(C.p<bf16_t>(WS_HN) + (size_t)(idx >> 2) * D); u32x4* dst = (u32x4*)(C.p<bf16_t>(WS_XS) + (size_t)slot * D);
        const u32x4 a = src[C.lane], b = src[C.lane + 64]; dst[C.lane] = a; dst[C.lane + 64] = b;
    }
    for (int e = 0; e < 32; ++e) { const int n = (int)__hip_atomic_load(CNT + e, __ATOMIC_RELAXED, __HIP_MEMORY_SCOPE_AGENT), p0 = offs[e] + n, p1 = offs[e + 1];
        for (int r = p0 + gw; r < p1; r += NGW) { u32x4* dst = (u32x4*)(C.p<bf16_t>(WS_XS) + (size_t)r * D); const u32x4 z = (u32x4){0u, 0u, 0u, 0u}; dst[C.lane] = z; dst[C.lane + 64] = z; } }
}
__device__ __forceinline__ void phase_final(const Ctx& C) {
    const int gw = blockIdx.x * 8 + C.wave, NGW = C.G * 8;
    for (int m = gw; m < NLAT; m += NGW) {
        f32x4 v[4]; load_row(C, false, m, true, DEPTH - 1, v);
        const float rstd = row_rstd(v);
#pragma unroll
        for (int j = 0; j < 4; ++j) { const int c = 4 * C.lane + 256 * j; *(f32x4*)(C.out + (size_t)m * D + c) = v[j] * rstd * *(const f32x4*)(C.in(35) + c); }
    }
}

__device__ __forceinline__ void phase_s5carry_ol(const Ctx& C, int l) {
    if (C.tid < 256) {
        for (int gid = blockIdx.x * 256 + C.tid; gid < 65536; gid += C.G * 256) {
            const int p = gid & 63, dr = (gid >> 6) & 1, g = (gid >> 7) & 31, b = gid >> 12;
            const f32x2 dec = *(const f32x2*)(C.p<float>(WS_DEC) + (((size_t)(l * 2 + dr) * 32 + g) * 64 + p) * 2);
            float hr = 0.f, hi = 0.f;
#pragma unroll 8
            for (int k = 0; k < NCH; ++k) {
                const int cidx = dr == 0 ? k : (k < 16 ? 15 - k : 159 - k);
                const size_t rg = (size_t)(b * NCH + cidx) * 32 + g;
                const float* s = C.p<float>(WS_SB) + rg * 256 + dr * 128 + p; bf16_t* a3 = C.p<bf16_t>(WS_A3) + rg * 512 + 256 + dr * 128 + p;
                const float sr = s[0], si = s[64];
                a3[0] = f2bf(hr); a3[64] = f2bf(hi);
                const float nr = dec.x * hr - dec.y * hi + sr, ni = dec.x * hi + dec.y * hr + si; hr = nr; hi = ni;
            }
        }
    }
    const size_t n8 = (size_t)NTOK * D / 8;
    for (size_t i = (size_t)blockIdx.x * 512 + C.tid; i < n8; i += (size_t)C.G * 512) {
        f32x4 g0, g1, f0, f1, b0, b1; unpack8(((const u32x4*)C.p<bf16_t>(WS_GG))[i], g0, g1); unpack8(((const u32x4*)C.p<bf16_t>(WS_HF))[i], f0, f1); unpack8(((const u32x4*)C.p<bf16_t>(WS_HB))[i], b0, b1);
        ((u32x4*)C.p<bf16_t>(WS_OL))[i] = pack8(g0 * (f0 + b0), g1 * (f1 + b1));
    }
}

__device__ __forceinline__ int lru_row(int b, bool isctx, int p) { return isctx ? NLAT + b * 256 + p : b * 2048 + (p & 31) * 64 + (p >> 5); }
__device__ __forceinline__ void phase_lru(const Ctx& C, int l) {
    const int tid = C.tid, dir = tid >> 8, lt = tid & 255, lw = (tid >> 6) & 3, lane = tid & 63;
    LAS unsigned char* R = C.lds + dir * 65536;
    LAS unsigned char* XT = R;
    LAS unsigned char* XC = R + 8704;
    LAS float* GT = (LAS float*)(R + 17920);
    LAS float* SEG = (LAS float*)(R + 51712);
    const bf16_t* XR = C.p<bf16_t>(WS_XR); bf16_t* HOUT = C.p<bf16_t>(dir ? WS_HB : WS_HF);
    for (int task = blockIdx.x; task < 256; task += C.G) {
        const int b = task >> 4, n = task & 15;
        const int c = lt & 63, seg = lt >> 6;
        const float lam = C.in(21)[(size_t)(l * 2 + dir) * D + n * 64 + c];
        const float coef = -8.0f * log1pf(__expf(-lam));
        const int c2 = lt & 31, pg = lt >> 5;
        float cw[4][2], cb[2];
#pragma unroll
        for (int j = 0; j < 4; ++j) { cw[j][0] = C.in(19)[((size_t)l * 4 + j) * D + n * 64 + 2 * c2]; cw[j][1] = C.in(19)[((size_t)l * 4 + j) * D + n * 64 + 2 * c2 + 1]; }
        cb[0] = C.in(20)[(size_t)l * D + n * 64 + 2 * c2]; cb[1] = C.in(20)[(size_t)l * D + n * 64 + 2 * c2 + 1];
        const int gcol = (lw & 1) * 32 + (lane & 31);
        const float* Wg = (lw < 2 ? C.in(22) : C.in(24)) + ((size_t)((l * 2 + dir) * 16 + n) * 64) * 64;
        bf16x8 bfr[4];
#pragma unroll
        for (int s = 0; s < 4; ++s) {
            unsigned w[4];
#pragma unroll
            for (int jj = 0; jj < 4; ++jj) { const int k = 16 * s + 8 * (lane >> 5) + 2 * jj; w[jj] = cvt_pk_bf16(Wg[(size_t)k * 64 + gcol], Wg[(size_t)(k + 1) * 64 + gcol]); }
            u32x4 t = (u32x4){w[0], w[1], w[2], w[3]}; bfr[s] = __builtin_bit_cast(bf16x8, t);
        }
        const float bias_g = (lw < 2 ? C.in(23) : C.in(25))[(size_t)(l * 2 + dir) * D + n * 64 + gcol];
        float hrun = 0.f;
        u32x4 pf[3];
        auto issue_tile = [&](int it) {
            const bool isctx = it < 4; const int p0 = dir == 0 ? (isctx ? 64 * it : 64 * (it - 4)) : (isctx ? 64 * (3 - it) : 64 * (35 - it)); const int slen = isctx ? 256 : 2048;
#pragma unroll
            for (int r = 0; r < 3; ++r) { const int q = lt + 256 * r, rr = q >> 3, pc = q & 7, p = p0 - 1 + rr;
                pf[r] = (u32x4){0u, 0u, 0u, 0u};
                if (rr < 67 && p >= 0 && p < slen) pf[r] = *(const u32x4*)(XR + (size_t)lru_row(b, isctx, p) * D + n * 64 + pc * 8); }
        };
        issue_tile(0);
#pragma unroll 1
        for (int it = 0; it < 36; ++it) {
            const bool isctx = it < 4; const int p0 = dir == 0 ? (isctx ? 64 * it : 64 * (it - 4)) : (isctx ? 64 * (3 - it) : 64 * (35 - it));
#pragma unroll
            for (int r = 0; r < 3; ++r) { const int q = lt + 256 * r, rr = q >> 3, pc = q & 7; if (rr < 67) *(LAS u32x4*)(XT + rr * 128 + pc * 16) = pf[r]; }
            __syncthreads();
            if (it + 1 < 36) issue_tile(it + 1);
            {
                float x0[11], x1[11];
#pragma unroll
                for (int r = 0; r < 11; ++r) { const unsigned w = *(const LAS unsigned*)(XT + (8 * pg + r) * 128 + c2 * 4); x0[r] = bflo(w); x1[r] = bfhi(w); }
#pragma unroll
                for (int q = 0; q < 8; ++q) { float y0 = cb[0], y1 = cb[1];
#pragma unroll
                    for (int j = 0; j < 4; ++j) { y0 += cw[j][0] * x0[q + j]; y1 += cw[j][1] * x1[q + j]; }
                    *(LAS unsigned*)(XC + (8 * pg + q) * 144 + c2 * 4) = cvt_pk_bf16(y0, y1); }
            }
            __syncthreads();
            {
                f32x16 acc0, acc1;
#pragma unroll
                for (int q = 0; q < 16; ++q) { acc0[q] = 0.f; acc1[q] = 0.f; }
#pragma unroll
                for (int s = 0; s < 4; ++s) {
                    const bf16x8 a0 = *(const LAS bf16x8*)(XC + (lane & 31) * 144 + (16 * s + 8 * (lane >> 5)) * 2);
                    const bf16x8 a1 = *(const LAS bf16x8*)(XC + (32 + (lane & 31)) * 144 + (16 * s + 8 * (lane >> 5)) * 2);
                    acc0 = __builtin_amdgcn_mfma_f32_32x32x16_bf16(a0, bfr[s], acc0, 0, 0, 0);
                    acc1 = __builtin_amdgcn_mfma_f32_32x32x16_bf16(a1, bfr[s], acc1, 0, 0, 0);
                }
#pragma unroll
                for (int q = 0; q < 16; ++q) { const int rowq = (q & 3) + 8 * (q >> 2) + 4 * (lane >> 5);
                    GT[rowq * 132 + lw * 32 + (lane & 31)] = acc0[q] + bias_g; GT[(32 + rowq) * 132 + lw * 32 + (lane & 31)] = acc1[q] + bias_g; }
            }
            __syncthreads();
            float av[16], bv[16]; float P = 1.f, H = 0.f;
#pragma unroll
            for (int i = 0; i < 16; ++i) { const int s = 16 * seg + i, q = dir ? 63 - s : s;
                const float r = sigmoidf_(GT[q * 132 + c]), ig = sigmoidf_(GT[q * 132 + 64 + c]), xc = bf2f(*(const LAS unsigned short*)(XC + q * 144 + c * 2));
                const float la = coef * r, a = __expf(la), bb = sqrtf(-expm1f(2.0f * la)) * (ig * xc);
                av[i] = a; bv[i] = bb; P *= a; H = a * H + bb; }
            SEG[(seg * 64 + c) * 2] = P; SEG[(seg * 64 + c) * 2 + 1] = H;
            __syncthreads();
            float carry = hrun, mine = 0.f;
#pragma unroll
            for (int s2 = 0; s2 < 4; ++s2) { if (s2 == seg) mine = carry; carry = SEG[(s2 * 64 + c) * 2] * carry + SEG[(s2 * 64 + c) * 2 + 1]; }
            hrun = carry;
            float h = mine;
#pragma unroll
            for (int i = 0; i < 16; ++i) { const int s = 16 * seg + i, q = dir ? 63 - s : s; h = av[i] * h + bv[i];
                HOUT[(size_t)lru_row(b, isctx, p0 + q) * D + n * 64 + c] = f2bf(h); }
        }
        __syncthreads();
    }
}

__global__ void __launch_bounds__(512, 2) fwd_kernel(Args args) {
    extern __shared__ __attribute__((aligned(16))) unsigned char lds_raw[];
    Ctx C0; C0.out = args.out; C0.ws = args.ws; C0.lds = (LAS unsigned char*)lds_raw;
    C0.tid = threadIdx.x; C0.lane = C0.tid & 63; C0.wave = __builtin_amdgcn_readfirstlane(C0.tid >> 6); C0.G = gridDim.x;
    for (int u = C0.tid; u < (LDS_BYTES - LDS_CTL) / 4; u += 512) ((LAS unsigned*)(C0.lds + LDS_CTL))[u] = 0u;
    __syncthreads();
    if (C0.tid < 36) { const unsigned long long pv = (unsigned long long)args.in[C0.tid]; LAS unsigned* t = (LAS unsigned*)(C0.lds + LC_PTRS) + 2 * C0.tid; t[0] = (unsigned)pv; t[1] = (unsigned)(pv >> 32); }
    __syncthreads();
    const Ctx& C = C0;
    XcdBarrier bar = xcd_barrier_post(C.p<unsigned>(WS_CTL) + CW_BAR, (volatile LAS unsigned*)(C.lds + LC_MISC) + 8);
    const int lo = args.ph_lo, hi = args.ph_hi;
    int ph = 0;
#ifndef PHMASK
#define PHMASK 0xffffffffu
#endif
#define PH_ON(id) (((PHMASK) >> (id)) & 1u)
#define PHASE_BEGIN(id) if (PH_ON(id) && lo <= ph && ph < hi) { Ctx C = C0; asm volatile("" : "+s"(C.ws), "+s"(C.out), "+v"(C.tid)); C.lane = C.tid & 63; C.wave = __builtin_amdgcn_readfirstlane(C.tid >> 6);
#define PHASE_END(last) if (ph + 1 < hi && !(last)) xcd_barrier(bar); } ++ph;
#define PHASE_JOIN __syncthreads(); }
    const int cid = (int)blockIdx.x;

    PHASE_BEGIN(0)
        phase_transposes(C);
        __syncthreads();
        phase_s5prep(C);
        phase_ada(C);
    PHASE_END(false)

#pragma unroll 1
    for (int l = 0; l < DEPTH; ++l) {
        const int nMtok = (l == DEPTH - 1) ? 128 : 144;
        const int ntok = nMtok * 256;
        PHASE_BEGIN(1) phase_norm1(C, l); PHASE_END(false)
        PHASE_BEGIN(2)
            pg8::Gemm g{D, D, D}; SchedGrid S; S.so.init(144, 18, C.G, cid); S.A = (const char*)C.p<bf16_t>(WS_HN); S.B = (const char*)(C.p<bf16_t>(WS_WINT) + (size_t)l * INW * D); S.atile = (size_t)256 * D * 2; S.btile = (size_t)256 * D * 2;
            EpiInProj E{C.p<bf16_t>(WS_A3), C.p<bf16_t>(WS_XR), C.p<bf16_t>(WS_GG), C.p<bf16_t>(WS_M5), C.p<bf16_t>(WS_ML)};
            pg8::gemm_phase(C.lds, C.tid, g, S, E);
        PHASE_END(false)
        PHASE_BEGIN(3)
            pg8::Gemm g{16384, 256, 256}; SchedS5 S{C.G, cid, (const char*)C.p<bf16_t>(WS_A3), (const char*)(C.p<bf16_t>(WS_FT) + (size_t)l * 32 * 256 * 256), (size_t)256 * 256 * 2};
            EpiS5L1 E{C.p<float>(WS_SB)};
            pg8::gemm_phase(C.lds, C.tid, g, S, E);
        PHASE_JOIN
        PHASE_BEGIN(15) phase_lru(C, l); PHASE_END(false)
        PHASE_BEGIN(4) phase_s5carry_ol(C, l); PHASE_END(false)
        PHASE_BEGIN(5)
            pg8::Gemm g{16384, 512, 512}; SchedS5 S{C.G, cid, (const char*)C.p<bf16_t>(WS_A3), (const char*)(C.p<bf16_t>(WS_W3T) + (size_t)l * 32 * 256 * 512), (size_t)256 * 512 * 2};
            EpiS5Y E{C.p<bf16_t>(WS_GY)};
            pg8::gemm_phase(C.lds, C.tid, g, S, E);
        PHASE_END(false)
        PHASE_BEGIN(6)
            pg8::Gemm g{512, 512, 512}; SchedGrid S; S.so.init(nMtok, 2, C.G, cid); S.A = (const char*)C.p<bf16_t>(WS_GY); S.B = (const char*)(C.p<bf16_t>(WS_WGLUT) + (size_t)l * 512 * 512); S.atile = (size_t)256 * 512 * 2; S.btile = (size_t)256 * 512 * 2;
            EpiGlu E{C.p<bf16_t>(WS_GY), C.p<bf16_t>(WS_O5), C.in(18) + (size_t)l * 512};
            pg8::gemm_phase(C.lds, C.tid, g, S, E);
        PHASE_END(false)
        PHASE_BEGIN(7)
            pg8::Gemm g{512, 512, 512}; SchedGrid S; S.so.init(nMtok, 4, C.G, cid); S.A = (const char*)C.p<bf16_t>(WS_O5); S.B = (const char*)(C.p<bf16_t>(WS_WP5T) + (size_t)l * D * 512); S.atile = (size_t)256 * 512 * 2; S.btile = (size_t)256 * 512 * 2;
            EpiMulGate E{C.p<bf16_t>(WS_M5), nullptr, C.p<bf16_t>(WS_T1)};
            pg8::gemm_phase(C.lds, C.tid, g, S, E);
        PHASE_END(false)
        PHASE_BEGIN(8)
            pg8::Gemm g{D, D, D}; SchedGrid S; S.so.init(nMtok, 4, C.G, cid); S.A = (const char*)C.p<bf16_t>(WS_OL); S.B = (const char*)(C.p<bf16_t>(WS_WPLT) + (size_t)l * D * D); S.atile = (size_t)256 * D * 2; S.btile = (size_t)256 * D * 2;
            EpiMulGate E{C.p<bf16_t>(WS_ML), C.p<bf16_t>(WS_T1), C.p<bf16_t>(WS_MG)};
            pg8::gemm_phase(C.lds, C.tid, g, S, E);
        PHASE_END(false)
        PHASE_BEGIN(9)
            pg8::Gemm g{D, D, D}; SchedGrid S; S.so.init(nMtok, 4, C.G, cid); S.A = (const char*)C.p<bf16_t>(WS_MG); S.B = (const char*)(C.p<bf16_t>(WS_WOUTT) + (size_t)l * D * D); S.atile = (size_t)256 * D * 2; S.btile = (size_t)256 * D * 2;
            EpiOut E{l == 0 ? C.in(0) : C.p<float>(WS_X), l == 0 ? C.in(2) : C.p<float>(WS_X) + (size_t)NLAT * D, C.p<float>(WS_X), C.p<float>(WS_ADA), l};
            pg8::gemm_phase(C.lds, C.tid, g, S, E);
        PHASE_END(false)
        PHASE_BEGIN(10) phase_norm2(C, l, ntok); PHASE_END(false)
        PHASE_BEGIN(11) phase_slots(C, l, ntok); PHASE_END(false)
        PHASE_BEGIN(12)
            const int tt = moe_offsets(C, l, true);
            pg8::Gemm g{D, D, D}; SchedMoe S; S.so.init(tt, 8, C.G, cid); S.A = (const char*)C.p<bf16_t>(WS_XS); S.B = (const char*)(C.p<bf16_t>(WS_WUPT) + (size_t)l * NEXP * 2048 * D);
            S.atile = (size_t)256 * D * 2; S.btile = (size_t)256 * D * 2; S.bexp = (size_t)2048 * D * 2; S.tile_e = (const LAS unsigned char*)(C.lds + LC_TILE);
            EpiUp E{C.p<bf16_t>(WS_ACT), C.in(32) + (size_t)l * NEXP * 2048};
            pg8::gemm_phase(C.lds, C.tid, g, S, E);
        PHASE_END(false)
        PHASE_BEGIN(13)
            const int tt = moe_offsets(C, l, true);
            pg8::Gemm g{D, D, D}; SchedMoe S; S.so.init(tt, 4, C.G, cid); S.A = (const char*)C.p<bf16_t>(WS_ACT); S.B = (const char*)(C.p<bf16_t>(WS_WDNT) + (size_t)l * NEXP * D * D);
            S.atile = (size_t)256 * D * 2; S.btile = (size_t)256 * D * 2; S.bexp = (size_t)D * D * 2; S.tile_e = (const LAS unsigned char*)(C.lds + LC_TILE);
            EpiDown E{C.p<bf16_t>(WS_Y), C.in(34) + (size_t)l * NEXP * D};
            pg8::gemm_phase(C.lds, C.tid, g, S, E);
        PHASE_END(false)
    }
    PHASE_BEGIN(14) phase_final(C); PHASE_END(true)
}

constexpr int N_PHASES = 1 + DEPTH * 13 + 1;
extern "C" void kernel_launch(void* const* d_in, const int* in_sizes, int n_in, void* d_out, int out_size, void* d_ws, size_t ws_size, hipStream_t stream) {
    static int grid = 0;
    if (grid == 0) {
        if (n_in != 36 || ws_size < WS_END) { fprintf(stderr, "kernel_launch: need 36 inputs and >= %zu bytes of workspace; got %d, %zu\n", (size_t)WS_END, n_in, ws_size); grid = -1; return; }
        int dev = 0, cus = 0, per_cu = 0;
        if (hipGetDevice(&dev) != hipSuccess || hipDeviceGetAttribute(&cus, hipDeviceAttributeMultiprocessorCount, dev) != hipSuccess) { grid = -1; return; }
        if (hipFuncSetAttribute((const void*)fwd_kernel, hipFuncAttributeMaxDynamicSharedMemorySize, LDS_BYTES) != hipSuccess) { fprintf(stderr, "kernel_launch: hipFuncSetAttribute failed\n"); grid = -1; return; }
        if (hipOccupancyMaxActiveBlocksPerMultiprocessor(&per_cu, (const void*)fwd_kernel, 512, LDS_BYTES) != hipSuccess || per_cu < 1) fprintf(stderr, "kernel_launch: occupancy query says %d\n", per_cu);
        (void)hipGetLastError();
        grid = cus;
    }
    if (grid < 0) return;
    (void)hipMemsetAsync((char*)d_ws + WS_CTL, 0, CTL_ZERO_BYTES, stream);
    Args a{};
    for (int i = 0; i < 36; ++i) a.in[i] = (const float*)d_in[i];
    a.out = (float*)d_out; a.ws = (unsigned char*)d_ws;
#ifndef MK_SPLIT
    a.ph_lo = 0; a.ph_hi = N_PHASES;
    hipLaunchKernelGGL(fwd_kernel, dim3(grid), dim3(512), LDS_BYTES, stream, a);
#else
    for (int p = 0; p < N_PHASES; ++p) { a.ph_lo = p; a.ph_hi = p + 1; hipLaunchKernelGGL(fwd_kernel, dim3(grid), dim3(512), LDS_BYTES, stream, a); }
#endif
}
```

```cpp
#include <hip/hip_runtime.h>
#include <cstdio>
#include <cstdint>

#define LAS __attribute__((address_space(3)))
typedef unsigned short bf16_t;
typedef short bf16x8 __attribute__((ext_vector_type(8)));
typedef float f32x4 __attribute__((ext_vector_type(4)));
typedef float f32x2 __attribute__((ext_vector_type(2)));
typedef float f32x16 __attribute__((ext_vector_type(16)));
typedef unsigned u32x4 __attribute__((ext_vector_type(4)));
typedef unsigned u32x2 __attribute__((ext_vector_type(2)));
typedef int i32x4 __attribute__((ext_vector_type(4)));
typedef int i32x8 __attribute__((ext_vector_type(8)));

constexpr int D = 1024, NB = 16, SEQ = 2048, CTXL = 256, DEPTH = 4;
constexpr int NLAT = NB * SEQ, NCTX = NB * CTXL, NTOK = NLAT + NCTX;
constexpr int INW = 4608, NEXP = 32;
constexpr int NCH = 144;
constexpr int NROW3 = NB * NCH;
constexpr int MAXSLOT = NTOK * 4 + NEXP * 256;

__device__ __forceinline__ float bf2f(unsigned short b) { return __uint_as_float(((unsigned)b) << 16); }
__device__ __forceinline__ float bflo(unsigned w) { return __uint_as_float(w << 16); }
__device__ __forceinline__ float bfhi(unsigned w) { return __uint_as_float(w & 0xffff0000u); }
typedef __bf16 bf16x2_n __attribute__((ext_vector_type(2)));
__device__ __forceinline__ unsigned cvt_pk_bf16(float lo, float hi) { f32x2 v = {lo, hi}; bf16x2_n b = __builtin_convertvector(v, bf16x2_n); return __builtin_bit_cast(unsigned, b); }
__device__ __forceinline__ unsigned short f2bf(float f) { return (unsigned short)(cvt_pk_bf16(f, 0.f) & 0xffffu); }
__device__ __forceinline__ float sigmoidf_(float x) { return __builtin_amdgcn_rcpf(1.0f + __expf(-x)); }
__device__ __forceinline__ float gelu_tanh(float x) { const float z = 1.5957691216f * (x + 0.044715f * x * x * x); return x * __builtin_amdgcn_rcpf(1.0f + __expf(-z)); }
__device__ __forceinline__ float wave_sum(float v, int lane) {
#pragma unroll
    for (int o = 1; o < 64; o <<= 1) v += __builtin_bit_cast(float, __builtin_amdgcn_ds_bpermute((lane ^ o) << 2, __builtin_bit_cast(int, v)));
    return v;
}

namespace pg8 {
constexpr int BM = 256, BK = 64, HALF = 128, HTB = HALF * BK * 2, STAGE_BYTES = 8 * HTB, NXCD = 8, WGM = 8;
__host__ __device__ __forceinline__ int lds_byte(int r, int c) { const int st = (r >> 4) * 2 + (c >> 5), rr = r & 15, cc = c & 31, ob = rr * 64 + cc * 2; return st * 1024 + (ob ^ (((ob >> 9) & 1) << 5)); }
__host__ __device__ __forceinline__ void stage_rc(int b, int& R, int& C) { const int st = b / 1024, sb = b % 1024, swz = sb ^ (((sb >> 9) & 1) << 5); R = (st >> 1) * 16 + swz / 64; C = (st & 1) * 32 + (swz % 64) / 2; }
__host__ __device__ __forceinline__ int perm32(int rho) { const int n = rho >> 4, i = rho & 15; return 8 * (i >> 2) + 4 * n + (i & 3); }

constexpr int ACT8_SHIFT = 2, W8_SHIFT = 6;
struct Unit { int pm, pn, grp, hu, hoff; unsigned a, b; };
struct Gemm { int lda, ldb, K; const void* A; const void* B; };

constexpr bool TAIL_SPLIT = false;
__device__ __forceinline__ bool tail_map(long L, int nwg, int G, int& fidx, int& hu, int& hs) {
    const int r = nwg % G, F = nwg - r; hu = 0; hs = 0;
    if (!TAIL_SPLIT || r == 0 || 2 * r > G || L < F) { if (L >= nwg) return false; fidx = (int)L; return true; }
    const long h = L - F; if (h >= 2 * r) return false; fidx = F + (int)(h >> 1); hu = 1; hs = (int)(h & 1); return true;
}
struct StaticOrder {
    int nM, nN, nwg, G, c;
    __device__ void init(int nM_, int nN_, int G_, int c_) { nM = nM_; nN = nN_; nwg = nM * nN; G = G_; c = c_; }
    __device__ bool next(int i, int& pm, int& pn, int& hu, int& hs) const {
        int wgid; if (!tail_map((long)i * G + c, nwg, G, wgid, hu, hs)) return false;
        { const int q = nwg / NXCD, r = nwg % NXCD, xcd = wgid % NXCD, off = wgid / NXCD; wgid = (xcd < r ? xcd * (q + 1) : r * (q + 1) + (xcd - r) * q) + off; }
        const int nig = WGM * nN, gid = wgid / nig, fm = gid * WGM, gsz = (nM - fm) < WGM ? (nM - fm) : WGM;
        pm = fm + ((wgid % nig) % gsz); pn = (wgid % nig) / gsz; return true;
    }
};

template <class Epi, class Sched>
__device__ __forceinline__ void gemm_phase(LAS unsigned char* lds, const int tid, const Gemm g, const Sched& S, const Epi& E) {
    const int wid = __builtin_amdgcn_readfirstlane(tid >> 6), lane = tid & 63, wr = wid >> 2, wc = wid & 3, fr = lane & 15, fq = lane >> 4;
    const int K = g.K, nt = K / BK;
    unsigned voffA[2], voffB[2];
#pragma unroll
    for (int i = 0; i < 2; ++i) { int R, C; stage_rc(tid * 16 + i * 8192, R, C); const int Rb = Epi::PERM ? ((R & ~31) + perm32(R & 31)) : R;
        voffA[i] = (unsigned)(R * g.lda + C) * 2u; voffB[i] = (unsigned)(Rb * g.ldb + C) * 2u; }
    constexpr bool GA = Sched::GATHER, F8 = Sched::F8;
    const unsigned long long _pa = (unsigned long long)g.A, _pb = (unsigned long long)g.B;
    void* const uA = (void*)(((unsigned long long)(unsigned)__builtin_amdgcn_readfirstlane((int)(_pa >> 32)) << 32) | (unsigned)__builtin_amdgcn_readfirstlane((int)_pa));
    void* const uB = (void*)(((unsigned long long)(unsigned)__builtin_amdgcn_readfirstlane((int)(_pb >> 32)) << 32) | (unsigned)__builtin_amdgcn_readfirstlane((int)_pb));
    const __amdgpu_buffer_rsrc_t rsA = __builtin_amdgcn_make_buffer_rsrc(uA, 0, 0x7fffffff, 0x00020000), rsB = __builtin_amdgcn_make_buffer_rsrc(uB, 0, 0x7fffffff, 0x00020000);
    const unsigned kstep = (unsigned)(BK * 2);
    const unsigned hstepA = GA ? 0u : (unsigned)HALF * g.lda * 2, hstepB = (unsigned)HALF * g.ldb * 2;
    unsigned vA[2][2], vN[2][2];
#define PG8_ROWS(u, v) do { if constexpr (GA) { const i32x4 _t = S.rowtab4[(u).pm * 512 + tid]; const bool _hh = (u).hoff != 0;     \
        v[0][0] = (unsigned)(_hh ? _t.z : _t.x); v[0][1] = (unsigned)(_hh ? _t.w : _t.y); v[1][0] = (unsigned)_t.z; v[1][1] = (unsigned)_t.w; } \
        else { _Pragma("unroll") for (int _h = 0; _h < 2; ++_h) { v[_h][0] = voffA[0]; v[_h][1] = voffA[1]; } } } while (0)
#define PG8_SEL(h, usenext) unsigned vs[2] = { (usenext) ? vN[h][0] : vA[h][0], (usenext) ? vN[h][1] : vA[h][1] }
    const unsigned ldsw = (unsigned)wid * 1024u;
    const int aoff = lds_byte(wr * 64 + fr, fq * 8), boff = lds_byte(wc * 32 + fr, fq * 8);
#define PG8_SA(b, h) (((b) * 2 + (h)) * HTB)
#define PG8_SB(b, h) ((4 + (b) * 2 + (h)) * HTB)
#define PG8_STAGEX(rs, bufoff, soff, voff) do { _Pragma("unroll") for (int _i = 0; _i < 2; ++_i) \
        __builtin_amdgcn_raw_ptr_buffer_load_lds(rs, (LAS void*)(lds + (bufoff) + ldsw + _i * 8192), 16, (int)(voff)[_i], (int)(soff), 0, 0); } while (0)
#define PG8_STAGEA(bufoff, soff, voff) PG8_STAGEX(rsA, bufoff, soff, voff)
#define PG8_STAGEB(bufoff, soff, voff) PG8_STAGEX(rsB, bufoff, soff, voff)
#define PG8_LDA(dst, b, h) do { _Pragma("unroll") for (int m = 0; m < 4; ++m) _Pragma("unroll") for (int k = 0; k < 2; ++k) dst[m][k] = *(const LAS bf16x8*)(lds + PG8_SA(b, h) + aoff + m * 2048 + k * 1024); } while (0)
#define PG8_LDB(dst, b, h) do { _Pragma("unroll") for (int n = 0; n < 2; ++n) _Pragma("unroll") for (int k = 0; k < 2; ++k) dst[n][k] = *(const LAS bf16x8*)(lds + PG8_SB(b, h) + boff + n * 2048 + k * 1024); } while (0)
#define PG8_CAT(x) __builtin_shufflevector(__builtin_bit_cast(i32x4, (x)[0]), __builtin_bit_cast(i32x4, (x)[1]), 0, 1, 2, 3, 4, 5, 6, 7)
#define PG8_MMA(ai, bj, At, Bt) do { __builtin_amdgcn_s_setprio(1); if constexpr (F8) { _Pragma("unroll") for (int m = 0; m < 4; ++m) _Pragma("unroll") for (int n = 0; n < 2; ++n) \
        acc[ai][bj][m][n] = __builtin_amdgcn_mfma_scale_f32_16x16x128_f8f6f4(PG8_CAT(Bt[n]), PG8_CAT(At[m]), acc[ai][bj][m][n], 0, 0, 0, Sched::SCALE_B, 0, Sched::SCALE_A); } else { \
        _Pragma("unroll") for (int m = 0; m < 4; ++m) _Pragma("unroll") for (int n = 0; n < 2; ++n) _Pragma("unroll") for (int k = 0; k < 2; ++k) \
        acc[ai][bj][m][n] = __builtin_amdgcn_mfma_f32_16x16x32_bf16(Bt[n][k], At[m][k], acc[ai][bj][m][n], 0, 0, 0); } __builtin_amdgcn_s_setprio(0); } while (0)
#define PG8_WAIT_V(n) asm volatile("s_waitcnt vmcnt(" #n ")" ::: "memory")
#define PG8_WAIT_L(n) asm volatile("s_waitcnt lgkmcnt(" #n ")" ::: "memory")
#define PG8_BAR __builtin_amdgcn_s_barrier()
#define PG8_SCHED __builtin_amdgcn_sched_barrier(0)
    Unit cur, nxt; int ui = 0;
    if (!S.next(0, cur)) return;
    f32x4 acc[2][2][4][2];
#pragma unroll
    for (int a = 0; a < 2; ++a)
#pragma unroll
        for (int b = 0; b < 2; ++b)
#pragma unroll
            for (int m = 0; m < 4; ++m)
#pragma unroll
                for (int n = 0; n < 2; ++n) acc[a][b][m][n] = (f32x4){0.f, 0.f, 0.f, 0.f};
    bf16x8 At[4][2], B0[2][2], B1[2][2];
    unsigned cA = cur.a, cB = cur.b;
    PG8_ROWS(cur, vA);
    PG8_STAGEB(PG8_SB(0, 0), cB, voffB); PG8_STAGEB(PG8_SB(0, 1), cB + hstepB, voffB); PG8_STAGEA(PG8_SA(0, 0), cA, vA[0]); PG8_STAGEA(PG8_SA(0, 1), cA + hstepA, vA[1]);
    if (wr == 1) PG8_BAR;
    PG8_WAIT_V(2); PG8_BAR;
    PG8_STAGEB(PG8_SB(1, 0), cB + kstep, voffB); PG8_STAGEA(PG8_SA(1, 0), cA + kstep, vA[0]); PG8_STAGEB(PG8_SB(1, 1), cB + hstepB + kstep, voffB);
    PG8_WAIT_V(6); PG8_BAR;
    for (;;) {
        const bool has_next = S.next(ui + 1, nxt);
        const unsigned nA = has_next ? nxt.a : cA, nB = has_next ? nxt.b : cB;
        if (GA) { if (has_next) PG8_ROWS(nxt, vN); else { _Pragma("unroll") for (int _h = 0; _h < 2; ++_h) { vN[_h][0] = vA[_h][0]; vN[_h][1] = vA[_h][1]; } } }
#pragma unroll 1
        for (int t = 0; t < nt; t += 2) {
            const bool last = (t == nt - 2);
            const unsigned a1 = cA + (unsigned)(t + 1) * kstep;
            const unsigned a2 = last ? nA : cA + (unsigned)(t + 2) * kstep, b2 = last ? nB : cB + (unsigned)(t + 2) * kstep;
            const unsigned a3 = a2 + kstep, b3 = b2 + kstep;
            const bool un = GA && last, hu = cur.hu != 0;
            PG8_LDB(B0, 0, 0); PG8_LDB(B1, 0, 1); PG8_SCHED; PG8_LDA(At, 0, 0); PG8_STAGEA(PG8_SA(1, 1), a1 + hstepA, vA[1]);
            PG8_WAIT_V(8); PG8_WAIT_L(0); PG8_BAR; PG8_MMA(0, 0, At, B0); PG8_MMA(0, 1, At, B1); PG8_BAR; PG8_SCHED;
            { PG8_SEL(0, un); if (!hu) PG8_LDA(At, 0, 1); PG8_STAGEB(PG8_SB(0, 0), b2, voffB); PG8_STAGEB(PG8_SB(0, 1), b2 + hstepB, voffB); PG8_STAGEA(PG8_SA(0, 0), a2, vs); }
            PG8_WAIT_V(8); PG8_WAIT_L(0); PG8_BAR; if (!hu) { PG8_MMA(1, 0, At, B0); PG8_MMA(1, 1, At, B1); } PG8_BAR; PG8_SCHED;
            { PG8_SEL(1, un); PG8_LDB(B0, 1, 0); PG8_LDB(B1, 1, 1); PG8_SCHED; PG8_LDA(At, 1, 0); PG8_STAGEA(PG8_SA(0, 1), a2 + hstepA, vs); }
            PG8_WAIT_V(8); PG8_WAIT_L(0); PG8_BAR; PG8_MMA(0, 0, At, B0); PG8_MMA(0, 1, At, B1); PG8_BAR; PG8_SCHED;
            { PG8_SEL(0, un); if (!hu) PG8_LDA(At, 1, 1); PG8_STAGEB(PG8_SB(1, 0), b3, voffB); PG8_STAGEB(PG8_SB(1, 1), b3 + hstepB, voffB); PG8_STAGEA(PG8_SA(1, 0), a3, vs); }
            PG8_WAIT_V(8); PG8_WAIT_L(0); PG8_BAR; if (!hu) { PG8_MMA(1, 0, At, B0); PG8_MMA(1, 1, At, B1); } PG8_BAR; PG8_SCHED;
        }
        if (wr == 0) PG8_BAR;
        E(acc, cur, wr, wc, fr, fq);
        if (!has_next) break;
#pragma unroll
        for (int a = 0; a < 2; ++a)
#pragma unroll
            for (int b = 0; b < 2; ++b)
#pragma unroll
                for (int m = 0; m < 4; ++m)
#pragma unroll
                    for (int n = 0; n < 2; ++n) acc[a][b][m][n] = (f32x4){0.f, 0.f, 0.f, 0.f};
        cur = nxt; cA = nA; cB = nB; ++ui;
        if (GA) {
#pragma unroll
            for (int _h = 0; _h < 2; ++_h) { vA[_h][0] = vN[_h][0]; vA[_h][1] = vN[_h][1]; } }
        if (wr == 1) PG8_BAR;
    }
    PG8_WAIT_V(0);
    PG8_BAR;
#undef PG8_SA
#undef PG8_CAT
#undef PG8_ROWS
#undef PG8_SEL
#undef PG8_SB
#undef PG8_STAGEX
#undef PG8_STAGEA
#undef PG8_STAGEB
#undef PG8_LDA
#undef PG8_LDB
#undef PG8_MMA
#undef PG8_WAIT_V
#undef PG8_WAIT_L
#undef PG8_BAR
#undef PG8_SCHED
}
}
using pg8::Unit;

#define XB_TMO      128
#define XB_XCNT(j)  (256  + 64 * (j))
#define XB_XSUB(j)  (1280 + 64 * (j))
#define XB_XGEN(j)  (2304 + 64 * (j))
#define XB_TOP      3328
#define XB_TOPGEN   3392
#define XCD_BAR_WORDS 3456
#define XB_SPIN_CAP (1u << 18)
__device__ __forceinline__ unsigned xb_ld(unsigned* p)              { return __hip_atomic_load(p, __ATOMIC_RELAXED, __HIP_MEMORY_SCOPE_AGENT); }
__device__ __forceinline__ unsigned xb_add(unsigned* p, unsigned v) { return __hip_atomic_fetch_add(p, v, __ATOMIC_RELAXED, __HIP_MEMORY_SCOPE_AGENT); }
__device__ __forceinline__ unsigned xb_xcc_id() { return (unsigned)__builtin_amdgcn_s_getreg((3 << 11) | 20) & 0xFu; }
#define XB_SPIN(cond, bar) do { unsigned _sp = 0; while (cond) { __builtin_amdgcn_s_sleep(1); \
    if ((++_sp & 255u) == 0u) { if (xb_ld(&(bar)[XB_TMO])) break; if (_sp > XB_SPIN_CAP) { atomicAdd(&(bar)[XB_TMO], 1u); break; } } } } while (0)
struct XcdBarrier { unsigned* bar; unsigned x; volatile LAS unsigned* st; };
__device__ __forceinline__ XcdBarrier xcd_barrier_post(unsigned* bar, volatile LAS unsigned* st) {
    XcdBarrier b; b.bar = bar; b.x = xb_xcc_id(); b.st = st;
    if (threadIdx.x == 0) (void)xb_add(&bar[XB_XCNT(b.x)], 1u);
    return b;
}
__device__ __forceinline__ void xcd_barrier_complete(unsigned* bar, unsigned x, unsigned& nloc, unsigned& nx) {
    const unsigned G = gridDim.x * gridDim.y * gridDim.z;
    unsigned sum, cnt, mine, sp = 0u;
    for (;;) {
        sum = 0u; cnt = 0u; mine = 0u;
#pragma unroll
        for (unsigned j = 0; j < 16; ++j) { const unsigned c = xb_ld(&bar[XB_XCNT(j)]); sum += c; cnt += (c > 0u) ? 1u : 0u; mine = (j == x) ? c : mine; }
        if (sum == G) break;
        __builtin_amdgcn_s_sleep(1);
        if ((++sp & 255u) == 0u) { if (xb_ld(&bar[XB_TMO])) break; if (sp > XB_SPIN_CAP) { atomicAdd(&bar[XB_TMO], 1u); break; } }
    }
    nloc = mine > 0u ? mine : 1u; nx = cnt > 0u ? cnt : 1u;
}
__device__ __forceinline__ void xcd_barrier(const XcdBarrier& b) {
    asm volatile("s_waitcnt vmcnt(0)" ::: "memory");
    __syncthreads();
    if (threadIdx.x == 0) {
        unsigned* bar = b.bar;
        __builtin_amdgcn_s_waitcnt(0);
        unsigned nloc = b.st[0], nx = b.st[1];
        if (nloc == 0u) { xcd_barrier_complete(bar, b.x, nloc, nx); b.st[0] = nloc; b.st[1] = nx; }
        const unsigned old = xb_add(&bar[XB_XSUB(b.x)], 1u);
        const unsigned gen = old / nloc;
        if (old + 1u == (gen + 1u) * nloc) {
            __builtin_amdgcn_fence(__ATOMIC_RELEASE, "agent");
            asm volatile("s_waitcnt vmcnt(0)" ::: "memory");
            const unsigned og = xb_add(&bar[XB_TOP], 1u);
            const unsigned tg = og / nx;
            if (og + 1u == (tg + 1u) * nx) xb_add(&bar[XB_TOPGEN], 1u);
            else XB_SPIN(xb_ld(&bar[XB_TOPGEN]) == tg, bar);
            __builtin_amdgcn_fence(__ATOMIC_ACQUIRE, "agent");
            xb_add(&bar[XB_XGEN(b.x)], 1u);
            asm volatile("s_waitcnt vmcnt(0)" ::: "memory");
        } else {
            XB_SPIN(xb_ld(&bar[XB_XGEN(b.x)]) == gen, bar);
            __builtin_amdgcn_fence(__ATOMIC_ACQUIRE, "agent");
            asm volatile("s_waitcnt vmcnt(0)" ::: "memory");
        }
    }
    __syncthreads();
}

constexpr size_t al256(size_t x) { return (x + 255) & ~(size_t)255; }
constexpr size_t WS_CTL = 0, CTL_ZERO_BYTES = 1u << 20;
constexpr int CW_QUEUE = 2048;
constexpr int CW_CNT = 1024;
constexpr int CW_BAR = 4096;
constexpr size_t WS_ADA   = CTL_ZERO_BYTES;
constexpr size_t WS_DEC   = al256(WS_ADA + (size_t)DEPTH * 17 * 6144 * 4);
constexpr size_t WS_W3T   = al256(WS_DEC + (size_t)DEPTH * 2 * 32 * 64 * 2 * 4);
constexpr size_t WS_FT    = al256(WS_W3T + (size_t)DEPTH * 32 * 256 * 512 * 2);
constexpr size_t WS_WINT  = al256(WS_FT + (size_t)DEPTH * 32 * 256 * 256 * 2);
constexpr size_t WS_WGLUT = al256(WS_WINT + (size_t)DEPTH * INW * D * 2);
constexpr size_t WS_WP5T  = al256(WS_WGLUT + (size_t)DEPTH * 512 * 512 * 2);
constexpr size_t WS_WPLT  = al256(WS_WP5T + (size_t)DEPTH * D * 512 * 2);
constexpr size_t WS_WOUTT = al256(WS_WPLT + (size_t)DEPTH * D * D * 2);
constexpr size_t WS_WUPT  = al256(WS_WOUTT + (size_t)DEPTH * D * D * 2);
constexpr size_t WS_WDNT  = al256(WS_WUPT + (size_t)DEPTH * NEXP * 2048 * D * 2);
constexpr size_t WS_X     = al256(WS_WDNT + (size_t)DEPTH * NEXP * D * D * 2);
constexpr size_t WS_HN    = al256(WS_X + (size_t)NTOK * D * 4);
constexpr size_t WS_A3    = al256(WS_HN + (size_t)NTOK * D * 2);
constexpr size_t WS_SB    = al256(WS_A3 + (size_t)NROW3 * 32 * 512 * 2);
constexpr size_t WS_XR    = al256(WS_SB + (size_t)NROW3 * 32 * 256 * 4);
constexpr size_t WS_GG    = al256(WS_XR + (size_t)NTOK * D * 2);
constexpr size_t WS_M5    = al256(WS_GG + (size_t)NTOK * D * 2);
constexpr size_t WS_ML    = al256(WS_M5 + (size_t)NTOK * D * 2);
constexpr size_t WS_HF    = al256(WS_ML + (size_t)NTOK * D * 2);
constexpr size_t WS_HB    = al256(WS_HF + (size_t)NTOK * D * 2);
constexpr size_t WS_OL    = al256(WS_HB + (size_t)NTOK * D * 2);
constexpr size_t WS_GY    = al256(WS_OL + (size_t)NTOK * D * 2);
constexpr size_t WS_O5    = al256(WS_GY + (size_t)NTOK * 512 * 2);
constexpr size_t WS_T1    = al256(WS_O5 + (size_t)NTOK * 512 * 2);
constexpr size_t WS_MG    = al256(WS_T1 + (size_t)NTOK * D * 2);
constexpr size_t WS_TOKE  = al256(WS_MG + (size_t)NTOK * D * 2);
constexpr size_t WS_TOKP  = al256(WS_TOKE + (size_t)NTOK * 4 * 4);
constexpr size_t WS_TOKW  = al256(WS_TOKP + (size_t)NTOK * 4 * 4);
constexpr size_t WS_SLOT  = al256(WS_TOKW + (size_t)NTOK * 4 * 4);
constexpr size_t WS_XS    = al256(WS_SLOT + (size_t)NTOK * 4 * 4);
constexpr size_t WS_ACT   = al256(WS_XS + (size_t)MAXSLOT * D * 2);
constexpr size_t WS_Y     = al256(WS_ACT + (size_t)MAXSLOT * D * 2);
constexpr size_t WS_END   = al256(WS_Y + (size_t)MAXSLOT * D * 2);

constexpr int LDS_BYTES = 147456;
constexpr int LDS_CTL = 143360;
constexpr int LC_MISC = LDS_CTL;
constexpr int LC_OFFS = LDS_CTL + 256;
constexpr int LC_LCNT = LDS_CTL + 512;
constexpr int LC_GB   = LDS_CTL + 768;
constexpr int LC_TILE = LDS_CTL + 1024;
constexpr int LC_PTRS = LDS_CTL + 2048;

struct Args { const float* in[36]; float* out; unsigned char* ws; int ph_lo, ph_hi; };

struct Ctx {
    float* out; unsigned char* ws; LAS unsigned char* lds; int tid, lane, wave, G;
    template <class T> __device__ __forceinline__ T* p(size_t off) const { return (T*)(ws + off); }
    __device__ __forceinline__ const float* in(int k) const { const LAS unsigned* t = (const LAS unsigned*)(lds + LC_PTRS) + 2 * k;
        const unsigned lo = __builtin_amdgcn_readfirstlane(t[0]), hi = __builtin_amdgcn_readfirstlane(t[1]); return (const float*)(((unsigned long long)hi << 32) | lo); }
};

struct SchedGrid {
    static constexpr bool GATHER = false, F8 = false; static constexpr int SCALE_A = 127 * 0x01010101, SCALE_B = 127 * 0x01010101, rowmax = 0; const __attribute__((address_space(1))) i32x4* rowtab4;
    pg8::StaticOrder so; unsigned atile, btile;
    __device__ __forceinline__ bool next(int i, Unit& u) const { int hs; if (!so.next(i, u.pm, u.pn, u.hu, hs)) return false; u.grp = 0; u.hoff = hs * 128; u.a = (unsigned)u.pm * atile + (unsigned)hs * (atile >> 1); u.b = (unsigned)u.pn * btile; return true; }
};
struct SchedS5 {
    static constexpr bool GATHER = false, F8 = false; static constexpr int SCALE_A = 127 * 0x01010101, SCALE_B = 127 * 0x01010101, rowmax = 0; const __attribute__((address_space(1))) i32x4* rowtab4; int G, c; unsigned bgrp;
    __device__ __forceinline__ bool next(int i, Unit& u) const { int L, hs; if (!pg8::tail_map((long)i * G + c, 288, G, L, u.hu, hs)) return false; const int g = L / 9, pm = L - g * 9; u.pm = pm; u.pn = 0; u.grp = g; u.hoff = hs * 128;
        u.a = ((unsigned)(pm * 256 + hs * 128) * 16384 + (unsigned)g * 512) * 2; u.b = (unsigned)g * bgrp; return true; }
};
template <bool GA, bool F8_>
struct SchedMoe {
    int rowmax; static constexpr bool GATHER = GA, F8 = F8_; static constexpr int SCALE_A = (127 - pg8::ACT8_SHIFT) * 0x01010101, SCALE_B = (127 - pg8::W8_SHIFT) * 0x01010101;
    const __attribute__((address_space(1))) i32x4* rowtab4; pg8::StaticOrder so; unsigned atile, btile, bexp; const LAS unsigned char* tile_e;
    __device__ __forceinline__ bool next(int i, Unit& u) const { int hs; if (!so.next(i, u.pm, u.pn, u.hu, hs)) return false; u.grp = tile_e[u.pm]; u.hoff = hs * 128; u.a = GA ? 0u : (unsigned)u.pm * atile + (unsigned)hs * (atile >> 1); u.b = (unsigned)u.grp * bexp + (unsigned)u.pn * btile; return true; }
};

#define EPI_ROWS_BEGIN  _Pragma("unroll") for (int ai = 0; ai < 2; ++ai) _Pragma("unroll") for (int m = 0; m < 4; ++m) { if (ai == 1 && u.hu) continue; const int row = u.pm * 256 + u.hoff + ai * 128 + wr * 64 + m * 16 + fr;
#define EPI_ROWS_END    asm volatile("" ::: "memory"); }
__device__ __forceinline__ u32x4 pack8(const f32x4 a, const f32x4 b) { u32x4 w; w.x = cvt_pk_bf16(a[0], a[1]); w.y = cvt_pk_bf16(a[2], a[3]); w.z = cvt_pk_bf16(b[0], b[1]); w.w = cvt_pk_bf16(b[2], b[3]); return w; }
__device__ __forceinline__ void unpack8(const u32x4 w, f32x4& a, f32x4& b) { a = (f32x4){bflo(w.x), bfhi(w.x), bflo(w.y), bfhi(w.y)}; b = (f32x4){bflo(w.z), bfhi(w.z), bflo(w.w), bfhi(w.w)}; }

struct EpiInProj {
    static constexpr bool PERM = true;
    bf16_t *A3, *XR, *GG, *M5, *ML;
    __device__ __forceinline__ void operator()(const f32x4 (&acc)[2][2][4][2], const Unit& u, int wr, int wc, int fr, int fq) const {
        const int pn = u.pn;
        EPI_ROWS_BEGIN
#pragma unroll
            for (int bj = 0; bj < 2; ++bj) {
                const int col = pn * 256 + bj * 128 + wc * 32 + 8 * fq; f32x4 v0 = acc[ai][bj][m][0], v1 = acc[ai][bj][m][1];
                if (pn < 2) {
                    int b, cidx, j; if (row < NLAT) { b = row >> 11; const int t = row & 2047; cidx = 16 + (t >> 4); j = t & 15; } else { const int rr = row - NLAT; b = rr >> 8; const int tc = rr & 255; cidx = tc >> 4; j = tc & 15; }
                    const int g = col >> 4, h = col & 15;
                    *(u32x4*)(A3 + ((size_t)((b * NCH + cidx) * 32 + g)) * 512 + j * 16 + h) = pack8(v0, v1);
                } else if (pn < 6) {
                    *(u32x4*)(XR + (size_t)row * D + (col - 512)) = pack8(v0, v1);
                } else if (pn < 10) {
#pragma unroll
                    for (int q = 0; q < 4; ++q) { v0[q] = gelu_tanh(v0[q]); v1[q] = gelu_tanh(v1[q]); }
                    *(u32x4*)(GG + (size_t)row * D + (col - 1536)) = pack8(v0, v1);
                } else {
#pragma unroll
                    for (int q = 0; q < 4; ++q) { v0[q] = sigmoidf_(v0[q]); v1[q] = sigmoidf_(v1[q]); }
                    bf16_t* dst = pn < 14 ? M5 + (size_t)row * D + (col - 2560) : ML + (size_t)row * D + (col - 3584);
                    *(u32x4*)dst = pack8(v0, v1);
                }
            }
        EPI_ROWS_END
    }
};
struct EpiS5L1 {
    static constexpr bool PERM = false;
    float* S;
    __device__ __forceinline__ void operator()(const f32x4 (&acc)[2][2][4][2], const Unit& u, int wr, int wc, int fr, int fq) const {
        EPI_ROWS_BEGIN
            float* rowp = S + ((size_t)row * 32 + u.grp) * 256 + wc * 32 + 4 * fq;
#pragma unroll
            for (int bj = 0; bj < 2; ++bj)
#pragma unroll
                for (int n = 0; n < 2; ++n) *(f32x4*)(rowp + bj * 128 + n * 16) = acc[ai][bj][m][n];
        EPI_ROWS_END
    }
};
struct EpiS5Y {
    static constexpr bool PERM = true;
    bf16_t* GY;
    __device__ __forceinline__ void operator()(const f32x4 (&acc)[2][2][4][2], const Unit& u, int wr, int wc, int fr, int fq) const {
        EPI_ROWS_BEGIN
            const int b = row / NCH, cidx = row - b * NCH;
            const int tok0 = cidx < 16 ? NLAT + b * 256 + cidx * 16 : b * 2048 + (cidx - 16) * 16;
#pragma unroll
            for (int bj = 0; bj < 2; ++bj) {
                const int col = bj * 128 + wc * 32 + 8 * fq, j = col >> 4, h = col & 15; f32x4 v0 = acc[ai][bj][m][0], v1 = acc[ai][bj][m][1];
#pragma unroll
                for (int q = 0; q < 4; ++q) { v0[q] = gelu_tanh(v0[q]); v1[q] = gelu_tanh(v1[q]); }
                *(u32x4*)(GY + (size_t)(tok0 + j) * 512 + u.grp * 16 + h) = pack8(v0, v1);
            }
        EPI_ROWS_END
    }
};
#define GAS __attribute__((address_space(1)))
struct EpiGlu {
    static constexpr bool PERM = true;
    const bf16_t* GY; bf16_t* O5; const float* bias;
    __device__ __forceinline__ void operator()(const f32x4 (&acc)[2][2][4][2], const Unit& u, int wr, int wc, int fr, int fq) const {
        const int col0 = u.pn * 256 + wc * 32 + 8 * fq;
        f32x4 bb[2][2];
#pragma unroll
        for (int bj = 0; bj < 2; ++bj) { bb[bj][0] = *(const GAS f32x4*)(bias + col0 + bj * 128); bb[bj][1] = *(const GAS f32x4*)(bias + col0 + bj * 128 + 4); }
#pragma unroll
        for (int ai = 0; ai < 2; ++ai) {
            if (ai == 1 && u.hu) break;
            const size_t r0 = (size_t)(u.pm * 256 + u.hoff + ai * 128 + wr * 64 + fr) * 512 + col0;
            u32x4 gy[4][2];
#pragma unroll
            for (int m = 0; m < 4; ++m)
#pragma unroll
                for (int bj = 0; bj < 2; ++bj) gy[m][bj] = *(const GAS u32x4*)(GY + r0 + (size_t)m * 16 * 512 + bj * 128);
#pragma unroll
            for (int m = 0; m < 4; ++m)
#pragma unroll
                for (int bj = 0; bj < 2; ++bj) { f32x4 v0 = acc[ai][bj][m][0], v1 = acc[ai][bj][m][1], g0, g1; unpack8(gy[m][bj], g0, g1);
#pragma unroll
                    for (int q = 0; q < 4; ++q) { v0[q] = g0[q] * sigmoidf_(v0[q] + bb[bj][0][q]); v1[q] = g1[q] * sigmoidf_(v1[q] + bb[bj][1][q]); }
                    *(GAS u32x4*)(O5 + r0 + (size_t)m * 16 * 512 + bj * 128) = pack8(v0, v1); }
            asm volatile("" ::: "memory");
        }
    }
};
struct EpiMulGate {
    static constexpr bool PERM = true;
    const bf16_t* GATE; const bf16_t* ADD; bf16_t* O;
    __device__ __forceinline__ void operator()(const f32x4 (&acc)[2][2][4][2], const Unit& u, int wr, int wc, int fr, int fq) const {
#pragma unroll
        for (int ai = 0; ai < 2; ++ai) {
            if (ai == 1 && u.hu) break;
            const size_t r0 = (size_t)(u.pm * 256 + u.hoff + ai * 128 + wr * 64 + fr) * D + u.pn * 256 + wc * 32 + 8 * fq;
            u32x4 gt[4][2], ad[4][2];
#pragma unroll
            for (int m = 0; m < 4; ++m)
#pragma unroll
                for (int bj = 0; bj < 2; ++bj) { gt[m][bj] = *(const GAS u32x4*)(GATE + r0 + (size_t)m * 16 * D + bj * 128); if (ADD) ad[m][bj] = *(const GAS u32x4*)(ADD + r0 + (size_t)m * 16 * D + bj * 128); }
#pragma unroll
            for (int m = 0; m < 4; ++m)
#pragma unroll
                for (int bj = 0; bj < 2; ++bj) { f32x4 v0 = acc[ai][bj][m][0], v1 = acc[ai][bj][m][1], g0, g1; unpack8(gt[m][bj], g0, g1); v0 = v0 * g0; v1 = v1 * g1;
                    if (ADD) { f32x4 a0, a1; unpack8(ad[m][bj], a0, a1); v0 = v0 + a0; v1 = v1 + a1; }
                    *(GAS u32x4*)(O + r0 + (size_t)m * 16 * D + bj * 128) = pack8(v0, v1); }
            asm volatile("" ::: "memory");
        }
    }
};
struct EpiOut {
    static constexpr bool PERM = true;
    const float* xlat; const float* xctx; bf16_t* X; const float* ada; int l;
    __device__ __forceinline__ void operator()(const f32x4 (&acc)[2][2][4][2], const Unit& u, int wr, int wc, int fr, int fq) const {
        const int bsel = u.pm < 128 ? (u.pm >> 3) : 16;
        const float* gate = ada + ((size_t)(l * 17 + bsel) * 6 + 2) * D;
        const int col0 = u.pn * 256 + wc * 32 + 8 * fq;
        f32x4 gv[2][2];
#pragma unroll
        for (int bj = 0; bj < 2; ++bj)
#pragma unroll
            for (int n = 0; n < 2; ++n) gv[bj][n] = *(const GAS f32x4*)(gate + col0 + bj * 128 + n * 4);
        const float* srcb = u.pm < 128 ? xlat + (size_t)u.pm * 256 * D : xctx + (size_t)(u.pm - 128) * 256 * D;
        bf16_t* xb = X + (size_t)u.pm * 256 * D;
#pragma unroll
        for (int ai = 0; ai < 2; ++ai) {
            if (ai == 1 && u.hu) break;
            const size_t rr = (size_t)(u.hoff + ai * 128 + wr * 64 + fr) * D + col0;
            f32x4 xs[4][2][2];
            if (l == 0) {
#pragma unroll
                for (int m = 0; m < 4; ++m)
#pragma unroll
                    for (int bj = 0; bj < 2; ++bj)
#pragma unroll
                        for (int n = 0; n < 2; ++n) xs[m][bj][n] = *(const GAS f32x4*)(srcb + rr + (size_t)m * 16 * D + bj * 128 + n * 4);
            } else {
                u32x4 xr[4][2];
#pragma unroll
                for (int m = 0; m < 4; ++m)
#pragma unroll
                    for (int bj = 0; bj < 2; ++bj) xr[m][bj] = *(const GAS u32x4*)(xb + rr + (size_t)m * 16 * D + bj * 128);
#pragma unroll
                for (int m = 0; m < 4; ++m)
#pragma unroll
                    for (int bj = 0; bj < 2; ++bj) unpack8(xr[m][bj], xs[m][bj][0], xs[m][bj][1]);
            }
#pragma unroll
            for (int m = 0; m < 4; ++m)
#pragma unroll
                for (int bj = 0; bj < 2; ++bj)
                    *(GAS u32x4*)(xb + rr + (size_t)m * 16 * D + bj * 128) = pack8(xs[m][bj][0] + gv[bj][0] * acc[ai][bj][m][0], xs[m][bj][1] + gv[bj][1] * acc[ai][bj][m][1]);
            asm volatile("" ::: "memory");
        }
    }
};
struct EpiUp {
    static constexpr bool PERM = true;
    bf16_t* ACT; const float* bup;
    __device__ __forceinline__ void operator()(const f32x4 (&acc)[2][2][4][2], const Unit& u, int wr, int wc, int fr, int fq) const {
        const int a0 = u.pn * 128 + wc * 32 + 8 * fq;
        const float* bp = bup + (size_t)u.grp * 2048 + 2 * a0;
        constexpr float SC = (float)(1 << pg8::ACT8_SHIFT);
        float bg[8], bu4[8];
#pragma unroll
        for (int q = 0; q < 4; ++q) { const f32x4 t = *(const GAS f32x4*)(bp + 4 * q); bg[2 * q] = t[0]; bu4[2 * q] = SC * t[1] + SC; bg[2 * q + 1] = t[2]; bu4[2 * q + 1] = SC * t[3] + SC; }
        EPI_ROWS_BEGIN
            float o[8];
#pragma unroll
            for (int q = 0; q < 8; ++q) {
                const float gt = fminf(acc[ai][0][m][q >> 2][q & 3] + bg[q], 7.0f);
                const float u4 = __builtin_amdgcn_fmed3f(fmaf(acc[ai][1][m][q >> 2][q & 3], SC, bu4[q]), -6.0f * SC, 8.0f * SC);
                const float e = __builtin_amdgcn_exp2f(gt * (-1.702f * 1.4426950409f));
                o[q] = (gt * __builtin_amdgcn_rcpf(1.0f + e)) * u4;
            }
            int p0 = 0, p1 = 0;
            p0 = __builtin_amdgcn_cvt_pk_fp8_f32(o[0], o[1], p0, false); p0 = __builtin_amdgcn_cvt_pk_fp8_f32(o[2], o[3], p0, true);
            p1 = __builtin_amdgcn_cvt_pk_fp8_f32(o[4], o[5], p1, false); p1 = __builtin_amdgcn_cvt_pk_fp8_f32(o[6], o[7], p1, true);
            *(GAS u32x2*)((unsigned char*)ACT + (size_t)row * D + a0) = (u32x2){(unsigned)p0, (unsigned)p1};
        EPI_ROWS_END
    }
};
struct EpiDown {
    static constexpr bool PERM = true;
    bf16_t* Y; const float* bdn; const int* TS;
    __device__ __forceinline__ void operator()(const f32x4 (&acc)[2][2][4][2], const Unit& u, int wr, int wc, int fr, int fq) const {
        int dst[2][4];
#pragma unroll
        for (int ai = 0; ai < 2; ++ai)
#pragma unroll
            for (int m = 0; m < 4; ++m) dst[ai][m] = (ai == 1 && u.hu) ? -1 : TS[u.pm * 256 + u.hoff + ai * 128 + wr * 64 + m * 16 + fr];
#pragma unroll
        for (int bj = 0; bj < 2; ++bj) {
            const int col = u.pn * 256 + bj * 128 + wc * 32 + 8 * fq;
            const f32x4 b0 = *(const f32x4*)(bdn + (size_t)u.grp * D + col), b1 = *(const f32x4*)(bdn + (size_t)u.grp * D + col + 4);
#pragma unroll
            for (int ai = 0; ai < 2; ++ai)
#pragma unroll
                for (int m = 0; m < 4; ++m) if (dst[ai][m] >= 0) { f32x4 v0 = (acc[ai][bj][m][0] + b0) * 4.0f, v1 = (acc[ai][bj][m][1] + b1) * 4.0f; int p0 = 0, p1 = 0;
#pragma unroll
                    for (int q = 0; q < 4; ++q) { v0[q] = __builtin_amdgcn_fmed3f(v0[q], -448.0f, 448.0f); v1[q] = __builtin_amdgcn_fmed3f(v1[q], -448.0f, 448.0f); }
                    p0 = __builtin_amdgcn_cvt_pk_fp8_f32(v0[0], v0[1], p0, false); p0 = __builtin_amdgcn_cvt_pk_fp8_f32(v0[2], v0[3], p0, true); p1 = __builtin_amdgcn_cvt_pk_fp8_f32(v1[0], v1[1], p1, false); p1 = __builtin_amdgcn_cvt_pk_fp8_f32(v1[2], v1[3], p1, true);
                    *(u32x2*)((unsigned char*)Y + (size_t)dst[ai][m] * D + col) = (u32x2){(unsigned)p0, (unsigned)p1}; }
            asm volatile("" ::: "memory");
        }
    }
};

struct TItem { const float* W; unsigned char* WT; int K, N, k0, n0, kind; };
__device__ __forceinline__ TItem titem_decode(const Ctx& C, int it) {
    constexpr int I_IN = 16 * 72, I_GLU = 8 * 8, I_P5 = 8 * 16, I_PL = 16 * 16, I_OUT = 16 * 16, I_UP1 = 16 * 32, I_UP = 32 * I_UP1, I_DN1 = 16 * 16, I_DN = 32 * I_DN1;
    constexpr int PER_L = I_IN + I_GLU + I_P5 + I_PL + I_OUT + I_UP + I_DN;
    TItem t; const int l = it / PER_L; int r = it - l * PER_L, item;
    if (r < I_IN) { t.W = C.in(8) + (size_t)l * D * INW; t.K = D; t.N = INW; t.WT = C.p<unsigned char>(WS_WINT) + (size_t)l * INW * D * 2; t.kind = 0; item = r; }
    else if ((r -= I_IN) < I_GLU) { t.W = C.in(17) + (size_t)l * 512 * 512; t.K = 512; t.N = 512; t.WT = C.p<unsigned char>(WS_WGLUT) + (size_t)l * 512 * 512 * 2; t.kind = 0; item = r; }
    else if ((r -= I_GLU) < I_P5) { t.W = C.in(26) + (size_t)l * 512 * D; t.K = 512; t.N = D; t.WT = C.p<unsigned char>(WS_WP5T) + (size_t)l * D * 512 * 2; t.kind = 0; item = r; }
    else if ((r -= I_P5) < I_PL) { t.W = C.in(27) + (size_t)l * D * D; t.K = D; t.N = D; t.WT = C.p<unsigned char>(WS_WPLT) + (size_t)l * D * D * 2; t.kind = 0; item = r; }
    else if ((r -= I_PL) < I_OUT) { t.W = C.in(28) + (size_t)l * D * D; t.K = D; t.N = D; t.WT = C.p<unsigned char>(WS_WOUTT) + (size_t)l * D * D * 2; t.kind = 0; item = r; }
    else if ((r -= I_OUT) < I_UP) { const int e = r / I_UP1; t.W = C.in(31) + ((size_t)l * NEXP + e) * D * 2048; t.K = D; t.N = 2048; t.WT = C.p<unsigned char>(WS_WUPT) + ((size_t)l * NEXP + e) * 2048 * D; t.kind = 2; item = r - e * I_UP1; }
    else { r -= I_UP; const int e = r / I_DN1; t.W = C.in(33) + ((size_t)l * NEXP + e) * D * D; t.K = D; t.N = D; t.WT = C.p<unsigned char>(WS_WDNT) + ((size_t)l * NEXP + e) * D * D; t.kind = 1; item = r - e * I_DN1; }
    const int nblk = t.N / 64, kb = item / nblk; t.k0 = 64 * kb; t.n0 = 64 * (item - kb * nblk); return t;
}
__device__ __forceinline__ void titem_load(const TItem& t, int lane, f32x4 (&v)[16]) {
    const int r = lane >> 4, c4 = lane & 15;
#pragma unroll
    for (int i = 0; i < 16; ++i) v[i] = *(const f32x4*)(t.W + (size_t)(t.k0 + 4 * i + r) * t.N + t.n0 + 4 * c4);
}
__device__ __forceinline__ void titem_to_lds(const f32x4 (&v)[16], LAS float* scr, int lane) {
    const int r = lane >> 4, c4 = lane & 15;
#pragma unroll
    for (int i = 0; i < 16; ++i) { LAS float* d = scr + (4 * i + r) * 65 + 4 * c4; d[0] = v[i][0]; d[1] = v[i][1]; d[2] = v[i][2]; d[3] = v[i][3]; }
    asm volatile("s_waitcnt lgkmcnt(0)" ::: "memory");
}
__device__ __forceinline__ void titem_store(const TItem& t, const LAS float* scr, int lane) {
    const int c = lane & 7, nn = lane >> 3;
#pragma unroll
    for (int j = 0; j < 8; ++j) { const int n = nn + 8 * j; const LAS float* sp = scr + (8 * c) * 65 + n;
        int orow = t.n0 + n;
        if (t.kind == 2) { const int a = orow >> 1, sft = orow & 1; orow = (a >> 7) * 256 + sft * 128 + (a & 127); }
        if (t.kind != 0) {
            const float sc = (float)(1 << pg8::W8_SHIFT); int p0 = 0, p1 = 0;
            p0 = __builtin_amdgcn_cvt_pk_fp8_f32(sp[0 * 65] * sc, sp[1 * 65] * sc, p0, false); p0 = __builtin_amdgcn_cvt_pk_fp8_f32(sp[2 * 65] * sc, sp[3 * 65] * sc, p0, true);
            p1 = __builtin_amdgcn_cvt_pk_fp8_f32(sp[4 * 65] * sc, sp[5 * 65] * sc, p1, false); p1 = __builtin_amdgcn_cvt_pk_fp8_f32(sp[6 * 65] * sc, sp[7 * 65] * sc, p1, true);
            *(u32x2*)(t.WT + (size_t)orow * t.K + t.k0 + 8 * c) = (u32x2){(unsigned)p0, (unsigned)p1}; }
        else { u32x4 o; o.x = cvt_pk_bf16(sp[0 * 65], sp[1 * 65]); o.y = cvt_pk_bf16(sp[2 * 65], sp[3 * 65]); o.z = cvt_pk_bf16(sp[4 * 65], sp[5 * 65]); o.w = cvt_pk_bf16(sp[6 * 65], sp[7 * 65]);
            *(u32x4*)(t.WT + ((size_t)orow * t.K + t.k0 + 8 * c) * 2) = o; } }
    asm volatile("s_waitcnt lgkmcnt(0)" ::: "memory");
}
__device__ __forceinline__ void phase_transposes(const Ctx& C) {
    LAS float* scr = (LAS float*)(C.lds + C.wave * 17408);
    constexpr int NITEMS = DEPTH * (16 * 72 + 8 * 8 + 8 * 16 + 16 * 16 + 16 * 16 + 32 * 16 * 32 + 32 * 16 * 16), CHUNK = 16;
    static_assert(NITEMS % CHUNK == 0, "items per chunk");
    unsigned* q = C.p<unsigned>(WS_CTL) + CW_QUEUE;
    for (;;) {
        unsigned base = 0; if (C.lane == 0) base = __hip_atomic_fetch_add(q, (unsigned)CHUNK, __ATOMIC_RELAXED, __HIP_MEMORY_SCOPE_AGENT);
        base = (unsigned)__builtin_amdgcn_readfirstlane((int)base); if (base >= (unsigned)NITEMS) break;
        f32x4 va[16]; TItem ta = titem_decode(C, (int)base); titem_load(ta, C.lane, va);
#pragma unroll 1
        for (int i = 0; i < CHUNK; ++i) {
            titem_to_lds(va, scr, C.lane);
            const TItem tcur = ta;
            if (i + 1 < CHUNK) { ta = titem_decode(C, (int)base + i + 1); titem_load(ta, C.lane, va); }
            titem_store(tcur, scr, C.lane);
        }
    }
}

__device__ __forceinline__ void phase_s5prep(const Ctx& C) {
    LAS float* PW = (LAS float*)(C.lds);
    LAS float* BB = (LAS float*)(C.lds + 17408);
    LAS float* CC = (LAS float*)(C.lds + 17408 + 16384);
    LAS float* KT = (LAS float*)(C.lds + 17408 + 32768);
    const int tid = C.tid;
    for (int item = blockIdx.x; item < DEPTH * 32; item += C.G) {
        const int l = item >> 5, g = item & 31;
        __syncthreads();
        if (tid < 128) {
            const int dr = tid >> 6, p = tid & 63; const size_t ix = ((size_t)(l * 2 + dr) * 32 + g) * 64 + p;
            const double lr = (double)C.in(9)[ix], li = (double)C.in(10)[ix], dt = exp((double)C.in(11)[(l * 2 + dr) * 32 + g]);
            for (int k = 0; k <= 16; ++k) { const double mag = exp(lr * dt * k), ang = li * dt * k; PW[((dr * 17 + k) * 64 + p) * 2] = (float)(mag * cos(ang)); PW[((dr * 17 + k) * 64 + p) * 2 + 1] = (float)(mag * sin(ang)); }
            const double m1 = exp(lr * dt), abr = m1 * cos(li * dt), abi = m1 * sin(li * dt), den = lr * lr + li * li, zr = abr - 1.0;
            const double qr = (zr * lr + abi * li) / den, qi = (abi * lr - zr * li) / den;
            for (int h = 0; h < 16; ++h) { const double br = (double)C.in(12)[ix * 16 + h], bi = (double)C.in(13)[ix * 16 + h];
                BB[((dr * 64 + p) * 16 + h) * 2] = (float)(qr * br - qi * bi); BB[((dr * 64 + p) * 16 + h) * 2 + 1] = (float)(qr * bi + qi * br); }
            float* dec = C.p<float>(WS_DEC) + ix * 2; const double m16 = exp(lr * dt * 16), a16 = li * dt * 16; dec[0] = (float)(m16 * cos(a16)); dec[1] = (float)(m16 * sin(a16));
        }
        for (int e = tid; e < 2 * 16 * 64; e += 512) { const int dr = e >> 10, h = (e >> 6) & 15, p = e & 63; const size_t ix = (((size_t)(l * 2 + dr) * 32 + g) * 16 + h) * 64 + p;
            CC[e * 2] = C.in(14)[ix]; CC[e * 2 + 1] = C.in(15)[ix]; }
        __syncthreads();
        for (int e = tid; e < 8192; e += 512) { const int dr = e >> 12, tau = (e >> 8) & 15, i = (e >> 4) & 15, ip = e & 15; float s = 0.f;
            for (int p = 0; p < 64; ++p) { const float cr = CC[((dr * 16 + i) * 64 + p) * 2], ci = CC[((dr * 16 + i) * 64 + p) * 2 + 1], pr = PW[((dr * 17 + tau) * 64 + p) * 2], pi = PW[((dr * 17 + tau) * 64 + p) * 2 + 1];
                const float xr = cr * pr - ci * pi, xi = cr * pi + ci * pr; s += xr * BB[((dr * 64 + p) * 16 + ip) * 2] - xi * BB[((dr * 64 + p) * 16 + ip) * 2 + 1]; }
            KT[e] = s; }
        __syncthreads();
        bf16_t* W3 = C.p<bf16_t>(WS_W3T) + (size_t)item * 256 * 512; bf16_t* FT = C.p<bf16_t>(WS_FT) + (size_t)item * 256 * 256;
        const float* dvec = C.in(16) + (size_t)l * 512 + g * 16;
        for (int e2 = tid; e2 < 256 * 256; e2 += 512) {
            const int row = e2 >> 8, col0 = (e2 & 255) * 2, j = row >> 4, i = row & 15; float v[2];
#pragma unroll
            for (int q = 0; q < 2; ++q) { const int col = col0 + q;
                if (col < 256) { const int jp = col >> 4, ip = col & 15; float s = 0.f; if (j >= jp) s += KT[((0 * 16 + (j - jp)) * 16 + i) * 16 + ip]; if (jp >= j) s += KT[((1 * 16 + (jp - j)) * 16 + i) * 16 + ip]; if (row == col) s += dvec[i]; v[q] = s; }
                else { const int cc = col - 256, dr = cc >> 7, isim = (cc >> 6) & 1, p = cc & 63, pw = dr ? 16 - j : j + 1;
                    const float cr = CC[((dr * 16 + i) * 64 + p) * 2], ci = CC[((dr * 16 + i) * 64 + p) * 2 + 1], pr = PW[((dr * 17 + pw) * 64 + p) * 2], pi = PW[((dr * 17 + pw) * 64 + p) * 2 + 1];
                    v[q] = isim ? -(cr * pi + ci * pr) : (cr * pr - ci * pi); } }
            *(unsigned*)(W3 + (size_t)row * 512 + col0) = cvt_pk_bf16(v[0], v[1]);
        }
        for (int e2 = tid; e2 < 256 * 128; e2 += 512) {
            const int n = e2 >> 7, col0 = (e2 & 127) * 2, blk = n >> 6, p = n & 63, dr = blk >> 1; float v[2];
#pragma unroll
            for (int q = 0; q < 2; ++q) { const int col = col0 + q, jp = col >> 4, ip = col & 15, pw = dr ? jp : 15 - jp;
                const float pr = PW[((dr * 17 + pw) * 64 + p) * 2], pi = PW[((dr * 17 + pw) * 64 + p) * 2 + 1], br = BB[((dr * 64 + p) * 16 + ip) * 2], bi = BB[((dr * 64 + p) * 16 + ip) * 2 + 1];
                v[q] = (blk & 1) ? (pr * bi + pi * br) : (pr * br - pi * bi); }
            *(unsigned*)(FT + (size_t)n * 256 + col0) = cvt_pk_bf16(v[0], v[1]);
        }
    }
    __syncthreads();
}

__device__ __forceinline__ void phase_ada(const Ctx& C) {
    LAS float* cond = (LAS float*)(C.lds);
    LAS float* red = (LAS float*)(C.lds + 17 * 1024 * 4);
    const int tid = C.tid;
    for (int e = tid; e < 17 * 1024; e += 512) { const float v = e < 16 * 1024 ? C.in(1)[e] : C.in(3)[e - 16 * 1024]; cond[e] = v * sigmoidf_(v); }
    __syncthreads();
    const int c = tid & 63, ks = tid >> 6;
    for (int item = C.G - 1 - (int)blockIdx.x; item < DEPTH * 96; item += C.G) {
        const int l = item / 96, cb = item - l * 96, col = cb * 64 + c;
        const float* W = C.in(4) + (size_t)l * D * 6144 + col;
        float acc[17];
#pragma unroll
        for (int r = 0; r < 17; ++r) acc[r] = 0.f;
        for (int k = ks * 128; k < ks * 128 + 128; k += 4) {
            const float w0 = W[(size_t)k * 6144], w1 = W[(size_t)(k + 1) * 6144], w2 = W[(size_t)(k + 2) * 6144], w3 = W[(size_t)(k + 3) * 6144];
#pragma unroll
            for (int r = 0; r < 17; ++r) { const f32x4 cv = *(const LAS f32x4*)(cond + r * 1024 + k); acc[r] += cv[0] * w0 + cv[1] * w1 + cv[2] * w2 + cv[3] * w3; }
        }
#pragma unroll
        for (int r = 0; r < 17; ++r) red[(ks * 17 + r) * 64 + c] = acc[r];
        __syncthreads();
        for (int e = tid; e < 17 * 64; e += 512) { const int r = e >> 6, cc = e & 63; float s = 0.f;
#pragma unroll
            for (int q = 0; q < 8; ++q) s += red[(q * 17 + r) * 64 + cc];
            C.p<float>(WS_ADA)[(size_t)(l * 17 + r) * 6144 + cb * 64 + cc] = s + C.in(5)[(size_t)l * 6144 + cb * 64 + cc]; }
        __syncthreads();
    }
}

__device__ __forceinline__ void load_row(const Ctx& C, bool from_input, int m, bool combine, int lc  , f32x4 (&v)[4]) {
    if (from_input) { const float* src = m < NLAT ? C.in(0) + (size_t)m * D : C.in(2) + (size_t)(m - NLAT) * D;
#pragma unroll
        for (int j = 0; j < 4; ++j) v[j] = *(const f32x4*)(src + 4 * C.lane + 256 * j); }
    else { const bf16_t* src = C.p<bf16_t>(WS_X) + (size_t)m * D;
#pragma unroll
        for (int j = 0; j < 4; ++j) { const u32x2 t = *(const u32x2*)(src + 4 * C.lane + 256 * j); v[j] = (f32x4){bflo(t.x), bfhi(t.x), bflo(t.y), bfhi(t.y)}; } }
    if (combine) {
        const int bsel = m < NLAT ? (m >> 11) : 16;
        const float* g2 = C.p<float>(WS_ADA) + ((size_t)(lc * 17 + bsel) * 6 + 5) * D;
        f32x4 s[4];
#pragma unroll
        for (int j = 0; j < 4; ++j) s[j] = (f32x4){0.f, 0.f, 0.f, 0.f};
#pragma unroll
        for (int k = 0; k < 4; ++k) {
            const float w = C.p<float>(WS_TOKW)[m * 4 + k] * (1.0f / 4.0f);
            const unsigned char* y = C.p<unsigned char>(WS_Y) + (size_t)(m * 4 + k) * D;
#pragma unroll
            for (int j = 0; j < 4; ++j) { const int t = *(const int*)(y + 4 * C.lane + 256 * j); const f32x2 lo = __builtin_amdgcn_cvt_pk_f32_fp8(t, false), hi = __builtin_amdgcn_cvt_pk_f32_fp8(t, true); s[j] += w * (f32x4){lo.x, lo.y, hi.x, hi.y}; }
        }
#pragma unroll
        for (int j = 0; j < 4; ++j) v[j] += *(const f32x4*)(g2 + 4 * C.lane + 256 * j) * s[j];
    }
}
__device__ __forceinline__ float row_rstd(const f32x4 (&v)[4], int lane) {
    float s = 0.f;
#pragma unroll
    for (int j = 0; j < 4; ++j) s += (v[j][0] * v[j][0] + v[j][1] * v[j][1]) + (v[j][2] * v[j][2] + v[j][3] * v[j][3]);
    return rsqrtf(wave_sum(s, lane) * (1.0f / D) + 1e-6f);
}
__device__ __forceinline__ void norm_mod(const Ctx& C, f32x4 (&v)[4], const float* gain, const float* shift, const float* scale) {
    const float rstd = row_rstd(v, C.lane);
#pragma unroll
    for (int j = 0; j < 4; ++j) { const int c = 4 * C.lane + 256 * j; const f32x4 gn = *(const f32x4*)(gain + c), sh = *(const f32x4*)(shift + c), sc = *(const f32x4*)(scale + c);
        v[j] = (v[j] * rstd * gn) * (sc + 1.0f) + sh; }
}
constexpr int Y8_SHIFT = 2;
__device__ __forceinline__ void unpack8_fp8(const u32x2 w, f32x4& a, f32x4& b) {
    const f32x2 a0 = __builtin_amdgcn_cvt_pk_f32_fp8((int)w.x, false), a1 = __builtin_amdgcn_cvt_pk_f32_fp8((int)w.x, true), b0 = __builtin_amdgcn_cvt_pk_f32_fp8((int)w.y, false), b1 = __builtin_amdgcn_cvt_pk_f32_fp8((int)w.y, true);
    a = (f32x4){a0.x, a0.y, a1.x, a1.y}; b = (f32x4){b0.x, b0.y, b1.x, b1.y}; }
struct RowV { f32x4 a[4]; };
__device__ __forceinline__ void n1_vec(const float* p, int lane, f32x4 (&o)[4]) { const GAS f32x4* q = (const GAS f32x4*)(p + 8 * lane); o[0] = q[0]; o[1] = q[1]; o[2] = q[128]; o[3] = q[129]; }
__device__ __forceinline__ void phase_norm1(const Ctx& C, int l) {
    const int gw = blockIdx.x * 8 + C.wave, NGW = C.G * 8, lane = C.lane;
    const int per = (NTOK + NGW - 1) / NGW, mb = gw * per, me = min(mb + per, NTOK);
    f32x4 gain[4], sh[4], sc[4], g2[4]; int cur_b = -1;
    n1_vec(C.in(6) + (size_t)l * D, lane, gain);
    const bool comb = l > 0;
    for (int m0 = mb; m0 < me; m0 += 2) {
        const bool has1 = m0 + 1 < me; const int m1 = has1 ? m0 + 1 : m0;
        RowV x[2]; u32x2 y[2][4][2]; f32x4 w[2];
#pragma unroll
        for (int r = 0; r < 2; ++r) { const int m = r ? m1 : m0;
            if (l == 0) { const float* src = m < NLAT ? C.in(0) + (size_t)m * D : C.in(2) + (size_t)(m - NLAT) * D; n1_vec(src, lane, x[r].a); }
            else { const GAS u32x4* q = (const GAS u32x4*)(C.p<bf16_t>(WS_X) + (size_t)m * D + 8 * lane); const u32x4 t0 = q[0], t1 = q[64]; unpack8(t0, x[r].a[0], x[r].a[1]); unpack8(t1, x[r].a[2], x[r].a[3]); }
            if (comb) { w[r] = *(const GAS f32x4*)(C.p<float>(WS_TOKW) + (size_t)m * 4);
#pragma unroll
                for (int k = 0; k < 4; ++k) { const GAS u32x2* q = (const GAS u32x2*)(C.p<unsigned char>(WS_Y) + (size_t)(m * 4 + k) * D + 8 * lane); y[r][k][0] = q[0]; y[r][k][1] = q[64]; } }
        }
#pragma unroll
        for (int r = 0; r < 2; ++r) { const int m = r ? m1 : m0; if (r == 1 && !has1) break;
            const int bsel = m < NLAT ? (m >> 11) : 16;
            if (bsel != cur_b) { cur_b = bsel; const float* ada = C.p<float>(WS_ADA) + (size_t)(l * 17 + bsel) * 6 * D; n1_vec(ada, lane, sh); n1_vec(ada + D, lane, sc);
                if (comb) n1_vec(C.p<float>(WS_ADA) + ((size_t)((l - 1) * 17 + bsel) * 6 + 5) * D, lane, g2); }
            if (comb) {
                f32x4 s4[4];
#pragma unroll
                for (int q = 0; q < 4; ++q) s4[q] = (f32x4){0.f, 0.f, 0.f, 0.f};
#pragma unroll
                for (int k = 0; k < 4; ++k) { f32x4 t0, t1, t2, t3; unpack8_fp8(y[r][k][0], t0, t1); unpack8_fp8(y[r][k][1], t2, t3); const float wk = w[r][k] * (1.0f / (float)(1 << Y8_SHIFT)); s4[0] += wk * t0; s4[1] += wk * t1; s4[2] += wk * t2; s4[3] += wk * t3; }
#pragma unroll
                for (int q = 0; q < 4; ++q) x[r].a[q] += g2[q] * s4[q];
                GAS u32x4* xo = (GAS u32x4*)(C.p<bf16_t>(WS_X) + (size_t)m * D + 8 * lane); xo[0] = pack8(x[r].a[0], x[r].a[1]); xo[64] = pack8(x[r].a[2], x[r].a[3]);
            }
            float ss = 0.f;
#pragma unroll
            for (int q = 0; q < 4; ++q) ss += (x[r].a[q][0] * x[r].a[q][0] + x[r].a[q][1] * x[r].a[q][1]) + (x[r].a[q][2] * x[r].a[q][2] + x[r].a[q][3] * x[r].a[q][3]);
            const float rstd = rsqrtf(wave_sum(ss, lane) * (1.0f / D) + 1e-6f);
            f32x4 h[4];
#pragma unroll
            for (int q = 0; q < 4; ++q) h[q] = (x[r].a[q] * rstd * gain[q]) * (sc[q] + 1.0f) + sh[q];
            GAS u32x4* ho = (GAS u32x4*)(C.p<bf16_t>(WS_HN) + (size_t)m * D + 8 * lane); ho[0] = pack8(h[0], h[1]); ho[64] = pack8(h[2], h[3]);
        }
    }
}
__device__ __forceinline__ void split_bf16(const f32x4 a, const f32x4 b, bf16x8& hi, bf16x8& lo) {
    u32x4 h = pack8(a, b); f32x4 ha, hb; unpack8(h, ha, hb); u32x4 lw = pack8(a - ha, b - hb); hi = __builtin_bit_cast(bf16x8, h); lo = __builtin_bit_cast(bf16x8, lw);
}
__device__ __forceinline__ void phase_norm2(const Ctx& C, int l, int ntok) {
    LAS float* T = (LAS float*)C.lds;
    LAS float* LG = (LAS float*)(C.lds + 131584);
    LAS int* lcnt = (LAS int*)(C.lds + LC_LCNT); LAS int* gb = (LAS int*)(C.lds + LC_GB);
    unsigned* CNT = C.p<unsigned>(WS_CTL) + CW_CNT + l * 32;
    const float* wr = C.in(29) + (size_t)l * D * 32; const float* br = C.in(30) + l * 32;
    const int tid = C.tid, lane = C.lane, w = C.wave;
    bf16x8 bhi[4][2], blo[4][2];
#pragma unroll
    for (int s = 0; s < 4; ++s)
#pragma unroll
        for (int nt = 0; nt < 2; ++nt) { const int k = 128 * w + 32 * s + 8 * (lane >> 4), e = 16 * nt + (lane & 15); f32x4 a, b;
#pragma unroll
            for (int j = 0; j < 4; ++j) { a[j] = wr[(size_t)(k + j) * 32 + e]; b[j] = wr[(size_t)(k + 4 + j) * 32 + e]; }
            split_bf16(a, b, bhi[s][nt], blo[s][nt]); }
    for (int blk = blockIdx.x; blk < ntok / 32; blk += C.G) {
        {
            f32x4 v[4][4]; const int mb = blk * 32 + w * 4;
#pragma unroll
            for (int rr = 0; rr < 4; ++rr) load_row(C, false, mb + rr, false, 0, v[rr]);
#pragma unroll
            for (int rr = 0; rr < 4; ++rr) { const int r = w * 4 + rr, m = mb + rr;
                const int bsel = m < NLAT ? (m >> 11) : 16; const float* ada = C.p<float>(WS_ADA) + (size_t)(l * 17 + bsel) * 6 * D;
                norm_mod(C, v[rr], C.in(7) + (size_t)l * D, ada + 3 * D, ada + 4 * D);
#pragma unroll
                for (int j = 0; j < 4; ++j) { const float sc = (float)(1 << pg8::ACT8_SHIFT); int pk = 0;
                    { f32x4 c4 = v[rr][j] * sc;
#pragma unroll
                      for (int q = 0; q < 4; ++q) c4[q] = __builtin_amdgcn_fmed3f(c4[q], -448.0f, 448.0f);
                      pk = __builtin_amdgcn_cvt_pk_fp8_f32(c4[0], c4[1], pk, false); pk = __builtin_amdgcn_cvt_pk_fp8_f32(c4[2], c4[3], pk, true); }
                    *(int*)(C.p<unsigned char>(WS_HN) + (size_t)m * D + 4 * lane + 256 * j) = pk;
                    *(LAS f32x4*)(T + r * 1028 + 4 * lane + 256 * j) = v[rr][j]; } }
        }
        if (tid < 32) lcnt[tid] = 0;
        __syncthreads();
        f32x4 acc[2][2];
#pragma unroll
        for (int mt = 0; mt < 2; ++mt)
#pragma unroll
            for (int nt = 0; nt < 2; ++nt) acc[mt][nt] = (f32x4){0.f, 0.f, 0.f, 0.f};
#pragma unroll
        for (int s = 0; s < 4; ++s)
#pragma unroll
            for (int mt = 0; mt < 2; ++mt) { const LAS float* tp = T + (16 * mt + (lane & 15)) * 1028 + 128 * w + 32 * s + 8 * (lane >> 4);
                bf16x8 ahi, alo; split_bf16(*(const LAS f32x4*)tp, *(const LAS f32x4*)(tp + 4), ahi, alo);
#pragma unroll
                for (int nt = 0; nt < 2; ++nt) {
                    acc[mt][nt] = __builtin_amdgcn_mfma_f32_16x16x32_bf16(ahi, bhi[s][nt], acc[mt][nt], 0, 0, 0);
                    acc[mt][nt] = __builtin_amdgcn_mfma_f32_16x16x32_bf16(alo, bhi[s][nt], acc[mt][nt], 0, 0, 0);
                    acc[mt][nt] = __builtin_amdgcn_mfma_f32_16x16x32_bf16(ahi, blo[s][nt], acc[mt][nt], 0, 0, 0); } }
        __syncthreads();
#pragma unroll
        for (int mt = 0; mt < 2; ++mt)
#pragma unroll
            for (int nt = 0; nt < 2; ++nt)
#pragma unroll
                for (int q = 0; q < 4; ++q) T[(w * 32 + 16 * mt + 4 * (lane >> 4) + q) * 33 + 16 * nt + (lane & 15)] = acc[mt][nt][q];
        __syncthreads();
#pragma unroll
        for (int o = tid; o < 1024; o += 512) { const int row = o >> 5, col = o & 31; float sum = 0.f;
#pragma unroll
            for (int q = 0; q < 8; ++q) sum += T[(q * 32 + row) * 33 + col];
            LG[row * 33 + col] = sum + br[col]; }
        __syncthreads();
        int te[4]; float tw[4]; int tp[4];
        if (tid < 32) {
            unsigned used = 0u; float tv[4];
#pragma unroll
            for (int k = 0; k < 4; ++k) { float best = -3.0e38f; int bi = 0;
                for (int e = 0; e < 32; ++e) { const float x = LG[tid * 33 + e]; if (!((used >> e) & 1u) && x > best) { best = x; bi = e; } }
                used |= 1u << bi; te[k] = bi; tv[k] = best; }
            float sm = 0.f;
#pragma unroll
            for (int k = 0; k < 4; ++k) { tw[k] = __expf(tv[k] - tv[0]); sm += tw[k]; }
#pragma unroll
            for (int k = 0; k < 4; ++k) { tw[k] /= sm; tp[k] = atomicAdd((int*)&lcnt[te[k]], 1); }
        }
        __syncthreads();
        if (tid < 32) { const int n = lcnt[tid]; gb[tid] = n > 0 ? (int)atomicAdd(CNT + tid, (unsigned)n) : 0; }
        __syncthreads();
        if (tid < 32) { const int m = blk * 32 + tid;
#pragma unroll
            for (int k = 0; k < 4; ++k) { C.p<int>(WS_TOKE)[m * 4 + k] = te[k]; C.p<int>(WS_TOKP)[m * 4 + k] = gb[te[k]] + tp[k]; C.p<float>(WS_TOKW)[m * 4 + k] = tw[k]; } }
        __syncthreads();
    }
}
__device__ __forceinline__ int moe_offsets(const Ctx& C, int l, bool tiles) {
    LAS int* offs = (LAS int*)(C.lds + LC_OFFS); LAS unsigned char* tile_e = (LAS unsigned char*)(C.lds + LC_TILE);
    unsigned* CNT = C.p<unsigned>(WS_CTL) + CW_CNT + l * 32;
    __syncthreads();
    if (C.tid == 0) { int o = 0;
#pragma unroll 1
        for (int e = 0; e < 32; ++e) { offs[e] = o; const int n = (int)__hip_atomic_load(CNT + e, __ATOMIC_RELAXED, __HIP_MEMORY_SCOPE_AGENT); o += (n + 255) & ~255; } offs[32] = o; }
    __syncthreads();
    const int tt = offs[32] >> 8;
    if (tiles) { for (int t = C.tid; t < tt; t += 512) { int e = 0;
#pragma unroll 1
        while (e < 31 && offs[e + 1] <= t * 256) ++e; tile_e[t] = (unsigned char)e; } __syncthreads(); }
    return tt;
}
__device__ __forceinline__ void phase_slots(const Ctx& C, int l, int ntok) {
    moe_offsets(C, l, false);
    LAS int* offs = (LAS int*)(C.lds + LC_OFFS);
    unsigned* CNT = C.p<unsigned>(WS_CTL) + CW_CNT + l * 32;
    int* TS = C.p<int>(WS_XS);
    int* TS2 = (int*)(C.ws + WS_XS + (1u << 20));
    const int gt = blockIdx.x * 512 + C.tid, NGT = C.G * 512;
    for (int w = gt; w < ntok * 32; w += NGT) {
        const int idx = w >> 3, cc = w & 7;
        const int e = C.p<int>(WS_TOKE)[idx], slot = offs[e] + C.p<int>(WS_TOKP)[idx];
        if (cc == 0) TS[slot] = idx;
        const int tile = slot >> 8, r = slot & 255, h = r >> 7, R = r & 127, bb = pg8::lds_byte(R, 8 * cc), i = bb >> 13, t = (bb & 8191) >> 4;
        TS2[((tile * 512 + t) * 2 + h) * 2 + i] = (idx >> 2) * D + 16 * cc;
    }
#pragma unroll 1
    for (int e = 0; e < 32; ++e) { const int n = (int)__hip_atomic_load(CNT + e, __ATOMIC_RELAXED, __HIP_MEMORY_SCOPE_AGENT), p0 = offs[e] + n, p1 = offs[e + 1];
        if (gt < (p1 - p0) * 8) { const int slot = p0 + (gt >> 3), cc = gt & 7; if (cc == 0) TS[slot] = -1;
            const int tile = slot >> 8, r = slot & 255, h = r >> 7, R = r & 127, bb = pg8::lds_byte(R, 8 * cc), i = bb >> 13, t = (bb & 8191) >> 4;
            TS2[((tile * 512 + t) * 2 + h) * 2 + i] = 16 * cc; } }
}
__device__ __forceinline__ void phase_final(const Ctx& C) {
    const int gw = blockIdx.x * 8 + C.wave, NGW = C.G * 8;
    for (int m = gw; m < NLAT; m += NGW) {
        f32x4 v[4]; load_row(C, false, m, true, DEPTH - 1, v);
        const float rstd = row_rstd(v, C.lane);
#pragma unroll
        for (int j = 0; j < 4; ++j) { const int c = 4 * C.lane + 256 * j; *(f32x4*)(C.out + (size_t)m * D + c) = v[j] * rstd * *(const f32x4*)(C.in(35) + c); }
    }
}

__device__ __forceinline__ void phase_s5carry_ol(const Ctx& C, int l) {
    if (C.tid < 256) {
        for (int gid = blockIdx.x * 256 + C.tid; gid < 65536; gid += C.G * 256) {
            const int p = gid & 63, dr = (gid >> 6) & 1, g = (gid >> 7) & 31, b = gid >> 12;
            const f32x2 dec = *(const f32x2*)(C.p<float>(WS_DEC) + (((size_t)(l * 2 + dr) * 32 + g) * 64 + p) * 2);
            float hr = 0.f, hi = 0.f;
#pragma unroll 1
            for (int k0 = 0; k0 < NCH; k0 += 16) {
                float sr[16], si[16];
#pragma unroll
                for (int q = 0; q < 16; ++q) { const int k = k0 + q, cidx = dr == 0 ? k : (k < 16 ? 15 - k : 159 - k);
                    const float* sp = C.p<float>(WS_SB) + ((size_t)(b * NCH + cidx) * 32 + g) * 256 + dr * 128 + p; sr[q] = sp[0]; si[q] = sp[64]; }
#pragma unroll
                for (int q = 0; q < 16; ++q) { const int k = k0 + q, cidx = dr == 0 ? k : (k < 16 ? 15 - k : 159 - k);
                    bf16_t* a3 = C.p<bf16_t>(WS_A3) + ((size_t)(b * NCH + cidx) * 32 + g) * 512 + 256 + dr * 128 + p;
                    a3[0] = f2bf(hr); a3[64] = f2bf(hi);
                    const float nr = dec.x * hr - dec.y * hi + sr[q], ni = dec.x * hi + dec.y * hr + si[q]; hr = nr; hi = ni; }
            }
        }
    }
}

__device__ __forceinline__ int lru_row(int b, bool isctx, int p) { return isctx ? NLAT + b * 256 + p : b * 2048 + (p & 31) * 64 + (p >> 5); }
__device__ __forceinline__ void phase_lru(const Ctx& C, int l) {
    const int tid = C.tid, dir = tid >> 8, lt = tid & 255, lw = (tid >> 6) & 3, lane = tid & 63;
    const int mt = lw >> 1, ct = lw & 1, half = lane >> 5, cl = lane & 31;
    LAS unsigned char* R = C.lds + dir * 49152;
    LAS unsigned char* XT = R;
    LAS unsigned char* XC = R + 8704;
    LAS float* SEG = (LAS float*)(R + 17920);
    LAS unsigned char* OT = R + 19968;
    LAS unsigned char* G2 = R + 29184;
    LAS unsigned char* OUTT = R + 38400;
    const bf16_t* XR = C.p<bf16_t>(WS_XR); bf16_t* HOUT = C.p<bf16_t>(dir ? WS_HB : WS_HF);
    const bf16_t* HOTH = C.p<bf16_t>(dir ? WS_HF : WS_HB); const bf16_t* GGp = C.p<bf16_t>(WS_GG); bf16_t* OLp = C.p<bf16_t>(WS_OL);
    const int seg = 2 * mt + half, ch = 32 * ct + cl;
    const int srow = 16 * (2 * mt + ((cl >> 2) & 1)) + (cl & 3) + 4 * (cl >> 3);
    const int qrow = dir ? 63 - srow : srow;
    for (int task = blockIdx.x; task < 256; task += C.G) {
        const int b = task >> 4, n = task & 15;
        const float lam = C.in(21)[(size_t)(l * 2 + dir) * D + n * 64 + ch];
        const float coef2 = -8.0f * log1pf(__expf(-lam)) * 1.4426950409f;
        const int c2 = lt & 31, pg = lt >> 5;
        float cw[4][2], cb[2];
#pragma unroll
        for (int j = 0; j < 4; ++j) { cw[j][0] = C.in(19)[((size_t)l * 4 + j) * D + n * 64 + 2 * c2]; cw[j][1] = C.in(19)[((size_t)l * 4 + j) * D + n * 64 + 2 * c2 + 1]; }
        cb[0] = C.in(20)[(size_t)l * D + n * 64 + 2 * c2]; cb[1] = C.in(20)[(size_t)l * D + n * 64 + 2 * c2 + 1];
        const float* Wa = C.in(22) + ((size_t)((l * 2 + dir) * 16 + n) * 64) * 64; const float* Wx = C.in(24) + ((size_t)((l * 2 + dir) * 16 + n) * 64) * 64;
        bf16x8 bfa[4], bfx[4];
#pragma unroll
        for (int s = 0; s < 4; ++s) {
            unsigned wa[4], wx[4];
#pragma unroll
            for (int jj = 0; jj < 4; ++jj) { const int k = 16 * s + 8 * half + 2 * jj; wa[jj] = cvt_pk_bf16(Wa[(size_t)k * 64 + ch], Wa[(size_t)(k + 1) * 64 + ch]); wx[jj] = cvt_pk_bf16(Wx[(size_t)k * 64 + ch], Wx[(size_t)(k + 1) * 64 + ch]); }
            u32x4 ta = (u32x4){wa[0], wa[1], wa[2], wa[3]}, tx = (u32x4){wx[0], wx[1], wx[2], wx[3]}; bfa[s] = __builtin_bit_cast(bf16x8, ta); bfx[s] = __builtin_bit_cast(bf16x8, tx);
        }
        const float bias_a = C.in(23)[(size_t)(l * 2 + dir) * D + n * 64 + ch], bias_x = C.in(25)[(size_t)(l * 2 + dir) * D + n * 64 + ch];
        const float nba = -1.4426950409f * bias_a, nbx = -1.4426950409f * bias_x;
        float hrun = 0.f;
        u32x4 pf[3];
        auto issue_tile = [&](int it) {
            const bool isctx = it < 4; const int p0 = dir == 0 ? (isctx ? 64 * it : 64 * (it - 4)) : (isctx ? 64 * (3 - it) : 64 * (35 - it)); const int slen = isctx ? 256 : 2048;
#pragma unroll
            for (int r = 0; r < 3; ++r) { const int q = lt + 256 * r, rr = q >> 3, pc = q & 7, p = p0 - 1 + rr;
                pf[r] = (u32x4){0u, 0u, 0u, 0u};
                if (rr < 67 && p >= 0 && p < slen) pf[r] = *(const u32x4*)(XR + (size_t)lru_row(b, isctx, p) * D + n * 64 + pc * 8); }
        };
        auto lru_flush = [&](int itp) {
            const bool cx = itp < 4; const int pp = dir == 0 ? (cx ? 64 * itp : 64 * (itp - 4)) : (cx ? 64 * (3 - itp) : 64 * (35 - itp)); const bool sec = itp < 4 ? itp >= 2 : itp >= 20;
            bf16_t* dstb = sec ? OLp : HOUT;
#pragma unroll
            for (int r = 0; r < 2; ++r) { const int q = lt + 256 * r, rr = q >> 3, pc = q & 7; *(GAS u32x4*)(dstb + (size_t)lru_row(b, cx, pp + rr) * D + n * 64 + pc * 8) = *(const LAS u32x4*)(OUTT + rr * 144 + pc * 16); }
        };
        issue_tile(0);
#pragma unroll 1
        for (int it = 0; it < 36; ++it) {
            const bool isctx = it < 4; const int p0 = dir == 0 ? (isctx ? 64 * it : 64 * (it - 4)) : (isctx ? 64 * (3 - it) : 64 * (35 - it));
#pragma unroll
            for (int r = 0; r < 3; ++r) { const int q = lt + 256 * r, rr = q >> 3, pc = q & 7; if (rr < 67) *(LAS u32x4*)(XT + rr * 128 + pc * 16) = pf[r]; }
            __syncthreads();
            if (it + 1 < 36) issue_tile(it + 1);
            if (it > 0) lru_flush(it - 1);
            const bool second = it < 4 ? it >= 2 : it >= 20;
            {
                float x0[11], x1[11];
#pragma unroll
                for (int r = 0; r < 11; ++r) { const unsigned w = *(const LAS unsigned*)(XT + (8 * pg + r) * 128 + c2 * 4); x0[r] = bflo(w); x1[r] = bfhi(w); }
#pragma unroll
                for (int q = 0; q < 8; ++q) { float y0 = cb[0], y1 = cb[1];
#pragma unroll
                    for (int j = 0; j < 4; ++j) { y0 += cw[j][0] * x0[q + j]; y1 += cw[j][1] * x1[q + j]; }
                    *(LAS unsigned*)(XC + (8 * pg + q) * 144 + c2 * 4) = cvt_pk_bf16(y0, y1); }
            }
            if (it == 2 || it == 20) asm volatile("s_waitcnt vmcnt(0)" ::: "memory");
            __syncthreads();
            u32x4 po[2], pg2[2];
            if (second) {
#pragma unroll
                for (int r = 0; r < 2; ++r) { const int q = lt + 256 * r, rr = q >> 3, pc = q & 7; const size_t off = (size_t)lru_row(b, isctx, p0 + rr) * D + n * 64 + pc * 8;
                    po[r] = *(const GAS u32x4*)(HOTH + off); pg2[r] = *(const GAS u32x4*)(GGp + off); }
            }
            f32x16 accr, acci;
#pragma unroll
            for (int q = 0; q < 16; ++q) { accr[q] = 0.f; acci[q] = 0.f; }
#pragma unroll
            for (int s = 0; s < 4; ++s) {
                const bf16x8 a = *(const LAS bf16x8*)(XC + qrow * 144 + (16 * s + 8 * half) * 2);
                accr = __builtin_amdgcn_mfma_f32_32x32x16_bf16(a, bfa[s], accr, 0, 0, 0);
                acci = __builtin_amdgcn_mfma_f32_32x32x16_bf16(a, bfx[s], acci, 0, 0, 0);
            }
            float av[16], bv[16]; float P = 1.f, H = 0.f;
#pragma unroll
            for (int i = 0; i < 16; ++i) { const int s = 16 * seg + i, q = dir ? 63 - s : s;
                const float r = __builtin_amdgcn_rcpf(1.0f + __builtin_amdgcn_exp2f(fmaf(accr[i], -1.4426950409f, nba))), ig = __builtin_amdgcn_rcpf(1.0f + __builtin_amdgcn_exp2f(fmaf(acci[i], -1.4426950409f, nbx)));
                const float xc = bf2f(*(const LAS unsigned short*)(XC + q * 144 + ch * 2));
                const float a = __builtin_amdgcn_exp2f(coef2 * r);
                const float em = fmaxf(fmaf(-a, a, 1.0f), 0.0f);
                const float bb = __builtin_amdgcn_sqrtf(em) * (ig * xc);
                av[i] = a; bv[i] = bb; P *= a; H = a * H + bb; }
            SEG[(seg * 64 + ch) * 2] = P; SEG[(seg * 64 + ch) * 2 + 1] = H;
            if (second) {
#pragma unroll
                for (int r = 0; r < 2; ++r) { const int q = lt + 256 * r, rr = q >> 3, pc = q & 7; *(LAS u32x4*)(OT + rr * 144 + pc * 16) = po[r]; *(LAS u32x4*)(G2 + rr * 144 + pc * 16) = pg2[r]; }
            }
            __syncthreads();
            float carry = hrun, mine = 0.f;
#pragma unroll
            for (int s2 = 0; s2 < 4; ++s2) { if (s2 == seg) mine = carry; carry = SEG[(s2 * 64 + ch) * 2] * carry + SEG[(s2 * 64 + ch) * 2 + 1]; }
            hrun = carry;
            float h = mine;
#pragma unroll
            for (int i = 0; i < 16; ++i) { const int s = 16 * seg + i, q = dir ? 63 - s : s; h = av[i] * h + bv[i];
                const float val = second ? bf2f(*(const LAS unsigned short*)(G2 + q * 144 + ch * 2)) * (h + bf2f(*(const LAS unsigned short*)(OT + q * 144 + ch * 2))) : h;
                *(LAS unsigned short*)(OUTT + q * 144 + ch * 2) = f2bf(val); }
        }
        __syncthreads();
        lru_flush(35);
        __syncthreads();
    }
}

__global__ void __launch_bounds__(512, 2) fwd_kernel(Args args) {
    extern __shared__ __attribute__((aligned(16))) unsigned char lds_raw[];
    Ctx C0; C0.out = args.out; C0.ws = args.ws; C0.lds = (LAS unsigned char*)lds_raw;
    C0.tid = threadIdx.x; C0.lane = C0.tid & 63; C0.wave = __builtin_amdgcn_readfirstlane(C0.tid >> 6); C0.G = gridDim.x;
    for (int u = C0.tid; u < (LDS_BYTES - LDS_CTL) / 4; u += 512) ((LAS unsigned*)(C0.lds + LDS_CTL))[u] = 0u;
    __syncthreads();
    if (C0.tid < 36) { const unsigned long long pv = (unsigned long long)args.in[C0.tid]; LAS unsigned* t = (LAS unsigned*)(C0.lds + LC_PTRS) + 2 * C0.tid; t[0] = (unsigned)pv; t[1] = (unsigned)(pv >> 32); }
    __syncthreads();
    const Ctx& C = C0;
    XcdBarrier bar = xcd_barrier_post(C.p<unsigned>(WS_CTL) + CW_BAR, (volatile LAS unsigned*)(C.lds + LC_MISC) + 8);
    const int lo = args.ph_lo, hi = args.ph_hi;
    int ph = 0;
#ifndef PHMASK
#define PHMASK 0xffffffffu
#endif
#define PH_ON(id) (((PHMASK) >> (id)) & 1u)
#define PHASE_BEGIN(id) if (PH_ON(id) && lo <= ph && ph < hi) { Ctx C = C0; const int _pid = id; (void)_pid; unsigned _z = 0u; asm volatile("" : "+s"(C.ws), "+s"(C.out), "+s"(C.lds), "+v"(_z)); C.lane = (int)__builtin_amdgcn_mbcnt_hi(~0u, __builtin_amdgcn_mbcnt_lo(~0u, _z)); C.tid = C.wave * 64 + C.lane;
#ifdef PROBE_MASK
#define PROBE_TICK() do { const unsigned long long _t = __builtin_amdgcn_s_memrealtime(); if (((PROBE_MASK) >> _pid) & 1u) pr_acc += _t - pr_prev; pr_prev = _t; } while (0)
#else
#define PROBE_TICK() do { } while (0)
#endif
#define PHASE_END(last) if (ph + 1 < hi && !(last)) xcd_barrier(bar); PROBE_TICK(); } ++ph;
#define PHASE_JOIN __syncthreads(); }
    const int cid = (int)blockIdx.x;
#ifdef PROBE_MASK
    unsigned long long pr_acc = 0ull, pr_prev = __builtin_amdgcn_s_memrealtime();
#endif

    PHASE_BEGIN(0)
        phase_s5prep(C);
        phase_ada(C);
        __syncthreads();
        phase_transposes(C);
    PHASE_END(false)

#pragma unroll 1
    for (int l = 0; l < DEPTH; ++l) {
        const int nMtok = (l == DEPTH - 1) ? 128 : 144;
        const int ntok = nMtok * 256;
        PHASE_BEGIN(1) phase_norm1(C, l); PHASE_END(false)
        PHASE_BEGIN(2)
            pg8::Gemm g{D, D, D, C.p<bf16_t>(WS_HN), (C.p<bf16_t>(WS_WINT) + (size_t)l * INW * D)}; SchedGrid S; S.rowtab4 = nullptr; S.so.init(144, 18, C.G, cid);  S.atile = (unsigned)256 * D * 2; S.btile = (unsigned)256 * D * 2;
            EpiInProj E{C.p<bf16_t>(WS_A3), C.p<bf16_t>(WS_XR), C.p<bf16_t>(WS_GG), C.p<bf16_t>(WS_M5), C.p<bf16_t>(WS_ML)};
            pg8::gemm_phase(C.lds, C.tid, g, S, E);
        PHASE_END(false)
        PHASE_BEGIN(3)
            pg8::Gemm g{16384, 256, 256, C.p<bf16_t>(WS_A3), (C.p<bf16_t>(WS_FT) + (size_t)l * 32 * 256 * 256)}; SchedS5 S{nullptr, C.G, cid, (unsigned)(256 * 256 * 2)};
            EpiS5L1 E{C.p<float>(WS_SB)};
            pg8::gemm_phase(C.lds, C.tid, g, S, E);
        PHASE_JOIN
        PHASE_BEGIN(15) phase_lru(C, l); PHASE_END(false)
        PHASE_BEGIN(4) phase_s5carry_ol(C, l); PHASE_END(false)
        PHASE_BEGIN(5)
            { pg8::Gemm g{16384, 512, 512, C.p<bf16_t>(WS_A3), (C.p<bf16_t>(WS_W3T) + (size_t)l * 32 * 256 * 512)}; SchedS5 S{nullptr, C.G, cid, (unsigned)(256 * 512 * 2)};
              EpiS5Y E{C.p<bf16_t>(WS_GY)};
              pg8::gemm_phase(C.lds, C.tid, g, S, E); }
            __syncthreads();
            { pg8::Gemm g{D, D, D, C.p<bf16_t>(WS_OL), (C.p<bf16_t>(WS_WPLT) + (size_t)l * D * D)}; SchedGrid S; S.rowtab4 = nullptr; S.so.init(nMtok, 4, C.G, C.G - 1 - cid);  S.atile = (unsigned)256 * D * 2; S.btile = (unsigned)256 * D * 2;
              EpiMulGate E{C.p<bf16_t>(WS_ML), nullptr, C.p<bf16_t>(WS_T1)};
              pg8::gemm_phase(C.lds, C.tid, g, S, E); }
        PHASE_END(false)
        PHASE_BEGIN(6)
            pg8::Gemm g{512, 512, 512, C.p<bf16_t>(WS_GY), (C.p<bf16_t>(WS_WGLUT) + (size_t)l * 512 * 512)}; SchedGrid S; S.rowtab4 = nullptr; S.so.init(nMtok, 2, C.G, cid);  S.atile = (unsigned)256 * 512 * 2; S.btile = (unsigned)256 * 512 * 2;
            EpiGlu E{C.p<bf16_t>(WS_GY), C.p<bf16_t>(WS_O5), C.in(18) + (size_t)l * 512};
            pg8::gemm_phase(C.lds, C.tid, g, S, E);
        PHASE_END(false)
        PHASE_BEGIN(7)
            pg8::Gemm g{512, 512, 512, C.p<bf16_t>(WS_O5), (C.p<bf16_t>(WS_WP5T) + (size_t)l * D * 512)}; SchedGrid S; S.rowtab4 = nullptr; S.so.init(nMtok, 4, C.G, cid);  S.atile = (unsigned)256 * 512 * 2; S.btile = (unsigned)256 * 512 * 2;
            EpiMulGate E{C.p<bf16_t>(WS_M5), C.p<bf16_t>(WS_T1), C.p<bf16_t>(WS_MG)};
            pg8::gemm_phase(C.lds, C.tid, g, S, E);
        PHASE_END(false)
        PHASE_BEGIN(9)
            pg8::Gemm g{D, D, D, C.p<bf16_t>(WS_MG), (C.p<bf16_t>(WS_WOUTT) + (size_t)l * D * D)}; SchedGrid S; S.rowtab4 = nullptr; S.so.init(nMtok, 4, C.G, cid);  S.atile = (unsigned)256 * D * 2; S.btile = (unsigned)256 * D * 2;
            EpiOut E{C.in(0), C.in(2), C.p<bf16_t>(WS_X), C.p<float>(WS_ADA), l};
            pg8::gemm_phase(C.lds, C.tid, g, S, E);
        PHASE_END(false)
        PHASE_BEGIN(10) phase_norm2(C, l, ntok); PHASE_END(false)
        PHASE_BEGIN(11) phase_slots(C, l, ntok); PHASE_END(false)
        PHASE_BEGIN(12)
            const int tt = moe_offsets(C, l, true);
            pg8::Gemm g{D / 2, D / 2, D / 2, C.p<unsigned char>(WS_HN), (C.p<unsigned char>(WS_WUPT) + (size_t)l * NEXP * 2048 * D)}; SchedMoe<true, true> S; S.rowtab4 = (const __attribute__((address_space(1))) i32x4*)(C.ws + WS_XS + (1u << 20)); S.rowmax = 0; S.so.init(tt, 8, C.G, cid);
            S.atile = (unsigned)256 * D; S.btile = (unsigned)256 * D; S.bexp = (unsigned)2048 * D;   S.tile_e = (const LAS unsigned char*)(C.lds + LC_TILE);
            EpiUp E{C.p<bf16_t>(WS_ACT), C.in(32) + (size_t)l * NEXP * 2048};
            pg8::gemm_phase(C.lds, C.tid, g, S, E);
        PHASE_END(false)
        PHASE_BEGIN(13)
            const int tt = moe_offsets(C, l, true);
            pg8::Gemm g{D / 2, D / 2, D / 2, C.p<unsigned char>(WS_ACT), (C.p<unsigned char>(WS_WDNT) + (size_t)l * NEXP * D * D)}; SchedMoe<false, true> S; S.rowtab4 = nullptr; S.rowmax = 0; S.so.init(tt, 4, C.G, cid);
            S.atile = (unsigned)256 * D; S.btile = (unsigned)256 * D; S.bexp = (unsigned)D * D; S.tile_e = (const LAS unsigned char*)(C.lds + LC_TILE);
            EpiDown E{C.p<bf16_t>(WS_Y), C.in(34) + (size_t)l * NEXP * D, C.p<int>(WS_XS)};
            pg8::gemm_phase(C.lds, C.tid, g, S, E);
        PHASE_END(false)
    }
    PHASE_BEGIN(14) phase_final(C); PHASE_END(true)
#ifdef PROBE_MASK
    if (blockIdx.x == 0) { const unsigned long long t0 = __builtin_amdgcn_s_memrealtime(); while (__builtin_amdgcn_s_memrealtime() - t0 < pr_acc * (PROBE_AMP)) __builtin_amdgcn_s_sleep(8); }
#endif
}

constexpr int N_PHASES = 1 + DEPTH * 12 + 1;
extern "C" void kernel_launch(void* const* d_in, const int* in_sizes, int n_in, void* d_out, int out_size, void* d_ws, size_t ws_size, hipStream_t stream) {
    static int grid = 0;
    if (grid == 0) {
        if (n_in != 36 || ws_size < WS_END) { fprintf(stderr, "kernel_launch: need 36 inputs and >= %zu bytes of workspace; got %d, %zu\n", (size_t)WS_END, n_in, ws_size); grid = -1; return; }
        int dev = 0, cus = 0, per_cu = 0;
        if (hipGetDevice(&dev) != hipSuccess || hipDeviceGetAttribute(&cus, hipDeviceAttributeMultiprocessorCount, dev) != hipSuccess) { grid = -1; return; }
        if (hipFuncSetAttribute((const void*)fwd_kernel, hipFuncAttributeMaxDynamicSharedMemorySize, LDS_BYTES) != hipSuccess) { fprintf(stderr, "kernel_launch: hipFuncSetAttribute failed\n"); grid = -1; return; }
        if (hipOccupancyMaxActiveBlocksPerMultiprocessor(&per_cu, (const void*)fwd_kernel, 512, LDS_BYTES) != hipSuccess || per_cu < 1) fprintf(stderr, "kernel_launch: occupancy query says %d\n", per_cu);
        (void)hipGetLastError();
        grid = cus;
    }
    if (grid < 0) return;
    (void)hipMemsetAsync((char*)d_ws + WS_CTL, 0, CTL_ZERO_BYTES, stream);
    Args a{};
    for (int i = 0; i < 36; ++i) a.in[i] = (const float*)d_in[i];
    a.out = (float*)d_out; a.ws = (unsigned char*)d_ws;
#ifndef MK_SPLIT
    a.ph_lo = 0; a.ph_hi = N_PHASES;
    hipLaunchKernelGGL(fwd_kernel, dim3(grid), dim3(512), LDS_BYTES, stream, a);
#else
    for (int p = 0; p < N_PHASES; ++p) { a.ph_lo = p; a.ph_hi = p + 1; hipLaunchKernelGGL(fwd_kernel, dim3(grid), dim3(512), LDS_BYTES, stream, a); }
#endif
}
```

```cpp
#include <hip/hip_runtime.h>
#include <cstdio>
#include <cstdint>

#define LAS __attribute__((address_space(3)))
typedef unsigned short bf16_t;
typedef short bf16x8 __attribute__((ext_vector_type(8)));
typedef float f32x4 __attribute__((ext_vector_type(4)));
typedef float f32x2 __attribute__((ext_vector_type(2)));
typedef float f32x16 __attribute__((ext_vector_type(16)));
typedef unsigned u32x4 __attribute__((ext_vector_type(4)));
typedef unsigned u32x2 __attribute__((ext_vector_type(2)));
typedef int i32x4 __attribute__((ext_vector_type(4)));
typedef int i32x8 __attribute__((ext_vector_type(8)));

constexpr int D = 1024, NB = 16, SEQ = 2048, CTXL = 256, DEPTH = 4;
constexpr int NLAT = NB * SEQ, NCTX = NB * CTXL, NTOK = NLAT + NCTX;
constexpr int INW = 4608, NEXP = 32;
constexpr int NCH = 144;
constexpr int NROW3 = NB * NCH;
constexpr int MAXSLOT = NTOK * 4 + NEXP * 256;

__device__ __forceinline__ float bf2f(unsigned short b) { return __uint_as_float(((unsigned)b) << 16); }
__device__ __forceinline__ float bflo(unsigned w) { return __uint_as_float(w << 16); }
__device__ __forceinline__ float bfhi(unsigned w) { return __uint_as_float(w & 0xffff0000u); }
typedef __bf16 bf16x2_n __attribute__((ext_vector_type(2)));
__device__ __forceinline__ unsigned cvt_pk_bf16(float lo, float hi) { f32x2 v = {lo, hi}; bf16x2_n b = __builtin_convertvector(v, bf16x2_n); return __builtin_bit_cast(unsigned, b); }
__device__ __forceinline__ unsigned short f2bf(float f) { return (unsigned short)(cvt_pk_bf16(f, 0.f) & 0xffffu); }
__device__ __forceinline__ float sigmoidf_(float x) { return __builtin_amdgcn_rcpf(1.0f + __expf(-x)); }
__device__ __forceinline__ float gelu_tanh(float x) { const float z = 1.5957691216f * (x + 0.044715f * x * x * x); return x * __builtin_amdgcn_rcpf(1.0f + __expf(-z)); }
__device__ __forceinline__ float wave_sum(float v, int lane) {
#pragma unroll
    for (int o = 1; o < 64; o <<= 1) v += __builtin_bit_cast(float, __builtin_amdgcn_ds_bpermute((lane ^ o) << 2, __builtin_bit_cast(int, v)));
    return v;
}

namespace pg8 {
constexpr int BM = 256, BK = 64, HALF = 128, HTB = HALF * BK * 2, STAGE_BYTES = 8 * HTB, NXCD = 8, WGM = 8;
__host__ __device__ __forceinline__ int lds_byte(int r, int c) { const int st = (r >> 4) * 2 + (c >> 5), rr = r & 15, cc = c & 31, ob = rr * 64 + cc * 2; return st * 1024 + (ob ^ (((ob >> 9) & 1) << 5)); }
__host__ __device__ __forceinline__ void stage_rc(int b, int& R, int& C) { const int st = b / 1024, sb = b % 1024, swz = sb ^ (((sb >> 9) & 1) << 5); R = (st >> 1) * 16 + swz / 64; C = (st & 1) * 32 + (swz % 64) / 2; }
__host__ __device__ __forceinline__ int perm32(int rho) { const int n = rho >> 4, i = rho & 15; return 8 * (i >> 2) + 4 * n + (i & 3); }

constexpr int ACT8_SHIFT = 2, W8_SHIFT = 6;
struct Unit { int pm, pn, grp, hu, hoff; unsigned a, b; };
struct Gemm { int lda, ldb, K; const void* A; const void* B; };

constexpr bool TAIL_SPLIT = false;
__device__ __forceinline__ bool tail_map(long L, int nwg, int G, int& fidx, int& hu, int& hs) {
    const int r = nwg % G, F = nwg - r; hu = 0; hs = 0;
    if (!TAIL_SPLIT || r == 0 || 2 * r > G || L < F) { if (L >= nwg) return false; fidx = (int)L; return true; }
    const long h = L - F; if (h >= 2 * r) return false; fidx = F + (int)(h >> 1); hu = 1; hs = (int)(h & 1); return true;
}
struct StaticOrder {
    int nM, nN, nwg, G, c;
    __device__ void init(int nM_, int nN_, int G_, int c_) { nM = nM_; nN = nN_; nwg = nM * nN; G = G_; c = c_; }
    __device__ bool next(int i, int& pm, int& pn, int& hu, int& hs) const {
        int wgid; if (!tail_map((long)i * G + c, nwg, G, wgid, hu, hs)) return false;
        { const int q = nwg / NXCD, r = nwg % NXCD, xcd = wgid % NXCD, off = wgid / NXCD; wgid = (xcd < r ? xcd * (q + 1) : r * (q + 1) + (xcd - r) * q) + off; }
        const int nig = WGM * nN, gid = wgid / nig, fm = gid * WGM, gsz = (nM - fm) < WGM ? (nM - fm) : WGM;
        pm = fm + ((wgid % nig) % gsz); pn = (wgid % nig) / gsz; return true;
    }
};

template <class Epi, class Sched>
__device__ __forceinline__ void gemm_phase(LAS unsigned char* lds, const int tid, const Gemm g, const Sched& S, const Epi& E) {
    const int wid = __builtin_amdgcn_readfirstlane(tid >> 6), lane = tid & 63, wr = wid >> 2, wc = wid & 3, fr = lane & 15, fq = lane >> 4;
    const int K = g.K, nt = K / BK;
    unsigned voffA[2], voffB[2];
#pragma unroll
    for (int i = 0; i < 2; ++i) { int R, C; stage_rc(tid * 16 + i * 8192, R, C); const int Rb = Epi::PERM ? ((R & ~31) + perm32(R & 31)) : R;
        voffA[i] = (unsigned)(R * g.lda + C) * 2u; voffB[i] = (unsigned)(Rb * g.ldb + C) * 2u; }
    constexpr bool GA = Sched::GATHER, F8 = Sched::F8;
    const unsigned long long _pa = (unsigned long long)g.A, _pb = (unsigned long long)g.B;
    void* const uA = (void*)(((unsigned long long)(unsigned)__builtin_amdgcn_readfirstlane((int)(_pa >> 32)) << 32) | (unsigned)__builtin_amdgcn_readfirstlane((int)_pa));
    void* const uB = (void*)(((unsigned long long)(unsigned)__builtin_amdgcn_readfirstlane((int)(_pb >> 32)) << 32) | (unsigned)__builtin_amdgcn_readfirstlane((int)_pb));
    const __amdgpu_buffer_rsrc_t rsA = __builtin_amdgcn_make_buffer_rsrc(uA, 0, 0x7fffffff, 0x00020000), rsB = __builtin_amdgcn_make_buffer_rsrc(uB, 0, 0x7fffffff, 0x00020000);
    const unsigned kstep = (unsigned)(BK * 2);
    const unsigned hstepA = GA ? 0u : (unsigned)HALF * g.lda * 2, hstepB = (unsigned)HALF * g.ldb * 2;
    unsigned vA[2][2], vN[2][2];
#define PG8_ROWS(u, v) do { if constexpr (GA) { unsigned _z = 0u; asm volatile("" : "+v"(_z)); const int _tid = wid * 64 + (int)__builtin_amdgcn_mbcnt_hi(~0u, __builtin_amdgcn_mbcnt_lo(~0u, _z)); const i32x4 _t = S.rowtab4[(u).pm * 512 + _tid]; const bool _hh = (u).hoff != 0;     \
        v[0][0] = (unsigned)(_hh ? _t.z : _t.x); v[0][1] = (unsigned)(_hh ? _t.w : _t.y); v[1][0] = (unsigned)_t.z; v[1][1] = (unsigned)_t.w; } \
        else { _Pragma("unroll") for (int _h = 0; _h < 2; ++_h) { v[_h][0] = voffA[0]; v[_h][1] = voffA[1]; } } } while (0)
#define PG8_SEL(h, usenext) unsigned vs[2] = { (usenext) ? vN[h][0] : vA[h][0], (usenext) ? vN[h][1] : vA[h][1] }
    const unsigned ldsw = (unsigned)wid * 1024u;
    const int aoff = lds_byte(wr * 64 + fr, fq * 8), boff = lds_byte(wc * 32 + fr, fq * 8);
#define PG8_SA(b, h) (((b) * 2 + (h)) * HTB)
#define PG8_SB(b, h) ((4 + (b) * 2 + (h)) * HTB)
#define PG8_STAGEX(rs, bufoff, soff, voff) do { _Pragma("unroll") for (int _i = 0; _i < 2; ++_i) \
        __builtin_amdgcn_raw_ptr_buffer_load_lds(rs, (LAS void*)(lds + (bufoff) + ldsw + _i * 8192), 16, (int)(voff)[_i], (int)(soff), 0, 0); } while (0)
#define PG8_STAGEA(bufoff, soff, voff) PG8_STAGEX(rsA, bufoff, soff, voff)
#define PG8_STAGEB(bufoff, soff, voff) PG8_STAGEX(rsB, bufoff, soff, voff)
#define PG8_LDA(dst, b, h) do { _Pragma("unroll") for (int m = 0; m < 4; ++m) _Pragma("unroll") for (int k = 0; k < 2; ++k) dst[m][k] = *(const LAS bf16x8*)(lds + PG8_SA(b, h) + aoff + m * 2048 + k * 1024); } while (0)
#define PG8_LDB(dst, b, h) do { _Pragma("unroll") for (int n = 0; n < 2; ++n) _Pragma("unroll") for (int k = 0; k < 2; ++k) dst[n][k] = *(const LAS bf16x8*)(lds + PG8_SB(b, h) + boff + n * 2048 + k * 1024); } while (0)
#define PG8_CAT(x) __builtin_shufflevector(__builtin_bit_cast(i32x4, (x)[0]), __builtin_bit_cast(i32x4, (x)[1]), 0, 1, 2, 3, 4, 5, 6, 7)
#define PG8_MMA(ai, bj, At, Bt) do { __builtin_amdgcn_s_setprio(1); if constexpr (F8) { _Pragma("unroll") for (int m = 0; m < 4; ++m) _Pragma("unroll") for (int n = 0; n < 2; ++n) \
        acc[ai][bj][m][n] = __builtin_amdgcn_mfma_scale_f32_16x16x128_f8f6f4(PG8_CAT(Bt[n]), PG8_CAT(At[m]), acc[ai][bj][m][n], 0, 0, 0, Sched::SCALE_B, 0, Sched::SCALE_A); } else { \
        _Pragma("unroll") for (int m = 0; m < 4; ++m) _Pragma("unroll") for (int n = 0; n < 2; ++n) _Pragma("unroll") for (int k = 0; k < 2; ++k) \
        acc[ai][bj][m][n] = __builtin_amdgcn_mfma_f32_16x16x32_bf16(Bt[n][k], At[m][k], acc[ai][bj][m][n], 0, 0, 0); } __builtin_amdgcn_s_setprio(0); } while (0)
#define PG8_WAIT_V(n) asm volatile("s_waitcnt vmcnt(" #n ")" ::: "memory")
#define PG8_WAIT_L(n) asm volatile("s_waitcnt lgkmcnt(" #n ")" ::: "memory")
#define PG8_BAR __builtin_amdgcn_s_barrier()
#define PG8_SCHED __builtin_amdgcn_sched_barrier(0)
    Unit cur, nxt; int ui = 0;
    if (!S.next(0, cur)) return;
    f32x4 acc[2][2][4][2];
#pragma unroll
    for (int a = 0; a < 2; ++a)
#pragma unroll
        for (int b = 0; b < 2; ++b)
#pragma unroll
            for (int m = 0; m < 4; ++m)
#pragma unroll
                for (int n = 0; n < 2; ++n) acc[a][b][m][n] = (f32x4){0.f, 0.f, 0.f, 0.f};
    bf16x8 At[4][2], B0[2][2], B1[2][2];
    unsigned cA = cur.a, cB = cur.b;
    PG8_ROWS(cur, vA);
    PG8_STAGEB(PG8_SB(0, 0), cB, voffB); PG8_STAGEB(PG8_SB(0, 1), cB + hstepB, voffB); PG8_STAGEA(PG8_SA(0, 0), cA, vA[0]); PG8_STAGEA(PG8_SA(0, 1), cA + hstepA, vA[1]);
    if (wr == 1) PG8_BAR;
    PG8_WAIT_V(2); PG8_BAR;
    PG8_STAGEB(PG8_SB(1, 0), cB + kstep, voffB); PG8_STAGEA(PG8_SA(1, 0), cA + kstep, vA[0]); PG8_STAGEB(PG8_SB(1, 1), cB + hstepB + kstep, voffB);
    PG8_WAIT_V(6); PG8_BAR;
    for (;;) {
        const bool has_next = S.next(ui + 1, nxt);
        const unsigned nA = has_next ? nxt.a : cA, nB = has_next ? nxt.b : cB;
        if (GA) { if (has_next) PG8_ROWS(nxt, vN); else { _Pragma("unroll") for (int _h = 0; _h < 2; ++_h) { vN[_h][0] = vA[_h][0]; vN[_h][1] = vA[_h][1]; } } }
#pragma unroll 1
        for (int t = 0; t < nt; t += 2) {
            const bool last = (t == nt - 2);
            const unsigned a1 = cA + (unsigned)(t + 1) * kstep;
            const unsigned a2 = last ? nA : cA + (unsigned)(t + 2) * kstep, b2 = last ? nB : cB + (unsigned)(t + 2) * kstep;
            const unsigned a3 = a2 + kstep, b3 = b2 + kstep;
            const bool un = GA && last, hu = cur.hu != 0;
            PG8_LDB(B0, 0, 0); PG8_LDB(B1, 0, 1); PG8_SCHED; PG8_LDA(At, 0, 0); PG8_STAGEA(PG8_SA(1, 1), a1 + hstepA, vA[1]);
            PG8_WAIT_V(8); PG8_WAIT_L(0); PG8_BAR; PG8_MMA(0, 0, At, B0); PG8_MMA(0, 1, At, B1); PG8_BAR; PG8_SCHED;
            { PG8_SEL(0, un); if (!hu) PG8_LDA(At, 0, 1); PG8_STAGEB(PG8_SB(0, 0), b2, voffB); PG8_STAGEB(PG8_SB(0, 1), b2 + hstepB, voffB); PG8_STAGEA(PG8_SA(0, 0), a2, vs); }
            PG8_WAIT_V(8); PG8_WAIT_L(0); PG8_BAR; if (!hu) { PG8_MMA(1, 0, At, B0); PG8_MMA(1, 1, At, B1); } PG8_BAR; PG8_SCHED;
            { PG8_SEL(1, un); PG8_LDB(B0, 1, 0); PG8_LDB(B1, 1, 1); PG8_SCHED; PG8_LDA(At, 1, 0); PG8_STAGEA(PG8_SA(0, 1), a2 + hstepA, vs); }
            PG8_WAIT_V(8); PG8_WAIT_L(0); PG8_BAR; PG8_MMA(0, 0, At, B0); PG8_MMA(0, 1, At, B1); PG8_BAR; PG8_SCHED;
            { PG8_SEL(0, un); if (!hu) PG8_LDA(At, 1, 1); PG8_STAGEB(PG8_SB(1, 0), b3, voffB); PG8_STAGEB(PG8_SB(1, 1), b3 + hstepB, voffB); PG8_STAGEA(PG8_SA(1, 0), a3, vs); }
            PG8_WAIT_V(8); PG8_WAIT_L(0); PG8_BAR; if (!hu) { PG8_MMA(1, 0, At, B0); PG8_MMA(1, 1, At, B1); } PG8_BAR; PG8_SCHED;
        }
        if (wr == 0) PG8_BAR;
        { unsigned z_ = 0u; asm volatile("" : "+v"(z_)); const int ln_ = (int)__builtin_amdgcn_mbcnt_hi(~0u, __builtin_amdgcn_mbcnt_lo(~0u, z_));
          E(acc, cur, wr, wc, ln_ & 15, ln_ >> 4); }
        if (!has_next) break;
#pragma unroll
        for (int a = 0; a < 2; ++a)
#pragma unroll
            for (int b = 0; b < 2; ++b)
#pragma unroll
                for (int m = 0; m < 4; ++m)
#pragma unroll
                    for (int n = 0; n < 2; ++n) acc[a][b][m][n] = (f32x4){0.f, 0.f, 0.f, 0.f};
        cur = nxt; cA = nA; cB = nB; ++ui;
        if (GA) {
#pragma unroll
            for (int _h = 0; _h < 2; ++_h) { vA[_h][0] = vN[_h][0]; vA[_h][1] = vN[_h][1]; } }
        if (wr == 1) PG8_BAR;
    }
    PG8_WAIT_V(0);
    PG8_BAR;
#undef PG8_SA
#undef PG8_CAT
#undef PG8_ROWS
#undef PG8_SEL
#undef PG8_SB
#undef PG8_STAGEX
#undef PG8_STAGEA
#undef PG8_STAGEB
#undef PG8_LDA
#undef PG8_LDB
#undef PG8_MMA
#undef PG8_WAIT_V
#undef PG8_WAIT_L
#undef PG8_BAR
#undef PG8_SCHED
}
}
using pg8::Unit;

#define XB_TMO      128
#define XB_XCNT(j)  (256  + 64 * (j))
#define XB_XSUB(j)  (1280 + 64 * (j))
#define XB_XGEN(j)  (2304 + 64 * (j))
#define XB_TOP      3328
#define XB_TOPGEN   3392
#define XCD_BAR_WORDS 3456
#define XB_SPIN_CAP (1u << 18)
__device__ __forceinline__ unsigned xb_ld(unsigned* p)              { return __hip_atomic_load(p, __ATOMIC_RELAXED, __HIP_MEMORY_SCOPE_AGENT); }
__device__ __forceinline__ unsigned xb_add(unsigned* p, unsigned v) { return __hip_atomic_fetch_add(p, v, __ATOMIC_RELAXED, __HIP_MEMORY_SCOPE_AGENT); }
__device__ __forceinline__ unsigned xb_xcc_id() { return (unsigned)__builtin_amdgcn_s_getreg((3 << 11) | 20) & 0xFu; }
#define XB_SPIN(cond, bar) do { unsigned _sp = 0; while (cond) { __builtin_amdgcn_s_sleep(1); \
    if ((++_sp & 255u) == 0u) { if (xb_ld(&(bar)[XB_TMO])) break; if (_sp > XB_SPIN_CAP) { atomicAdd(&(bar)[XB_TMO], 1u); break; } } } } while (0)
struct XcdBarrier { unsigned* bar; unsigned x; volatile LAS unsigned* st; };
__device__ __forceinline__ XcdBarrier xcd_barrier_post(unsigned* bar, volatile LAS unsigned* st) {
    XcdBarrier b; b.bar = bar; b.x = xb_xcc_id(); b.st = st;
    if (threadIdx.x == 0) (void)xb_add(&bar[XB_XCNT(b.x)], 1u);
    return b;
}
__device__ __forceinline__ void xcd_barrier_complete(unsigned* bar, unsigned x, unsigned& nloc, unsigned& nx) {
    const unsigned G = gridDim.x * gridDim.y * gridDim.z;
    unsigned sum, cnt, mine, sp = 0u;
    for (;;) {
        sum = 0u; cnt = 0u; mine = 0u;
#pragma unroll
        for (unsigned j = 0; j < 16; ++j) { const unsigned c = xb_ld(&bar[XB_XCNT(j)]); sum += c; cnt += (c > 0u) ? 1u : 0u; mine = (j == x) ? c : mine; }
        if (sum == G) break;
        __builtin_amdgcn_s_sleep(1);
        if ((++sp & 255u) == 0u) { if (xb_ld(&bar[XB_TMO])) break; if (sp > XB_SPIN_CAP) { atomicAdd(&bar[XB_TMO], 1u); break; } }
    }
    nloc = mine > 0u ? mine : 1u; nx = cnt > 0u ? cnt : 1u;
}
__device__ __forceinline__ void xcd_barrier(const XcdBarrier& b) {
    asm volatile("s_waitcnt vmcnt(0)" ::: "memory");
    __syncthreads();
    if (threadIdx.x == 0) {
        unsigned* bar = b.bar;
        __builtin_amdgcn_s_waitcnt(0);
        unsigned nloc = b.st[0], nx = b.st[1];
        if (nloc == 0u) { xcd_barrier_complete(bar, b.x, nloc, nx); b.st[0] = nloc; b.st[1] = nx; }
        const unsigned old = xb_add(&bar[XB_XSUB(b.x)], 1u);
        const unsigned gen = old / nloc;
        if (old + 1u == (gen + 1u) * nloc) {
            __builtin_amdgcn_fence(__ATOMIC_RELEASE, "agent");
            asm volatile("s_waitcnt vmcnt(0)" ::: "memory");
            const unsigned og = xb_add(&bar[XB_TOP], 1u);
            const unsigned tg = og / nx;
            if (og + 1u == (tg + 1u) * nx) xb_add(&bar[XB_TOPGEN], 1u);
            else XB_SPIN(xb_ld(&bar[XB_TOPGEN]) == tg, bar);
            __builtin_amdgcn_fence(__ATOMIC_ACQUIRE, "agent");
            xb_add(&bar[XB_XGEN(b.x)], 1u);
            asm volatile("s_waitcnt vmcnt(0)" ::: "memory");
        } else {
            XB_SPIN(xb_ld(&bar[XB_XGEN(b.x)]) == gen, bar);
            __builtin_amdgcn_fence(__ATOMIC_ACQUIRE, "agent");
            asm volatile("s_waitcnt vmcnt(0)" ::: "memory");
        }
    }
    __syncthreads();
}

constexpr size_t al256(size_t x) { return (x + 255) & ~(size_t)255; }
constexpr size_t WS_CTL = 0, CTL_ZERO_BYTES = 1u << 20;
constexpr int CW_QUEUE = 2048;
constexpr int CW_CNT = 1024;
constexpr int CW_BAR = 4096;
constexpr size_t WS_ADA   = CTL_ZERO_BYTES;
constexpr size_t WS_DEC   = al256(WS_ADA + (size_t)DEPTH * 17 * 6144 * 4);
constexpr size_t WS_W3T   = al256(WS_DEC + (size_t)DEPTH * 2 * 32 * 64 * 2 * 4);
constexpr size_t WS_FT    = al256(WS_W3T + (size_t)DEPTH * 32 * 256 * 512 * 2);
constexpr size_t WS_WINT  = al256(WS_FT + (size_t)DEPTH * 32 * 256 * 256 * 2);
constexpr size_t WS_WGLUT = al256(WS_WINT + (size_t)DEPTH * INW * D * 2);
constexpr size_t WS_WP5T  = al256(WS_WGLUT + (size_t)DEPTH * 512 * 512 * 2);
constexpr size_t WS_WPLT  = al256(WS_WP5T + (size_t)DEPTH * D * 512 * 2);
constexpr size_t WS_WOUTT = al256(WS_WPLT + (size_t)DEPTH * D * D * 2);
constexpr size_t WS_WUPT  = al256(WS_WOUTT + (size_t)DEPTH * D * D * 2);
constexpr size_t WS_WDNT  = al256(WS_WUPT + (size_t)DEPTH * NEXP * 2048 * D * 2);
constexpr size_t WS_X     = al256(WS_WDNT + (size_t)DEPTH * NEXP * D * D * 2);
constexpr size_t WS_HN    = al256(WS_X + (size_t)NTOK * D * 4);
constexpr size_t WS_A3    = al256(WS_HN + (size_t)NTOK * D * 2);
constexpr size_t WS_SB    = al256(WS_A3 + (size_t)NROW3 * 32 * 512 * 2);
constexpr size_t WS_XR    = al256(WS_SB + (size_t)NROW3 * 32 * 256 * 4);
constexpr size_t WS_GG    = al256(WS_XR + (size_t)NTOK * D * 2);
constexpr size_t WS_M5    = al256(WS_GG + (size_t)NTOK * D * 2);
constexpr size_t WS_ML    = al256(WS_M5 + (size_t)NTOK * D * 2);
constexpr size_t WS_HF    = al256(WS_ML + (size_t)NTOK * D * 2);
constexpr size_t WS_HB    = al256(WS_HF + (size_t)NTOK * D * 2);
constexpr size_t WS_OL    = al256(WS_HB + (size_t)NTOK * D * 2);
constexpr size_t WS_GY    = al256(WS_OL + (size_t)NTOK * D * 2);
constexpr size_t WS_O5    = al256(WS_GY + (size_t)NTOK * 512 * 2);
constexpr size_t WS_T1    = al256(WS_O5 + (size_t)NTOK * 512 * 2);
constexpr size_t WS_MG    = al256(WS_T1 + (size_t)NTOK * D * 2);
constexpr size_t WS_TOKE  = al256(WS_MG + (size_t)NTOK * D * 2);
constexpr size_t WS_TOKP  = al256(WS_TOKE + (size_t)NTOK * 4 * 4);
constexpr size_t WS_TOKW  = al256(WS_TOKP + (size_t)NTOK * 4 * 4);
constexpr size_t WS_SLOT  = al256(WS_TOKW + (size_t)NTOK * 4 * 4);
constexpr size_t WS_XS    = al256(WS_SLOT + (size_t)NTOK * 4 * 4);
constexpr size_t WS_ACT   = al256(WS_XS + (size_t)MAXSLOT * D * 2);
constexpr size_t WS_Y     = al256(WS_ACT + (size_t)MAXSLOT * D * 2);
constexpr size_t WS_END   = al256(WS_Y + (size_t)MAXSLOT * D * 2);

constexpr int LDS_BYTES = 147456;
constexpr int LDS_CTL = 143360;
constexpr int LC_MISC = LDS_CTL;
constexpr int LC_OFFS = LDS_CTL + 256;
constexpr int LC_LCNT = LDS_CTL + 512;
constexpr int LC_GB   = LDS_CTL + 768;
constexpr int LC_TILE = LDS_CTL + 1024;
constexpr int LC_PTRS = LDS_CTL + 2048;

struct Args { const float* in[36]; float* out; unsigned char* ws; int ph_lo, ph_hi; };

struct Ctx {
    float* out; unsigned char* ws; LAS unsigned char* lds; int tid, lane, wave, G;
    template <class T> __device__ __forceinline__ T* p(size_t off) const { return (T*)(ws + off); }
    __device__ __forceinline__ const float* in(int k) const { const LAS unsigned* t = (const LAS unsigned*)(lds + LC_PTRS) + 2 * k;
        const unsigned lo = __builtin_amdgcn_readfirstlane(t[0]), hi = __builtin_amdgcn_readfirstlane(t[1]); return (const float*)(((unsigned long long)hi << 32) | lo); }
};

struct SchedGrid {
    static constexpr bool GATHER = false, F8 = false; static constexpr int SCALE_A = 127 * 0x01010101, SCALE_B = 127 * 0x01010101, rowmax = 0; const __attribute__((address_space(1))) i32x4* rowtab4;
    pg8::StaticOrder so; unsigned atile, btile;
    __device__ __forceinline__ bool next(int i, Unit& u) const { int hs; if (!so.next(i, u.pm, u.pn, u.hu, hs)) return false; u.grp = 0; u.hoff = hs * 128; u.a = (unsigned)u.pm * atile + (unsigned)hs * (atile >> 1); u.b = (unsigned)u.pn * btile; return true; }
};
struct SchedS5 {
    static constexpr bool GATHER = false, F8 = false; static constexpr int SCALE_A = 127 * 0x01010101, SCALE_B = 127 * 0x01010101, rowmax = 0; const __attribute__((address_space(1))) i32x4* rowtab4; int G, c; unsigned bgrp;
    __device__ __forceinline__ bool next(int i, Unit& u) const { int L, hs; if (!pg8::tail_map((long)i * G + c, 288, G, L, u.hu, hs)) return false; const int g = L / 9, pm = L - g * 9; u.pm = pm; u.pn = 0; u.grp = g; u.hoff = hs * 128;
        u.a = ((unsigned)(pm * 256 + hs * 128) * 16384 + (unsigned)g * 512) * 2; u.b = (unsigned)g * bgrp; return true; }
};
template <bool GA, bool F8_>
struct SchedMoe {
    int rowmax; static constexpr bool GATHER = GA, F8 = F8_; static constexpr int SCALE_A = (127 - pg8::ACT8_SHIFT) * 0x01010101, SCALE_B = (127 - pg8::W8_SHIFT) * 0x01010101;
    const __attribute__((address_space(1))) i32x4* rowtab4; pg8::StaticOrder so; unsigned atile, btile, bexp; const LAS unsigned char* tile_e;
    __device__ __forceinline__ bool next(int i, Unit& u) const { int hs; if (!so.next(i, u.pm, u.pn, u.hu, hs)) return false; u.grp = __builtin_amdgcn_readfirstlane((int)tile_e[u.pm]);     u.hoff = hs * 128; u.a = GA ? 0u : (unsigned)u.pm * atile + (unsigned)hs * (atile >> 1); u.b = (unsigned)u.grp * bexp + (unsigned)u.pn * btile; return true; }
};

#define EPI_ROWS_BEGIN  _Pragma("unroll") for (int ai = 0; ai < 2; ++ai) _Pragma("unroll") for (int m = 0; m < 4; ++m) { if (ai == 1 && u.hu) continue; const int row = u.pm * 256 + u.hoff + ai * 128 + wr * 64 + m * 16 + fr;
#define EPI_ROWS_END    asm volatile("" ::: "memory"); }
__device__ __forceinline__ u32x4 pack8(const f32x4 a, const f32x4 b) { u32x4 w; w.x = cvt_pk_bf16(a[0], a[1]); w.y = cvt_pk_bf16(a[2], a[3]); w.z = cvt_pk_bf16(b[0], b[1]); w.w = cvt_pk_bf16(b[2], b[3]); return w; }
__device__ __forceinline__ void unpack8(const u32x4 w, f32x4& a, f32x4& b) { a = (f32x4){bflo(w.x), bfhi(w.x), bflo(w.y), bfhi(w.y)}; b = (f32x4){bflo(w.z), bfhi(w.z), bflo(w.w), bfhi(w.w)}; }

struct EpiInProj {
    static constexpr bool PERM = true;
    bf16_t *A3, *XR, *GG, *M5, *ML;
    __device__ __forceinline__ void operator()(const f32x4 (&acc)[2][2][4][2], const Unit& u, int wr, int wc, int fr, int fq) const {
        const int pn = u.pn;
        EPI_ROWS_BEGIN
#pragma unroll
            for (int bj = 0; bj < 2; ++bj) {
                const int col = pn * 256 + bj * 128 + wc * 32 + 8 * fq; f32x4 v0 = acc[ai][bj][m][0], v1 = acc[ai][bj][m][1];
                if (pn < 2) {
                    int b, cidx, j; if (row < NLAT) { b = row >> 11; const int t = row & 2047; cidx = 16 + (t >> 4); j = t & 15; } else { const int rr = row - NLAT; b = rr >> 8; const int tc = rr & 255; cidx = tc >> 4; j = tc & 15; }
                    const int g = col >> 4, h = col & 15;
                    *(u32x4*)(A3 + ((size_t)((b * NCH + cidx) * 32 + g)) * 512 + j * 16 + h) = pack8(v0, v1);
                } else if (pn < 6) {
                    *(u32x4*)(XR + (size_t)row * D + (col - 512)) = pack8(v0, v1);
                } else if (pn < 10) {
#pragma unroll
                    for (int q = 0; q < 4; ++q) { v0[q] = gelu_tanh(v0[q]); v1[q] = gelu_tanh(v1[q]); }
                    *(u32x4*)(GG + (size_t)row * D + (col - 1536)) = pack8(v0, v1);
                } else {
#pragma unroll
                    for (int q = 0; q < 4; ++q) { v0[q] = sigmoidf_(v0[q]); v1[q] = sigmoidf_(v1[q]); }
                    bf16_t* dst = pn < 14 ? M5 + (size_t)row * D + (col - 2560) : ML + (size_t)row * D + (col - 3584);
                    *(u32x4*)dst = pack8(v0, v1);
                }
            }
        EPI_ROWS_END
    }
};
struct EpiS5L1 {
    static constexpr bool PERM = false;
    float* S;
    __device__ __forceinline__ void operator()(const f32x4 (&acc)[2][2][4][2], const Unit& u, int wr, int wc, int fr, int fq) const {
        EPI_ROWS_BEGIN
            float* rowp = S + ((size_t)row * 32 + u.grp) * 256 + wc * 32 + 4 * fq;
#pragma unroll
            for (int bj = 0; bj < 2; ++bj)
#pragma unroll
                for (int n = 0; n < 2; ++n) *(f32x4*)(rowp + bj * 128 + n * 16) = acc[ai][bj][m][n];
        EPI_ROWS_END
    }
};
struct EpiS5Y {
    static constexpr bool PERM = true;
    bf16_t* GY;
    __device__ __forceinline__ void operator()(const f32x4 (&acc)[2][2][4][2], const Unit& u, int wr, int wc, int fr, int fq) const {
        EPI_ROWS_BEGIN
            const int b = row / NCH, cidx = row - b * NCH;
            const int tok0 = cidx < 16 ? NLAT + b * 256 + cidx * 16 : b * 2048 + (cidx - 16) * 16;
#pragma unroll
            for (int bj = 0; bj < 2; ++bj) {
                const int col = bj * 128 + wc * 32 + 8 * fq, j = col >> 4, h = col & 15; f32x4 v0 = acc[ai][bj][m][0], v1 = acc[ai][bj][m][1];
#pragma unroll
                for (int q = 0; q < 4; ++q) { v0[q] = gelu_tanh(v0[q]); v1[q] = gelu_tanh(v1[q]); }
                *(u32x4*)(GY + (size_t)(tok0 + j) * 512 + u.grp * 16 + h) = pack8(v0, v1);
            }
        EPI_ROWS_END
    }
};
#define GAS __attribute__((address_space(1)))
struct EpiGlu {
    static constexpr bool PERM = true;
    const bf16_t* GY; bf16_t* O5; const float* bias;
    __device__ __forceinline__ void operator()(const f32x4 (&acc)[2][2][4][2], const Unit& u, int wr, int wc, int fr, int fq) const {
        const int col0 = u.pn * 256 + wc * 32 + 8 * fq;
        f32x4 bb[2][2];
#pragma unroll
        for (int bj = 0; bj < 2; ++bj) { bb[bj][0] = *(const GAS f32x4*)(bias + col0 + bj * 128); bb[bj][1] = *(const GAS f32x4*)(bias + col0 + bj * 128 + 4); }
#pragma unroll
        for (int ai = 0; ai < 2; ++ai) {
            if (ai == 1 && u.hu) break;
            const size_t r0 = (size_t)(u.pm * 256 + u.hoff + ai * 128 + wr * 64 + fr) * 512 + col0;
            u32x4 gy[4][2];
#pragma unroll
            for (int m = 0; m < 4; ++m)
#pragma unroll
                for (int bj = 0; bj < 2; ++bj) gy[m][bj] = *(const GAS u32x4*)(GY + r0 + (size_t)m * 16 * 512 + bj * 128);
#pragma unroll
            for (int m = 0; m < 4; ++m)
#pragma unroll
                for (int bj = 0; bj < 2; ++bj) { f32x4 v0 = acc[ai][bj][m][0], v1 = acc[ai][bj][m][1], g0, g1; unpack8(gy[m][bj], g0, g1);
#pragma unroll
                    for (int q = 0; q < 4; ++q) { v0[q] = g0[q] * sigmoidf_(v0[q] + bb[bj][0][q]); v1[q] = g1[q] * sigmoidf_(v1[q] + bb[bj][1][q]); }
                    *(GAS u32x4*)(O5 + r0 + (size_t)m * 16 * 512 + bj * 128) = pack8(v0, v1); }
            asm volatile("" ::: "memory");
        }
    }
};
struct EpiMulGate {
    static constexpr bool PERM = true;
    const bf16_t* GATE; const bf16_t* ADD; bf16_t* O;
    __device__ __forceinline__ void operator()(const f32x4 (&acc)[2][2][4][2], const Unit& u, int wr, int wc, int fr, int fq) const {
#pragma unroll
        for (int ai = 0; ai < 2; ++ai) {
            if (ai == 1 && u.hu) break;
            const size_t r0 = (size_t)(u.pm * 256 + u.hoff + ai * 128 + wr * 64 + fr) * D + u.pn * 256 + wc * 32 + 8 * fq;
            u32x4 gt[4][2], ad[4][2];
#pragma unroll
            for (int m = 0; m < 4; ++m)
#pragma unroll
                for (int bj = 0; bj < 2; ++bj) { gt[m][bj] = *(const GAS u32x4*)(GATE + r0 + (size_t)m * 16 * D + bj * 128); if (ADD) ad[m][bj] = *(const GAS u32x4*)(ADD + r0 + (size_t)m * 16 * D + bj * 128); }
#pragma unroll
            for (int m = 0; m < 4; ++m)
#pragma unroll
                for (int bj = 0; bj < 2; ++bj) { f32x4 v0 = acc[ai][bj][m][0], v1 = acc[ai][bj][m][1], g0, g1; unpack8(gt[m][bj], g0, g1); v0 = v0 * g0; v1 = v1 * g1;
                    if (ADD) { f32x4 a0, a1; unpack8(ad[m][bj], a0, a1); v0 = v0 + a0; v1 = v1 + a1; }
                    *(GAS u32x4*)(O + r0 + (size_t)m * 16 * D + bj * 128) = pack8(v0, v1); }
            asm volatile("" ::: "memory");
        }
    }
};
struct EpiOut {
    static constexpr bool PERM = true;
    const float* xlat; const float* xctx; bf16_t* X; const float* ada; int l;
    __device__ __forceinline__ void operator()(const f32x4 (&acc)[2][2][4][2], const Unit& u, int wr, int wc, int fr, int fq) const {
        const int bsel = u.pm < 128 ? (u.pm >> 3) : 16;
        const float* gate = ada + ((size_t)(l * 17 + bsel) * 6 + 2) * D;
        const int col0 = u.pn * 256 + wc * 32 + 8 * fq;
        f32x4 gv[2][2];
#pragma unroll
        for (int bj = 0; bj < 2; ++bj)
#pragma unroll
            for (int n = 0; n < 2; ++n) gv[bj][n] = *(const GAS f32x4*)(gate + col0 + bj * 128 + n * 4);
        const float* srcb = u.pm < 128 ? xlat + (size_t)u.pm * 256 * D : xctx + (size_t)(u.pm - 128) * 256 * D;
        bf16_t* xb = X + (size_t)u.pm * 256 * D;
#pragma unroll
        for (int ai = 0; ai < 2; ++ai) {
            if (ai == 1 && u.hu) break;
            const size_t rr = (size_t)(u.hoff + ai * 128 + wr * 64 + fr) * D + col0;
            f32x4 xs[4][2][2];
            if (l == 0) {
#pragma unroll
                for (int m = 0; m < 4; ++m)
#pragma unroll
                    for (int bj = 0; bj < 2; ++bj)
#pragma unroll
                        for (int n = 0; n < 2; ++n) xs[m][bj][n] = *(const GAS f32x4*)(srcb + rr + (size_t)m * 16 * D + bj * 128 + n * 4);
            } else {
                u32x4 xr[4][2];
#pragma unroll
                for (int m = 0; m < 4; ++m)
#pragma unroll
                    for (int bj = 0; bj < 2; ++bj) xr[m][bj] = *(const GAS u32x4*)(xb + rr + (size_t)m * 16 * D + bj * 128);
#pragma unroll
                for (int m = 0; m < 4; ++m)
#pragma unroll
                    for (int bj = 0; bj < 2; ++bj) unpack8(xr[m][bj], xs[m][bj][0], xs[m][bj][1]);
            }
#pragma unroll
            for (int m = 0; m < 4; ++m)
#pragma unroll
                for (int bj = 0; bj < 2; ++bj)
                    *(GAS u32x4*)(xb + rr + (size_t)m * 16 * D + bj * 128) = pack8(xs[m][bj][0] + gv[bj][0] * acc[ai][bj][m][0], xs[m][bj][1] + gv[bj][1] * acc[ai][bj][m][1]);
            asm volatile("" ::: "memory");
        }
    }
};
struct EpiUp {
    static constexpr bool PERM = true;
    bf16_t* ACT; const float* bup;
    __device__ __forceinline__ void operator()(const f32x4 (&acc)[2][2][4][2], const Unit& u, int wr, int wc, int fr, int fq) const {
        const int a0 = u.pn * 128 + wc * 32 + 8 * fq;
        const float* bp = bup + (size_t)u.grp * 2048 + 2 * a0;
        constexpr float SC = (float)(1 << pg8::ACT8_SHIFT);
        float bg[8], bu4[8];
#pragma unroll
        for (int q = 0; q < 4; ++q) { const f32x4 t = *(const GAS f32x4*)(bp + 4 * q); bg[2 * q] = t[0]; bu4[2 * q] = SC * t[1] + SC; bg[2 * q + 1] = t[2]; bu4[2 * q + 1] = SC * t[3] + SC; }
        EPI_ROWS_BEGIN
            float o[8];
#pragma unroll
            for (int q = 0; q < 8; ++q) {
                const float gt = fminf(acc[ai][0][m][q >> 2][q & 3] + bg[q], 7.0f);
                const float u4 = __builtin_amdgcn_fmed3f(fmaf(acc[ai][1][m][q >> 2][q & 3], SC, bu4[q]), -6.0f * SC, 8.0f * SC);
                const float e = __builtin_amdgcn_exp2f(gt * (-1.702f * 1.4426950409f));
                o[q] = (gt * __builtin_amdgcn_rcpf(1.0f + e)) * u4;
            }
            int p0 = 0, p1 = 0;
            p0 = __builtin_amdgcn_cvt_pk_fp8_f32(o[0], o[1], p0, false); p0 = __builtin_amdgcn_cvt_pk_fp8_f32(o[2], o[3], p0, true);
            p1 = __builtin_amdgcn_cvt_pk_fp8_f32(o[4], o[5], p1, false); p1 = __builtin_amdgcn_cvt_pk_fp8_f32(o[6], o[7], p1, true);
            *(GAS u32x2*)((unsigned char*)ACT + (size_t)row * D + a0) = (u32x2){(unsigned)p0, (unsigned)p1};
        EPI_ROWS_END
    }
};
struct EpiDown {
    static constexpr bool PERM = true;
    bf16_t* Y; const float* bdn; const int* TS;
    __device__ __forceinline__ void operator()(const f32x4 (&acc)[2][2][4][2], const Unit& u, int wr, int wc, int fr, int fq) const {
        int dst[2][4];
#pragma unroll
        for (int ai = 0; ai < 2; ++ai)
#pragma unroll
            for (int m = 0; m < 4; ++m) dst[ai][m] = (ai == 1 && u.hu) ? -1 : TS[u.pm * 256 + u.hoff + ai * 128 + wr * 64 + m * 16 + fr];
#pragma unroll
        for (int bj = 0; bj < 2; ++bj) {
            const int col = u.pn * 256 + bj * 128 + wc * 32 + 8 * fq;
            const f32x4 b0 = *(const f32x4*)(bdn + (size_t)u.grp * D + col), b1 = *(const f32x4*)(bdn + (size_t)u.grp * D + col + 4);
#pragma unroll
            for (int ai = 0; ai < 2; ++ai)
#pragma unroll
                for (int m = 0; m < 4; ++m) if (dst[ai][m] >= 0) { f32x4 v0 = (acc[ai][bj][m][0] + b0) * 4.0f, v1 = (acc[ai][bj][m][1] + b1) * 4.0f; int p0 = 0, p1 = 0;
#pragma unroll
                    for (int q = 0; q < 4; ++q) { v0[q] = __builtin_amdgcn_fmed3f(v0[q], -448.0f, 448.0f); v1[q] = __builtin_amdgcn_fmed3f(v1[q], -448.0f, 448.0f); }
                    p0 = __builtin_amdgcn_cvt_pk_fp8_f32(v0[0], v0[1], p0, false); p0 = __builtin_amdgcn_cvt_pk_fp8_f32(v0[2], v0[3], p0, true); p1 = __builtin_amdgcn_cvt_pk_fp8_f32(v1[0], v1[1], p1, false); p1 = __builtin_amdgcn_cvt_pk_fp8_f32(v1[2], v1[3], p1, true);
                    *(u32x2*)((unsigned char*)Y + (size_t)dst[ai][m] * D + col) = (u32x2){(unsigned)p0, (unsigned)p1}; }
            asm volatile("" ::: "memory");
        }
    }
};

struct TItem { const float* W; unsigned char* WT; int K, N, k0, n0, kind; };
__device__ __forceinline__ TItem titem_decode(const Ctx& C, int it) {
    constexpr int I_IN = 16 * 72, I_GLU = 8 * 8, I_P5 = 8 * 16, I_PL = 16 * 16, I_OUT = 16 * 16, I_UP1 = 16 * 32, I_UP = 32 * I_UP1, I_DN1 = 16 * 16, I_DN = 32 * I_DN1;
    constexpr int PER_L = I_IN + I_GLU + I_P5 + I_PL + I_OUT + I_UP + I_DN;
    TItem t; const int l = it / PER_L; int r = it - l * PER_L, item;
    if (r < I_IN) { t.W = C.in(8) + (size_t)l * D * INW; t.K = D; t.N = INW; t.WT = C.p<unsigned char>(WS_WINT) + (size_t)l * INW * D * 2; t.kind = 0; item = r; }
    else if ((r -= I_IN) < I_GLU) { t.W = C.in(17) + (size_t)l * 512 * 512; t.K = 512; t.N = 512; t.WT = C.p<unsigned char>(WS_WGLUT) + (size_t)l * 512 * 512 * 2; t.kind = 0; item = r; }
    else if ((r -= I_GLU) < I_P5) { t.W = C.in(26) + (size_t)l * 512 * D; t.K = 512; t.N = D; t.WT = C.p<unsigned char>(WS_WP5T) + (size_t)l * D * 512 * 2; t.kind = 0; item = r; }
    else if ((r -= I_P5) < I_PL) { t.W = C.in(27) + (size_t)l * D * D; t.K = D; t.N = D; t.WT = C.p<unsigned char>(WS_WPLT) + (size_t)l * D * D * 2; t.kind = 0; item = r; }
    else if ((r -= I_PL) < I_OUT) { t.W = C.in(28) + (size_t)l * D * D; t.K = D; t.N = D; t.WT = C.p<unsigned char>(WS_WOUTT) + (size_t)l * D * D * 2; t.kind = 0; item = r; }
    else if ((r -= I_OUT) < I_UP) { const int e = r / I_UP1; t.W = C.in(31) + ((size_t)l * NEXP + e) * D * 2048; t.K = D; t.N = 2048; t.WT = C.p<unsigned char>(WS_WUPT) + ((size_t)l * NEXP + e) * 2048 * D; t.kind = 2; item = r - e * I_UP1; }
    else { r -= I_UP; const int e = r / I_DN1; t.W = C.in(33) + ((size_t)l * NEXP + e) * D * D; t.K = D; t.N = D; t.WT = C.p<unsigned char>(WS_WDNT) + ((size_t)l * NEXP + e) * D * D; t.kind = 1; item = r - e * I_DN1; }
    const int nblk = t.N / 64, kb = item / nblk; t.k0 = 64 * kb; t.n0 = 64 * (item - kb * nblk); return t;
}
__device__ __forceinline__ void titem_load(const TItem& t, int lane, f32x4 (&v)[16]) {
    const int r = lane >> 4, c4 = lane & 15;
#pragma unroll
    for (int i = 0; i < 16; ++i) v[i] = *(const f32x4*)(t.W + (size_t)(t.k0 + 4 * i + r) * t.N + t.n0 + 4 * c4);
}
__device__ __forceinline__ void titem_to_lds(const f32x4 (&v)[16], LAS float* scr, int lane) {
    const int r = lane >> 4, c4 = lane & 15;
#pragma unroll
    for (int i = 0; i < 16; ++i) { LAS float* d = scr + (4 * i + r) * 65 + 4 * c4; d[0] = v[i][0]; d[1] = v[i][1]; d[2] = v[i][2]; d[3] = v[i][3]; }
    asm volatile("s_waitcnt lgkmcnt(0)" ::: "memory");
}
__device__ __forceinline__ void titem_store(const TItem& t, const LAS float* scr, int lane) {
    const int c = lane & 7, nn = lane >> 3;
#pragma unroll
    for (int j = 0; j < 8; ++j) { const int n = nn + 8 * j; const LAS float* sp = scr + (8 * c) * 65 + n;
        int orow = t.n0 + n;
        if (t.kind == 2) { const int a = orow >> 1, sft = orow & 1; orow = (a >> 7) * 256 + sft * 128 + (a & 127); }
        if (t.kind != 0) {
            const float sc = (float)(1 << pg8::W8_SHIFT); int p0 = 0, p1 = 0;
            p0 = __builtin_amdgcn_cvt_pk_fp8_f32(sp[0 * 65] * sc, sp[1 * 65] * sc, p0, false); p0 = __builtin_amdgcn_cvt_pk_fp8_f32(sp[2 * 65] * sc, sp[3 * 65] * sc, p0, true);
            p1 = __builtin_amdgcn_cvt_pk_fp8_f32(sp[4 * 65] * sc, sp[5 * 65] * sc, p1, false); p1 = __builtin_amdgcn_cvt_pk_fp8_f32(sp[6 * 65] * sc, sp[7 * 65] * sc, p1, true);
            *(u32x2*)(t.WT + (size_t)orow * t.K + t.k0 + 8 * c) = (u32x2){(unsigned)p0, (unsigned)p1}; }
        else { u32x4 o; o.x = cvt_pk_bf16(sp[0 * 65], sp[1 * 65]); o.y = cvt_pk_bf16(sp[2 * 65], sp[3 * 65]); o.z = cvt_pk_bf16(sp[4 * 65], sp[5 * 65]); o.w = cvt_pk_bf16(sp[6 * 65], sp[7 * 65]);
            *(u32x4*)(t.WT + ((size_t)orow * t.K + t.k0 + 8 * c) * 2) = o; } }
    asm volatile("s_waitcnt lgkmcnt(0)" ::: "memory");
}
__device__ __forceinline__ void phase_transposes(const Ctx& C) {
    LAS float* scr = (LAS float*)(C.lds + C.wave * 17408);
    constexpr int NITEMS = DEPTH * (16 * 72 + 8 * 8 + 8 * 16 + 16 * 16 + 16 * 16 + 32 * 16 * 32 + 32 * 16 * 16), CHUNK = 16;
    static_assert(NITEMS % CHUNK == 0, "items per chunk");
    unsigned* q = C.p<unsigned>(WS_CTL) + CW_QUEUE;
    for (;;) {
        unsigned base = 0; if (C.lane == 0) base = __hip_atomic_fetch_add(q, (unsigned)CHUNK, __ATOMIC_RELAXED, __HIP_MEMORY_SCOPE_AGENT);
        base = (unsigned)__builtin_amdgcn_readfirstlane((int)base); if (base >= (unsigned)NITEMS) break;
        f32x4 va[16]; TItem ta = titem_decode(C, (int)base); titem_load(ta, C.lane, va);
#pragma unroll 1
        for (int i = 0; i < CHUNK; ++i) {
            titem_to_lds(va, scr, C.lane);
            const TItem tcur = ta;
            if (i + 1 < CHUNK) { ta = titem_decode(C, (int)base + i + 1); titem_load(ta, C.lane, va); }
            titem_store(tcur, scr, C.lane);
        }
    }
}

__device__ __forceinline__ void phase_s5prep(const Ctx& C) {
    LAS float* PW = (LAS float*)(C.lds);
    LAS float* BB = (LAS float*)(C.lds + 17408);
    LAS float* CC = (LAS float*)(C.lds + 17408 + 16384);
    LAS float* KT = (LAS float*)(C.lds + 17408 + 32768);
    const int tid = C.tid;
    for (int item = blockIdx.x; item < DEPTH * 32; item += C.G) {
        const int l = item >> 5, g = item & 31;
        __syncthreads();
        if (tid < 128) {
            const int dr = tid >> 6, p = tid & 63; const size_t ix = ((size_t)(l * 2 + dr) * 32 + g) * 64 + p;
            const double lr = (double)C.in(9)[ix], li = (double)C.in(10)[ix], dt = exp((double)C.in(11)[(l * 2 + dr) * 32 + g]);
            for (int k = 0; k <= 16; ++k) { const double mag = exp(lr * dt * k), ang = li * dt * k; PW[((dr * 17 + k) * 64 + p) * 2] = (float)(mag * cos(ang)); PW[((dr * 17 + k) * 64 + p) * 2 + 1] = (float)(mag * sin(ang)); }
            const double m1 = exp(lr * dt), abr = m1 * cos(li * dt), abi = m1 * sin(li * dt), den = lr * lr + li * li, zr = abr - 1.0;
            const double qr = (zr * lr + abi * li) / den, qi = (abi * lr - zr * li) / den;
            for (int h = 0; h < 16; ++h) { const double br = (double)C.in(12)[ix * 16 + h], bi = (double)C.in(13)[ix * 16 + h];
                BB[((dr * 64 + p) * 16 + h) * 2] = (float)(qr * br - qi * bi); BB[((dr * 64 + p) * 16 + h) * 2 + 1] = (float)(qr * bi + qi * br); }
            float* dec = C.p<float>(WS_DEC) + ix * 2; const double m16 = exp(lr * dt * 16), a16 = li * dt * 16; dec[0] = (float)(m16 * cos(a16)); dec[1] = (float)(m16 * sin(a16));
        }
        for (int e = tid; e < 2 * 16 * 64; e += 512) { const int dr = e >> 10, h = (e >> 6) & 15, p = e & 63; const size_t ix = (((size_t)(l * 2 + dr) * 32 + g) * 16 + h) * 64 + p;
            CC[e * 2] = C.in(14)[ix]; CC[e * 2 + 1] = C.in(15)[ix]; }
        __syncthreads();
        for (int e = tid; e < 8192; e += 512) { const int dr = e >> 12, tau = (e >> 8) & 15, i = (e >> 4) & 15, ip = e & 15; float s = 0.f;
            for (int p = 0; p < 64; ++p) { const float cr = CC[((dr * 16 + i) * 64 + p) * 2], ci = CC[((dr * 16 + i) * 64 + p) * 2 + 1], pr = PW[((dr * 17 + tau) * 64 + p) * 2], pi = PW[((dr * 17 + tau) * 64 + p) * 2 + 1];
                const float xr = cr * pr - ci * pi, xi = cr * pi + ci * pr; s += xr * BB[((dr * 64 + p) * 16 + ip) * 2] - xi * BB[((dr * 64 + p) * 16 + ip) * 2 + 1]; }
            KT[e] = s; }
        __syncthreads();
        bf16_t* W3 = C.p<bf16_t>(WS_W3T) + (size_t)item * 256 * 512; bf16_t* FT = C.p<bf16_t>(WS_FT) + (size_t)item * 256 * 256;
        const float* dvec = C.in(16) + (size_t)l * 512 + g * 16;
        for (int e2 = tid; e2 < 256 * 256; e2 += 512) {
            const int row = e2 >> 8, col0 = (e2 & 255) * 2, j = row >> 4, i = row & 15; float v[2];
#pragma unroll
            for (int q = 0; q < 2; ++q) { const int col = col0 + q;
                if (col < 256) { const int jp = col >> 4, ip = col & 15; float s = 0.f; if (j >= jp) s += KT[((0 * 16 + (j - jp)) * 16 + i) * 16 + ip]; if (jp >= j) s += KT[((1 * 16 + (jp - j)) * 16 + i) * 16 + ip]; if (row == col) s += dvec[i]; v[q] = s; }
                else { const int cc = col - 256, dr = cc >> 7, isim = (cc >> 6) & 1, p = cc & 63, pw = dr ? 16 - j : j + 1;
                    const float cr = CC[((dr * 16 + i) * 64 + p) * 2], ci = CC[((dr * 16 + i) * 64 + p) * 2 + 1], pr = PW[((dr * 17 + pw) * 64 + p) * 2], pi = PW[((dr * 17 + pw) * 64 + p) * 2 + 1];
                    v[q] = isim ? -(cr * pi + ci * pr) : (cr * pr - ci * pi); } }
            *(unsigned*)(W3 + (size_t)row * 512 + col0) = cvt_pk_bf16(v[0], v[1]);
        }
        for (int e2 = tid; e2 < 256 * 128; e2 += 512) {
            const int n = e2 >> 7, col0 = (e2 & 127) * 2, blk = n >> 6, p = n & 63, dr = blk >> 1; float v[2];
#pragma unroll
            for (int q = 0; q < 2; ++q) { const int col = col0 + q, jp = col >> 4, ip = col & 15, pw = dr ? jp : 15 - jp;
                const float pr = PW[((dr * 17 + pw) * 64 + p) * 2], pi = PW[((dr * 17 + pw) * 64 + p) * 2 + 1], br = BB[((dr * 64 + p) * 16 + ip) * 2], bi = BB[((dr * 64 + p) * 16 + ip) * 2 + 1];
                v[q] = (blk & 1) ? (pr * bi + pi * br) : (pr * br - pi * bi); }
            *(unsigned*)(FT + (size_t)n * 256 + col0) = cvt_pk_bf16(v[0], v[1]);
        }
    }
    __syncthreads();
}

__device__ __forceinline__ void phase_ada(const Ctx& C) {
    LAS float* cond = (LAS float*)(C.lds);
    LAS float* red = (LAS float*)(C.lds + 17 * 1024 * 4);
    const int tid = C.tid;
    for (int e = tid; e < 17 * 1024; e += 512) { const float v = e < 16 * 1024 ? C.in(1)[e] : C.in(3)[e - 16 * 1024]; cond[e] = v * sigmoidf_(v); }
    __syncthreads();
    const int c = tid & 63, ks = tid >> 6;
    for (int item = C.G - 1 - (int)blockIdx.x; item < DEPTH * 96; item += C.G) {
        const int l = item / 96, cb = item - l * 96, col = cb * 64 + c;
        const float* W = C.in(4) + (size_t)l * D * 6144 + col;
        float acc[17];
#pragma unroll
        for (int r = 0; r < 17; ++r) acc[r] = 0.f;
        for (int k = ks * 128; k < ks * 128 + 128; k += 4) {
            const float w0 = W[(size_t)k * 6144], w1 = W[(size_t)(k + 1) * 6144], w2 = W[(size_t)(k + 2) * 6144], w3 = W[(size_t)(k + 3) * 6144];
#pragma unroll
            for (int r = 0; r < 17; ++r) { const f32x4 cv = *(const LAS f32x4*)(cond + r * 1024 + k); acc[r] += cv[0] * w0 + cv[1] * w1 + cv[2] * w2 + cv[3] * w3; }
        }
#pragma unroll
        for (int r = 0; r < 17; ++r) red[(ks * 17 + r) * 64 + c] = acc[r];
        __syncthreads();
        for (int e = tid; e < 17 * 64; e += 512) { const int r = e >> 6, cc = e & 63; float s = 0.f;
#pragma unroll
            for (int q = 0; q < 8; ++q) s += red[(q * 17 + r) * 64 + cc];
            C.p<float>(WS_ADA)[(size_t)(l * 17 + r) * 6144 + cb * 64 + cc] = s + C.in(5)[(size_t)l * 6144 + cb * 64 + cc]; }
        __syncthreads();
    }
}

__device__ __forceinline__ void load_row(const Ctx& C, bool from_input, int m, bool combine, int lc  , f32x4 (&v)[4]) {
    if (from_input) { const float* src = m < NLAT ? C.in(0) + (size_t)m * D : C.in(2) + (size_t)(m - NLAT) * D;
#pragma unroll
        for (int j = 0; j < 4; ++j) v[j] = *(const f32x4*)(src + 4 * C.lane + 256 * j); }
    else { const bf16_t* src = C.p<bf16_t>(WS_X) + (size_t)m * D;
#pragma unroll
        for (int j = 0; j < 4; ++j) { const u32x2 t = *(const u32x2*)(src + 4 * C.lane + 256 * j); v[j] = (f32x4){bflo(t.x), bfhi(t.x), bflo(t.y), bfhi(t.y)}; } }
    if (combine) {
        const int bsel = m < NLAT ? (m >> 11) : 16;
        const float* g2 = C.p<float>(WS_ADA) + ((size_t)(lc * 17 + bsel) * 6 + 5) * D;
        f32x4 s[4];
#pragma unroll
        for (int j = 0; j < 4; ++j) s[j] = (f32x4){0.f, 0.f, 0.f, 0.f};
#pragma unroll
        for (int k = 0; k < 4; ++k) {
            const float w = C.p<float>(WS_TOKW)[m * 4 + k] * (1.0f / 4.0f);
            const unsigned char* y = C.p<unsigned char>(WS_Y) + (size_t)(m * 4 + k) * D;
#pragma unroll
            for (int j = 0; j < 4; ++j) { const int t = *(const int*)(y + 4 * C.lane + 256 * j); const f32x2 lo = __builtin_amdgcn_cvt_pk_f32_fp8(t, false), hi = __builtin_amdgcn_cvt_pk_f32_fp8(t, true); s[j] += w * (f32x4){lo.x, lo.y, hi.x, hi.y}; }
        }
#pragma unroll
        for (int j = 0; j < 4; ++j) v[j] += *(const f32x4*)(g2 + 4 * C.lane + 256 * j) * s[j];
    }
}
__device__ __forceinline__ float row_rstd(const f32x4 (&v)[4], int lane) {
    float s = 0.f;
#pragma unroll
    for (int j = 0; j < 4; ++j) s += (v[j][0] * v[j][0] + v[j][1] * v[j][1]) + (v[j][2] * v[j][2] + v[j][3] * v[j][3]);
    return rsqrtf(wave_sum(s, lane) * (1.0f / D) + 1e-6f);
}
__device__ __forceinline__ void norm_mod(const Ctx& C, f32x4 (&v)[4], const float* gain, const float* shift, const float* scale) {
    const float rstd = row_rstd(v, C.lane);
#pragma unroll
    for (int j = 0; j < 4; ++j) { const int c = 4 * C.lane + 256 * j; const f32x4 gn = *(const f32x4*)(gain + c), sh = *(const f32x4*)(shift + c), sc = *(const f32x4*)(scale + c);
        v[j] = (v[j] * rstd * gn) * (sc + 1.0f) + sh; }
}
constexpr int Y8_SHIFT = 2;
__device__ __forceinline__ void unpack8_fp8(const u32x2 w, f32x4& a, f32x4& b) {
    const f32x2 a0 = __builtin_amdgcn_cvt_pk_f32_fp8((int)w.x, false), a1 = __builtin_amdgcn_cvt_pk_f32_fp8((int)w.x, true), b0 = __builtin_amdgcn_cvt_pk_f32_fp8((int)w.y, false), b1 = __builtin_amdgcn_cvt_pk_f32_fp8((int)w.y, true);
    a = (f32x4){a0.x, a0.y, a1.x, a1.y}; b = (f32x4){b0.x, b0.y, b1.x, b1.y}; }
struct RowV { f32x4 a[4]; };
__device__ __forceinline__ void n1_vec(const float* p, int lane, f32x4 (&o)[4]) { const GAS f32x4* q = (const GAS f32x4*)(p + 8 * lane); o[0] = q[0]; o[1] = q[1]; o[2] = q[128]; o[3] = q[129]; }
__device__ __forceinline__ void phase_norm1(const Ctx& C, int l) {
    const int gw = blockIdx.x * 8 + C.wave, NGW = C.G * 8, lane = C.lane;
    const int per = (NTOK + NGW - 1) / NGW, mb = gw * per, me = min(mb + per, NTOK);
    f32x4 gain[4], sh[4], sc[4], g2[4]; int cur_b = -1;
    n1_vec(C.in(6) + (size_t)l * D, lane, gain);
    const bool comb = l > 0;
    for (int m0 = mb; m0 < me; m0 += 2) {
        const bool has1 = m0 + 1 < me; const int m1 = has1 ? m0 + 1 : m0;
        RowV x[2]; u32x2 y[2][4][2]; f32x4 w[2];
#pragma unroll
        for (int r = 0; r < 2; ++r) { const int m = r ? m1 : m0;
            if (l == 0) { const float* src = m < NLAT ? C.in(0) + (size_t)m * D : C.in(2) + (size_t)(m - NLAT) * D; n1_vec(src, lane, x[r].a); }
            else { const GAS u32x4* q = (const GAS u32x4*)(C.p<bf16_t>(WS_X) + (size_t)m * D + 8 * lane); const u32x4 t0 = q[0], t1 = q[64]; unpack8(t0, x[r].a[0], x[r].a[1]); unpack8(t1, x[r].a[2], x[r].a[3]); }
            if (comb) { w[r] = *(const GAS f32x4*)(C.p<float>(WS_TOKW) + (size_t)m * 4);
#pragma unroll
                for (int k = 0; k < 4; ++k) { const GAS u32x2* q = (const GAS u32x2*)(C.p<unsigned char>(WS_Y) + (size_t)(m * 4 + k) * D + 8 * lane); y[r][k][0] = q[0]; y[r][k][1] = q[64]; } }
        }
#pragma unroll
        for (int r = 0; r < 2; ++r) { const int m = r ? m1 : m0; if (r == 1 && !has1) break;
            const int bsel = m < NLAT ? (m >> 11) : 16;
            if (bsel != cur_b) { cur_b = bsel; const float* ada = C.p<float>(WS_ADA) + (size_t)(l * 17 + bsel) * 6 * D; n1_vec(ada, lane, sh); n1_vec(ada + D, lane, sc);
                if (comb) n1_vec(C.p<float>(WS_ADA) + ((size_t)((l - 1) * 17 + bsel) * 6 + 5) * D, lane, g2); }
            if (comb) {
                f32x4 s4[4];
#pragma unroll
                for (int q = 0; q < 4; ++q) s4[q] = (f32x4){0.f, 0.f, 0.f, 0.f};
#pragma unroll
                for (int k = 0; k < 4; ++k) { f32x4 t0, t1, t2, t3; unpack8_fp8(y[r][k][0], t0, t1); unpack8_fp8(y[r][k][1], t2, t3); const float wk = w[r][k] * (1.0f / (float)(1 << Y8_SHIFT)); s4[0] += wk * t0; s4[1] += wk * t1; s4[2] += wk * t2; s4[3] += wk * t3; }
#pragma unroll
                for (int q = 0; q < 4; ++q) x[r].a[q] += g2[q] * s4[q];
                GAS u32x4* xo = (GAS u32x4*)(C.p<bf16_t>(WS_X) + (size_t)m * D + 8 * lane); xo[0] = pack8(x[r].a[0], x[r].a[1]); xo[64] = pack8(x[r].a[2], x[r].a[3]);
            }
            float ss = 0.f;
#pragma unroll
            for (int q = 0; q < 4; ++q) ss += (x[r].a[q][0] * x[r].a[q][0] + x[r].a[q][1] * x[r].a[q][1]) + (x[r].a[q][2] * x[r].a[q][2] + x[r].a[q][3] * x[r].a[q][3]);
            const float rstd = rsqrtf(wave_sum(ss, lane) * (1.0f / D) + 1e-6f);
            f32x4 h[4];
#pragma unroll
            for (int q = 0; q < 4; ++q) h[q] = (x[r].a[q] * rstd * gain[q]) * (sc[q] + 1.0f) + sh[q];
            GAS u32x4* ho = (GAS u32x4*)(C.p<bf16_t>(WS_HN) + (size_t)m * D + 8 * lane); ho[0] = pack8(h[0], h[1]); ho[64] = pack8(h[2], h[3]);
        }
    }
}
__device__ __forceinline__ void split_bf16(const f32x4 a, const f32x4 b, bf16x8& hi, bf16x8& lo) {
    u32x4 h = pack8(a, b); f32x4 ha, hb; unpack8(h, ha, hb); u32x4 lw = pack8(a - ha, b - hb); hi = __builtin_bit_cast(bf16x8, h); lo = __builtin_bit_cast(bf16x8, lw);
}
__device__ __forceinline__ void phase_norm2(const Ctx& C, int l, int ntok) {
    LAS float* T = (LAS float*)C.lds;
    LAS float* LG = (LAS float*)(C.lds + 131584);
    LAS int* lcnt = (LAS int*)(C.lds + LC_LCNT); LAS int* gb = (LAS int*)(C.lds + LC_GB);
    unsigned* CNT = C.p<unsigned>(WS_CTL) + CW_CNT + l * 32;
    const float* wr = C.in(29) + (size_t)l * D * 32; const float* br = C.in(30) + l * 32;
    const int tid = C.tid, lane = C.lane, w = C.wave;
    bf16x8 bhi[4][2], blo[4][2];
#pragma unroll
    for (int s = 0; s < 4; ++s)
#pragma unroll
        for (int nt = 0; nt < 2; ++nt) { const int k = 128 * w + 32 * s + 8 * (lane >> 4), e = 16 * nt + (lane & 15); f32x4 a, b;
#pragma unroll
            for (int j = 0; j < 4; ++j) { a[j] = wr[(size_t)(k + j) * 32 + e]; b[j] = wr[(size_t)(k + 4 + j) * 32 + e]; }
            split_bf16(a, b, bhi[s][nt], blo[s][nt]); }
    for (int blk = blockIdx.x; blk < ntok / 32; blk += C.G) {
        {
            f32x4 v[4][4]; const int mb = blk * 32 + w * 4;
#pragma unroll
            for (int rr = 0; rr < 4; ++rr) load_row(C, false, mb + rr, false, 0, v[rr]);
#pragma unroll
            for (int rr = 0; rr < 4; ++rr) { const int r = w * 4 + rr, m = mb + rr;
                const int bsel = m < NLAT ? (m >> 11) : 16; const float* ada = C.p<float>(WS_ADA) + (size_t)(l * 17 + bsel) * 6 * D;
                norm_mod(C, v[rr], C.in(7) + (size_t)l * D, ada + 3 * D, ada + 4 * D);
#pragma unroll
                for (int j = 0; j < 4; ++j) { const float sc = (float)(1 << pg8::ACT8_SHIFT); int pk = 0;
                    { f32x4 c4 = v[rr][j] * sc;
#pragma unroll
                      for (int q = 0; q < 4; ++q) c4[q] = __builtin_amdgcn_fmed3f(c4[q], -448.0f, 448.0f);
                      pk = __builtin_amdgcn_cvt_pk_fp8_f32(c4[0], c4[1], pk, false); pk = __builtin_amdgcn_cvt_pk_fp8_f32(c4[2], c4[3], pk, true); }
                    *(int*)(C.p<unsigned char>(WS_HN) + (size_t)m * D + 4 * lane + 256 * j) = pk;
                    *(LAS f32x4*)(T + r * 1028 + 4 * lane + 256 * j) = v[rr][j]; } }
        }
        if (tid < 32) lcnt[tid] = 0;
        __syncthreads();
        f32x4 acc[2][2];
#pragma unroll
        for (int mt = 0; mt < 2; ++mt)
#pragma unroll
            for (int nt = 0; nt < 2; ++nt) acc[mt][nt] = (f32x4){0.f, 0.f, 0.f, 0.f};
#pragma unroll
        for (int s = 0; s < 4; ++s)
#pragma unroll
            for (int mt = 0; mt < 2; ++mt) { const LAS float* tp = T + (16 * mt + (lane & 15)) * 1028 + 128 * w + 32 * s + 8 * (lane >> 4);
                bf16x8 ahi, alo; split_bf16(*(const LAS f32x4*)tp, *(const LAS f32x4*)(tp + 4), ahi, alo);
#pragma unroll
                for (int nt = 0; nt < 2; ++nt) {
                    acc[mt][nt] = __builtin_amdgcn_mfma_f32_16x16x32_bf16(ahi, bhi[s][nt], acc[mt][nt], 0, 0, 0);
                    acc[mt][nt] = __builtin_amdgcn_mfma_f32_16x16x32_bf16(alo, bhi[s][nt], acc[mt][nt], 0, 0, 0);
                    acc[mt][nt] = __builtin_amdgcn_mfma_f32_16x16x32_bf16(ahi, blo[s][nt], acc[mt][nt], 0, 0, 0); } }
        __syncthreads();
#pragma unroll
        for (int mt = 0; mt < 2; ++mt)
#pragma unroll
            for (int nt = 0; nt < 2; ++nt)
#pragma unroll
                for (int q = 0; q < 4; ++q) T[(w * 32 + 16 * mt + 4 * (lane >> 4) + q) * 33 + 16 * nt + (lane & 15)] = acc[mt][nt][q];
        __syncthreads();
#pragma unroll
        for (int o = tid; o < 1024; o += 512) { const int row = o >> 5, col = o & 31; float sum = 0.f;
#pragma unroll
            for (int q = 0; q < 8; ++q) sum += T[(q * 32 + row) * 33 + col];
            LG[row * 33 + col] = sum + br[col]; }
        __syncthreads();
        int te[4]; float tw[4]; int tp[4];
        if (tid < 32) {
            unsigned used = 0u; float tv[4];
#pragma unroll
            for (int k = 0; k < 4; ++k) { float best = -3.0e38f; int bi = 0;
                for (int e = 0; e < 32; ++e) { const float x = LG[tid * 33 + e]; if (!((used >> e) & 1u) && x > best) { best = x; bi = e; } }
                used |= 1u << bi; te[k] = bi; tv[k] = best; }
            float sm = 0.f;
#pragma unroll
            for (int k = 0; k < 4; ++k) { tw[k] = __expf(tv[k] - tv[0]); sm += tw[k]; }
#pragma unroll
            for (int k = 0; k < 4; ++k) { tw[k] /= sm; tp[k] = atomicAdd((int*)&lcnt[te[k]], 1); }
        }
        __syncthreads();
        if (tid < 32) { const int n = lcnt[tid]; gb[tid] = n > 0 ? (int)atomicAdd(CNT + tid, (unsigned)n) : 0; }
        __syncthreads();
        if (tid < 32) { const int m = blk * 32 + tid;
#pragma unroll
            for (int k = 0; k < 4; ++k) { C.p<int>(WS_TOKE)[m * 4 + k] = te[k]; C.p<int>(WS_TOKP)[m * 4 + k] = gb[te[k]] + tp[k]; C.p<float>(WS_TOKW)[m * 4 + k] = tw[k]; } }
        __syncthreads();
    }
}
__device__ __forceinline__ int moe_offsets(const Ctx& C, int l, bool tiles) {
    LAS int* offs = (LAS int*)(C.lds + LC_OFFS); LAS unsigned char* tile_e = (LAS unsigned char*)(C.lds + LC_TILE);
    unsigned* CNT = C.p<unsigned>(WS_CTL) + CW_CNT + l * 32;
    __syncthreads();
    if (C.tid == 0) { int o = 0;
#pragma unroll 1
        for (int e = 0; e < 32; ++e) { offs[e] = o; const int n = (int)__hip_atomic_load(CNT + e, __ATOMIC_RELAXED, __HIP_MEMORY_SCOPE_AGENT); o += (n + 255) & ~255; } offs[32] = o; }
    __syncthreads();
    const int tt = offs[32] >> 8;
    if (tiles) { for (int t = C.tid; t < tt; t += 512) { int e = 0;
#pragma unroll 1
        while (e < 31 && offs[e + 1] <= t * 256) ++e; tile_e[t] = (unsigned char)e; } __syncthreads(); }
    return tt;
}
__device__ __forceinline__ void phase_slots(const Ctx& C, int l, int ntok) {
    moe_offsets(C, l, false);
    LAS int* offs = (LAS int*)(C.lds + LC_OFFS);
    unsigned* CNT = C.p<unsigned>(WS_CTL) + CW_CNT + l * 32;
    int* TS = C.p<int>(WS_XS);
    int* TS2 = (int*)(C.ws + WS_XS + (1u << 20));
    const int gt = blockIdx.x * 512 + C.tid, NGT = C.G * 512;
    for (int w = gt; w < ntok * 32; w += NGT) {
        const int idx = w >> 3, cc = w & 7;
        const int e = C.p<int>(WS_TOKE)[idx], slot = offs[e] + C.p<int>(WS_TOKP)[idx];
        if (cc == 0) TS[slot] = idx;
        const int tile = slot >> 8, r = slot & 255, h = r >> 7, R = r & 127, bb = pg8::lds_byte(R, 8 * cc), i = bb >> 13, t = (bb & 8191) >> 4;
        TS2[((tile * 512 + t) * 2 + h) * 2 + i] = (idx >> 2) * D + 16 * cc;
    }
#pragma unroll 1
    for (int e = 0; e < 32; ++e) { const int n = (int)__hip_atomic_load(CNT + e, __ATOMIC_RELAXED, __HIP_MEMORY_SCOPE_AGENT), p0 = offs[e] + n, p1 = offs[e + 1];
        if (gt < (p1 - p0) * 8) { const int slot = p0 + (gt >> 3), cc = gt & 7; if (cc == 0) TS[slot] = -1;
            const int tile = slot >> 8, r = slot & 255, h = r >> 7, R = r & 127, bb = pg8::lds_byte(R, 8 * cc), i = bb >> 13, t = (bb & 8191) >> 4;
            TS2[((tile * 512 + t) * 2 + h) * 2 + i] = 16 * cc; } }
}
__device__ __forceinline__ void phase_final(const Ctx& C) {
    const int gw = blockIdx.x * 8 + C.wave, NGW = C.G * 8;
    for (int m = gw; m < NLAT; m += NGW) {
        f32x4 v[4]; load_row(C, false, m, true, DEPTH - 1, v);
        const float rstd = row_rstd(v, C.lane);
#pragma unroll
        for (int j = 0; j < 4; ++j) { const int c = 4 * C.lane + 256 * j; *(f32x4*)(C.out + (size_t)m * D + c) = v[j] * rstd * *(const f32x4*)(C.in(35) + c); }
    }
}

__device__ __forceinline__ void phase_s5carry_ol(const Ctx& C, int l) {
    if (C.tid < 256) {
        for (int gid = blockIdx.x * 256 + C.tid; gid < 65536; gid += C.G * 256) {
            const int p = gid & 63, dr = (gid >> 6) & 1, g = (gid >> 7) & 31, b = gid >> 12;
            const f32x2 dec = *(const f32x2*)(C.p<float>(WS_DEC) + (((size_t)(l * 2 + dr) * 32 + g) * 64 + p) * 2);
            float hr = 0.f, hi = 0.f;
#pragma unroll 1
            for (int k0 = 0; k0 < NCH; k0 += 16) {
                float sr[16], si[16];
#pragma unroll
                for (int q = 0; q < 16; ++q) { const int k = k0 + q, cidx = dr == 0 ? k : (k < 16 ? 15 - k : 159 - k);
                    const float* sp = C.p<float>(WS_SB) + ((size_t)(b * NCH + cidx) * 32 + g) * 256 + dr * 128 + p; sr[q] = sp[0]; si[q] = sp[64]; }
#pragma unroll
                for (int q = 0; q < 16; ++q) { const int k = k0 + q, cidx = dr == 0 ? k : (k < 16 ? 15 - k : 159 - k);
                    bf16_t* a3 = C.p<bf16_t>(WS_A3) + ((size_t)(b * NCH + cidx) * 32 + g) * 512 + 256 + dr * 128 + p;
                    a3[0] = f2bf(hr); a3[64] = f2bf(hi);
                    const float nr = dec.x * hr - dec.y * hi + sr[q], ni = dec.x * hi + dec.y * hr + si[q]; hr = nr; hi = ni; }
            }
        }
    }
}

__device__ __forceinline__ int lru_row(int b, bool isctx, int p) { return isctx ? NLAT + b * 256 + p : b * 2048 + (p & 31) * 64 + (p >> 5); }
__device__ __forceinline__ void phase_lru(const Ctx& C, int l) {
    const int tid = C.tid, dir = tid >> 8, lt = tid & 255, lw = (tid >> 6) & 3, lane = tid & 63;
    const int mt = lw >> 1, ct = lw & 1, half = lane >> 5, cl = lane & 31;
    LAS unsigned char* R = C.lds + dir * 49152;
    LAS unsigned char* XT = R;
    LAS unsigned char* XC = R + 8704;
    LAS float* SEG = (LAS float*)(R + 17920);
    LAS unsigned char* OT = R + 19968;
    LAS unsigned char* G2 = R + 29184;
    LAS unsigned char* OUTT = R + 38400;
    const bf16_t* XR = C.p<bf16_t>(WS_XR); bf16_t* HOUT = C.p<bf16_t>(dir ? WS_HB : WS_HF);
    const bf16_t* HOTH = C.p<bf16_t>(dir ? WS_HF : WS_HB); const bf16_t* GGp = C.p<bf16_t>(WS_GG); bf16_t* OLp = C.p<bf16_t>(WS_OL);
    const int seg = 2 * mt + half, ch = 32 * ct + cl;
    const int srow = 16 * (2 * mt + ((cl >> 2) & 1)) + (cl & 3) + 4 * (cl >> 3);
    const int qrow = dir ? 63 - srow : srow;
    for (int task = blockIdx.x; task < 256; task += C.G) {
        const int b = task >> 4, n = task & 15;
        const float lam = C.in(21)[(size_t)(l * 2 + dir) * D + n * 64 + ch];
        const float coef2 = -8.0f * log1pf(__expf(-lam)) * 1.4426950409f;
        const int c2 = lt & 31, pg = lt >> 5;
        float cw[4][2], cb[2];
#pragma unroll
        for (int j = 0; j < 4; ++j) { cw[j][0] = C.in(19)[((size_t)l * 4 + j) * D + n * 64 + 2 * c2]; cw[j][1] = C.in(19)[((size_t)l * 4 + j) * D + n * 64 + 2 * c2 + 1]; }
        cb[0] = C.in(20)[(size_t)l * D + n * 64 + 2 * c2]; cb[1] = C.in(20)[(size_t)l * D + n * 64 + 2 * c2 + 1];
        const float* Wa = C.in(22) + ((size_t)((l * 2 + dir) * 16 + n) * 64) * 64; const float* Wx = C.in(24) + ((size_t)((l * 2 + dir) * 16 + n) * 64) * 64;
        bf16x8 bfa[4], bfx[4];
#pragma unroll
        for (int s = 0; s < 4; ++s) {
            unsigned wa[4], wx[4];
#pragma unroll
            for (int jj = 0; jj < 4; ++jj) { const int k = 16 * s + 8 * half + 2 * jj; wa[jj] = cvt_pk_bf16(Wa[(size_t)k * 64 + ch], Wa[(size_t)(k + 1) * 64 + ch]); wx[jj] = cvt_pk_bf16(Wx[(size_t)k * 64 + ch], Wx[(size_t)(k + 1) * 64 + ch]); }
            u32x4 ta = (u32x4){wa[0], wa[1], wa[2], wa[3]}, tx = (u32x4){wx[0], wx[1], wx[2], wx[3]}; bfa[s] = __builtin_bit_cast(bf16x8, ta); bfx[s] = __builtin_bit_cast(bf16x8, tx);
        }
        const float bias_a = C.in(23)[(size_t)(l * 2 + dir) * D + n * 64 + ch], bias_x = C.in(25)[(size_t)(l * 2 + dir) * D + n * 64 + ch];
        const float nba = -1.4426950409f * bias_a, nbx = -1.4426950409f * bias_x;
        float hrun = 0.f;
        u32x4 pf[3];
        auto issue_tile = [&](int it) {
            const bool isctx = it < 4; const int p0 = dir == 0 ? (isctx ? 64 * it : 64 * (it - 4)) : (isctx ? 64 * (3 - it) : 64 * (35 - it)); const int slen = isctx ? 256 : 2048;
#pragma unroll
            for (int r = 0; r < 3; ++r) { const int q = lt + 256 * r, rr = q >> 3, pc = q & 7, p = p0 - 1 + rr;
                pf[r] = (u32x4){0u, 0u, 0u, 0u};
                if (rr < 67 && p >= 0 && p < slen) pf[r] = *(const u32x4*)(XR + (size_t)lru_row(b, isctx, p) * D + n * 64 + pc * 8); }
        };
        auto lru_flush = [&](int itp) {
            const bool cx = itp < 4; const int pp = dir == 0 ? (cx ? 64 * itp : 64 * (itp - 4)) : (cx ? 64 * (3 - itp) : 64 * (35 - itp)); const bool sec = itp < 4 ? itp >= 2 : itp >= 20;
            bf16_t* dstb = sec ? OLp : HOUT;
#pragma unroll
            for (int r = 0; r < 2; ++r) { const int q = lt + 256 * r, rr = q >> 3, pc = q & 7; *(GAS u32x4*)(dstb + (size_t)lru_row(b, cx, pp + rr) * D + n * 64 + pc * 8) = *(const LAS u32x4*)(OUTT + rr * 144 + pc * 16); }
        };
        issue_tile(0);
#pragma unroll 1
        for (int it = 0; it < 36; ++it) {
            const bool isctx = it < 4; const int p0 = dir == 0 ? (isctx ? 64 * it : 64 * (it - 4)) : (isctx ? 64 * (3 - it) : 64 * (35 - it));
#pragma unroll
            for (int r = 0; r < 3; ++r) { const int q = lt + 256 * r, rr = q >> 3, pc = q & 7; if (rr < 67) *(LAS u32x4*)(XT + rr * 128 + pc * 16) = pf[r]; }
            __syncthreads();
            if (it + 1 < 36) issue_tile(it + 1);
            if (it > 0) lru_flush(it - 1);
            const bool second = it < 4 ? it >= 2 : it >= 20;
            {
                float x0[11], x1[11];
#pragma unroll
                for (int r = 0; r < 11; ++r) { const unsigned w = *(const LAS unsigned*)(XT + (8 * pg + r) * 128 + c2 * 4); x0[r] = bflo(w); x1[r] = bfhi(w); }
#pragma unroll
                for (int q = 0; q < 8; ++q) { float y0 = cb[0], y1 = cb[1];
#pragma unroll
                    for (int j = 0; j < 4; ++j) { y0 += cw[j][0] * x0[q + j]; y1 += cw[j][1] * x1[q + j]; }
                    *(LAS unsigned*)(XC + (8 * pg + q) * 144 + c2 * 4) = cvt_pk_bf16(y0, y1); }
            }
            if (it == 2 || it == 20) asm volatile("s_waitcnt vmcnt(0)" ::: "memory");
            __syncthreads();
            u32x4 po[2], pg2[2];
            if (second) {
#pragma unroll
                for (int r = 0; r < 2; ++r) { const int q = lt + 256 * r, rr = q >> 3, pc = q & 7; const size_t off = (size_t)lru_row(b, isctx, p0 + rr) * D + n * 64 + pc * 8;
                    po[r] = *(const GAS u32x4*)(HOTH + off); pg2[r] = *(const GAS u32x4*)(GGp + off); }
            }
            f32x16 accr, acci;
#pragma unroll
            for (int q = 0; q < 16; ++q) { accr[q] = 0.f; acci[q] = 0.f; }
#pragma unroll
            for (int s = 0; s < 4; ++s) {
                const bf16x8 a = *(const LAS bf16x8*)(XC + qrow * 144 + (16 * s + 8 * half) * 2);
                accr = __builtin_amdgcn_mfma_f32_32x32x16_bf16(a, bfa[s], accr, 0, 0, 0);
                acci = __builtin_amdgcn_mfma_f32_32x32x16_bf16(a, bfx[s], acci, 0, 0, 0);
            }
            float av[16], bv[16]; float P = 1.f, H = 0.f;
#pragma unroll
            for (int i = 0; i < 16; ++i) { const int s = 16 * seg + i, q = dir ? 63 - s : s;
                const float r = __builtin_amdgcn_rcpf(1.0f + __builtin_amdgcn_exp2f(fmaf(accr[i], -1.4426950409f, nba))), ig = __builtin_amdgcn_rcpf(1.0f + __builtin_amdgcn_exp2f(fmaf(acci[i], -1.4426950409f, nbx)));
                const float xc = bf2f(*(const LAS unsigned short*)(XC + q * 144 + ch * 2));
                const float a = __builtin_amdgcn_exp2f(coef2 * r);
                const float em = fmaxf(fmaf(-a, a, 1.0f), 0.0f);
                const float bb = __builtin_amdgcn_sqrtf(em) * (ig * xc);
                av[i] = a; bv[i] = bb; P *= a; H = a * H + bb; }
            SEG[(seg * 64 + ch) * 2] = P; SEG[(seg * 64 + ch) * 2 + 1] = H;
            if (second) {
#pragma unroll
                for (int r = 0; r < 2; ++r) { const int q = lt + 256 * r, rr = q >> 3, pc = q & 7; *(LAS u32x4*)(OT + rr * 144 + pc * 16) = po[r]; *(LAS u32x4*)(G2 + rr * 144 + pc * 16) = pg2[r]; }
            }
            __syncthreads();
            float carry = hrun, mine = 0.f;
#pragma unroll
            for (int s2 = 0; s2 < 4; ++s2) { if (s2 == seg) mine = carry; carry = SEG[(s2 * 64 + ch) * 2] * carry + SEG[(s2 * 64 + ch) * 2 + 1]; }
            hrun = carry;
            float h = mine;
#pragma unroll
            for (int i = 0; i < 16; ++i) { const int s = 16 * seg + i, q = dir ? 63 - s : s; h = av[i] * h + bv[i];
                const float val = second ? bf2f(*(const LAS unsigned short*)(G2 + q * 144 + ch * 2)) * (h + bf2f(*(const LAS unsigned short*)(OT + q * 144 + ch * 2))) : h;
                *(LAS unsigned short*)(OUTT + q * 144 + ch * 2) = f2bf(val); }
        }
        __syncthreads();
        lru_flush(35);
        __syncthreads();
    }
}

__global__ void __launch_bounds__(512, 2) fwd_kernel(Args args) {
    extern __shared__ __attribute__((aligned(16))) unsigned char lds_raw[];
    Ctx C0; C0.out = args.out; C0.ws = args.ws; C0.lds = (LAS unsigned char*)lds_raw;
    C0.tid = threadIdx.x; C0.lane = C0.tid & 63; C0.wave = __builtin_amdgcn_readfirstlane(C0.tid >> 6); C0.G = gridDim.x;
    for (int u = C0.tid; u < (LDS_BYTES - LDS_CTL) / 4; u += 512) ((LAS unsigned*)(C0.lds + LDS_CTL))[u] = 0u;
    __syncthreads();
    if (C0.tid < 36) { const unsigned long long pv = (unsigned long long)args.in[C0.tid]; LAS unsigned* t = (LAS unsigned*)(C0.lds + LC_PTRS) + 2 * C0.tid; t[0] = (unsigned)pv; t[1] = (unsigned)(pv >> 32); }
    __syncthreads();
    const Ctx& C = C0;
    XcdBarrier bar = xcd_barrier_post(C.p<unsigned>(WS_CTL) + CW_BAR, (volatile LAS unsigned*)(C.lds + LC_MISC) + 8);
    const int lo = args.ph_lo, hi = args.ph_hi;
    int ph = 0;
#ifndef PHMASK
#define PHMASK 0xffffffffu
#endif
#define PH_ON(id) (((PHMASK) >> (id)) & 1u)
#define PHASE_BEGIN(id) if (PH_ON(id) && lo <= ph && ph < hi) { Ctx C = C0; const int _pid = id; (void)_pid; unsigned _z = 0u; asm volatile("" : "+s"(C.ws), "+s"(C.out), "+s"(C.lds), "+v"(_z)); C.lane = (int)__builtin_amdgcn_mbcnt_hi(~0u, __builtin_amdgcn_mbcnt_lo(~0u, _z)); C.tid = C.wave * 64 + C.lane;
#ifdef PROBE_MASK
#define PROBE_TICK() do { const unsigned long long _t = __builtin_amdgcn_s_memrealtime(); if (((PROBE_MASK) >> _pid) & 1u) pr_acc += _t - pr_prev; pr_prev = _t; } while (0)
#else
#define PROBE_TICK() do { } while (0)
#endif
#define PHASE_END(last) if (ph + 1 < hi && !(last)) xcd_barrier(bar); PROBE_TICK(); } ++ph;
#define PHASE_JOIN __syncthreads(); }
    const int cid = (int)blockIdx.x;
#ifdef PROBE_MASK
    unsigned long long pr_acc = 0ull, pr_prev = __builtin_amdgcn_s_memrealtime();
#endif

    PHASE_BEGIN(0)
        phase_s5prep(C);
        phase_ada(C);
        __syncthreads();
        phase_transposes(C);
    PHASE_END(false)

#pragma unroll 1
    for (int l = 0; l < DEPTH; ++l) {
        const int nMtok = (l == DEPTH - 1) ? 128 : 144;
        const int ntok = nMtok * 256;
        PHASE_BEGIN(1) phase_norm1(C, l); PHASE_END(false)
        PHASE_BEGIN(2)
            pg8::Gemm g{D, D, D, C.p<bf16_t>(WS_HN), (C.p<bf16_t>(WS_WINT) + (size_t)l * INW * D)}; SchedGrid S; S.rowtab4 = nullptr; S.so.init(144, 18, C.G, cid);  S.atile = (unsigned)256 * D * 2; S.btile = (unsigned)256 * D * 2;
            EpiInProj E{C.p<bf16_t>(WS_A3), C.p<bf16_t>(WS_XR), C.p<bf16_t>(WS_GG), C.p<bf16_t>(WS_M5), C.p<bf16_t>(WS_ML)};
            pg8::gemm_phase(C.lds, C.tid, g, S, E);
        PHASE_END(false)
        PHASE_BEGIN(3)
            pg8::Gemm g{16384, 256, 256, C.p<bf16_t>(WS_A3), (C.p<bf16_t>(WS_FT) + (size_t)l * 32 * 256 * 256)}; SchedS5 S{nullptr, C.G, cid, (unsigned)(256 * 256 * 2)};
            EpiS5L1 E{C.p<float>(WS_SB)};
            pg8::gemm_phase(C.lds, C.tid, g, S, E);
        PHASE_JOIN
        PHASE_BEGIN(15) phase_lru(C, l); PHASE_END(false)
        PHASE_BEGIN(4) phase_s5carry_ol(C, l); PHASE_END(false)
        PHASE_BEGIN(5)
            { pg8::Gemm g{16384, 512, 512, C.p<bf16_t>(WS_A3), (C.p<bf16_t>(WS_W3T) + (size_t)l * 32 * 256 * 512)}; SchedS5 S{nullptr, C.G, cid, (unsigned)(256 * 512 * 2)};
              EpiS5Y E{C.p<bf16_t>(WS_GY)};
              pg8::gemm_phase(C.lds, C.tid, g, S, E); }
            __syncthreads();
            { pg8::Gemm g{D, D, D, C.p<bf16_t>(WS_OL), (C.p<bf16_t>(WS_WPLT) + (size_t)l * D * D)}; SchedGrid S; S.rowtab4 = nullptr; S.so.init(nMtok, 4, C.G, C.G - 1 - cid);  S.atile = (unsigned)256 * D * 2; S.btile = (unsigned)256 * D * 2;
              EpiMulGate E{C.p<bf16_t>(WS_ML), nullptr, C.p<bf16_t>(WS_T1)};
              pg8::gemm_phase(C.lds, C.tid, g, S, E); }
        PHASE_END(false)
        PHASE_BEGIN(6)
            pg8::Gemm g{512, 512, 512, C.p<bf16_t>(WS_GY), (C.p<bf16_t>(WS_WGLUT) + (size_t)l * 512 * 512)}; SchedGrid S; S.rowtab4 = nullptr; S.so.init(nMtok, 2, C.G, cid);  S.atile = (unsigned)256 * 512 * 2; S.btile = (unsigned)256 * 512 * 2;
            EpiGlu E{C.p<bf16_t>(WS_GY), C.p<bf16_t>(WS_O5), C.in(18) + (size_t)l * 512};
            pg8::gemm_phase(C.lds, C.tid, g, S, E);
        PHASE_END(false)
        PHASE_BEGIN(7)
            pg8::Gemm g{512, 512, 512, C.p<bf16_t>(WS_O5), (C.p<bf16_t>(WS_WP5T) + (size_t)l * D * 512)}; SchedGrid S; S.rowtab4 = nullptr; S.so.init(nMtok, 4, C.G, cid);  S.atile = (unsigned)256 * 512 * 2; S.btile = (unsigned)256 * 512 * 2;
            EpiMulGate E{C.p<bf16_t>(WS_M5), C.p<bf16_t>(WS_T1), C.p<bf16_t>(WS_MG)};
            pg8::gemm_phase(C.lds, C.tid, g, S, E);
        PHASE_END(false)
        PHASE_BEGIN(9)
            pg8::Gemm g{D, D, D, C.p<bf16_t>(WS_MG), (C.p<bf16_t>(WS_WOUTT) + (size_t)l * D * D)}; SchedGrid S; S.rowtab4 = nullptr; S.so.init(nMtok, 4, C.G, cid);  S.atile = (unsigned)256 * D * 2; S.btile = (unsigned)256 * D * 2;
            EpiOut E{C.in(0), C.in(2), C.p<bf16_t>(WS_X), C.p<float>(WS_ADA), l};
            pg8::gemm_phase(C.lds, C.tid, g, S, E);
        PHASE_END(false)
        PHASE_BEGIN(10) phase_norm2(C, l, ntok); PHASE_END(false)
        PHASE_BEGIN(11) phase_slots(C, l, ntok); PHASE_END(false)
        PHASE_BEGIN(12)
            const int tt = moe_offsets(C, l, true);
            pg8::Gemm g{D / 2, D / 2, D / 2, C.p<unsigned char>(WS_HN), (C.p<unsigned char>(WS_WUPT) + (size_t)l * NEXP * 2048 * D)}; SchedMoe<true, true> S; S.rowtab4 = (const __attribute__((address_space(1))) i32x4*)(C.ws + WS_XS + (1u << 20)); S.rowmax = 0; S.so.init(tt, 8, C.G, cid);
            S.atile = (unsigned)256 * D; S.btile = (unsigned)256 * D; S.bexp = (unsigned)2048 * D;   S.tile_e = (const LAS unsigned char*)(C.lds + LC_TILE);
            EpiUp E{C.p<bf16_t>(WS_ACT), C.in(32) + (size_t)l * NEXP * 2048};
            pg8::gemm_phase(C.lds, C.tid, g, S, E);
        PHASE_END(false)
        PHASE_BEGIN(13)
            const int tt = moe_offsets(C, l, true);
            pg8::Gemm g{D / 2, D / 2, D / 2, C.p<unsigned char>(WS_ACT), (C.p<unsigned char>(WS_WDNT) + (size_t)l * NEXP * D * D)}; SchedMoe<false, true> S; S.rowtab4 = nullptr; S.rowmax = 0; S.so.init(tt, 4, C.G, cid);
            S.atile = (unsigned)256 * D; S.btile = (unsigned)256 * D; S.bexp = (unsigned)D * D; S.tile_e = (const LAS unsigned char*)(C.lds + LC_TILE);
            EpiDown E{C.p<bf16_t>(WS_Y), C.in(34) + (size_t)l * NEXP * D, C.p<int>(WS_XS)};
            pg8::gemm_phase(C.lds, C.tid, g, S, E);
        PHASE_END(false)
    }
    PHASE_BEGIN(14) phase_final(C); PHASE_END(true)
#ifdef PROBE_MASK
    if (blockIdx.x == 0) { const unsigned long long t0 = __builtin_amdgcn_s_memrealtime(); while (__builtin_amdgcn_s_memrealtime() - t0 < pr_acc * (PROBE_AMP)) __builtin_amdgcn_s_sleep(8); }
#endif
}

constexpr int N_PHASES = 1 + DEPTH * 12 + 1;
extern "C" void kernel_launch(void* const* d_in, const int* in_sizes, int n_in, void* d_out, int out_size, void* d_ws, size_t ws_size, hipStream_t stream) {
    static int grid = 0;
    if (grid == 0) {
        if (n_in != 36 || ws_size < WS_END) { fprintf(stderr, "kernel_launch: need 36 inputs and >= %zu bytes of workspace; got %d, %zu\n", (size_t)WS_END, n_in, ws_size); grid = -1; return; }
        int dev = 0, cus = 0, per_cu = 0;
        if (hipGetDevice(&dev) != hipSuccess || hipDeviceGetAttribute(&cus, hipDeviceAttributeMultiprocessorCount, dev) != hipSuccess) { grid = -1; return; }
        if (hipFuncSetAttribute((const void*)fwd_kernel, hipFuncAttributeMaxDynamicSharedMemorySize, LDS_BYTES) != hipSuccess) { fprintf(stderr, "kernel_launch: hipFuncSetAttribute failed\n"); grid = -1; return; }
        if (hipOccupancyMaxActiveBlocksPerMultiprocessor(&per_cu, (const void*)fwd_kernel, 512, LDS_BYTES) != hipSuccess || per_cu < 1) fprintf(stderr, "kernel_launch: occupancy query says %d\n", per_cu);
        (void)hipGetLastError();
        grid = cus;
    }
    if (grid < 0) return;
    (void)hipMemsetAsync((char*)d_ws + WS_CTL, 0, CTL_ZERO_BYTES, stream);
    Args a{};
    for (int i = 0; i < 36; ++i) a.in[i] = (const float*)d_in[i];
    a.out = (float*)d_out; a.ws = (unsigned char*)d_ws;
#ifndef MK_SPLIT
    a.ph_lo = 0; a.ph_hi = N_PHASES;
    hipLaunchKernelGGL(fwd_kernel, dim3(grid), dim3(512), LDS_BYTES, stream, a);
#else
    for (int p = 0; p < N_PHASES; ++p) { a.ph_lo = p; a.ph_hi = p + 1; hipLaunchKernelGGL(fwd_kernel, dim3(grid), dim3(512), LDS_BYTES, stream, a); }
#endif
}
```

```cpp
#include <hip/hip_runtime.h>
#include <cstdio>
#include <cstdint>

#define LAS __attribute__((address_space(3)))
typedef unsigned short bf16_t;
typedef short bf16x8 __attribute__((ext_vector_type(8)));
typedef float f32x4 __attribute__((ext_vector_type(4)));
typedef float f32x2 __attribute__((ext_vector_type(2)));
typedef float f32x16 __attribute__((ext_vector_type(16)));
typedef unsigned u32x4 __attribute__((ext_vector_type(4)));
typedef unsigned u32x2 __attribute__((ext_vector_type(2)));
typedef int i32x4 __attribute__((ext_vector_type(4)));
typedef int i32x8 __attribute__((ext_vector_type(8)));

constexpr int D = 1024, NB = 16, SEQ = 2048, CTXL = 256, DEPTH = 4;
constexpr int NLAT = NB * SEQ, NCTX = NB * CTXL, NTOK = NLAT + NCTX;
constexpr int INW = 4608, NEXP = 32;
constexpr int NCH = 144;
constexpr int NROW3 = NB * NCH;
constexpr int MAXSLOT = NTOK * 4 + NEXP * 256;

__device__ __forceinline__ float bf2f(unsigned short b) { return __uint_as_float(((unsigned)b) << 16); }
__device__ __forceinline__ float bflo(unsigned w) { return __uint_as_float(w << 16); }
__device__ __forceinline__ float bfhi(unsigned w) { return __uint_as_float(w & 0xffff0000u); }
typedef __bf16 bf16x2_n __attribute__((ext_vector_type(2)));
__device__ __forceinline__ unsigned cvt_pk_bf16(float lo, float hi) { f32x2 v = {lo, hi}; bf16x2_n b = __builtin_convertvector(v, bf16x2_n); return __builtin_bit_cast(unsigned, b); }
__device__ __forceinline__ unsigned short f2bf(float f) { return (unsigned short)(cvt_pk_bf16(f, 0.f) & 0xffffu); }
__device__ __forceinline__ float sigmoidf_(float x) { return __builtin_amdgcn_rcpf(1.0f + __expf(-x)); }
__device__ __forceinline__ float gelu_tanh(float x) { const float z = 1.5957691216f * (x + 0.044715f * x * x * x); return x * __builtin_amdgcn_rcpf(1.0f + __expf(-z)); }
__device__ __forceinline__ float wave_sum(float v, int lane) {
#pragma unroll
    for (int o = 1; o < 64; o <<= 1) v += __builtin_bit_cast(float, __builtin_amdgcn_ds_bpermute((lane ^ o) << 2, __builtin_bit_cast(int, v)));
    return v;
}

namespace pg8 {
constexpr int BM = 256, BK = 64, HALF = 128, HTB = HALF * BK * 2, STAGE_BYTES = 8 * HTB, NXCD = 8, WGM = 8;
__host__ __device__ __forceinline__ int lds_byte(int r, int c) { const int st = (r >> 4) * 2 + (c >> 5), rr = r & 15, cc = c & 31, ob = rr * 64 + cc * 2; return st * 1024 + (ob ^ (((ob >> 9) & 1) << 5)); }
__host__ __device__ __forceinline__ void stage_rc(int b, int& R, int& C) { const int st = b / 1024, sb = b % 1024, swz = sb ^ (((sb >> 9) & 1) << 5); R = (st >> 1) * 16 + swz / 64; C = (st & 1) * 32 + (swz % 64) / 2; }
__host__ __device__ __forceinline__ int perm32(int rho) { const int n = rho >> 4, i = rho & 15; return 8 * (i >> 2) + 4 * n + (i & 3); }

constexpr int ACT8_SHIFT = 2, W8_SHIFT = 6;
struct Unit { int pm, pn, grp, hu, hoff; unsigned a, b; };
struct Gemm { int lda, ldb, K; const void* A; const void* B; };

constexpr bool TAIL_SPLIT = false;
__device__ __forceinline__ bool tail_map(long L, int nwg, int G, int& fidx, int& hu, int& hs) {
    const int r = nwg % G, F = nwg - r; hu = 0; hs = 0;
    if (!TAIL_SPLIT || r == 0 || 2 * r > G || L < F) { if (L >= nwg) return false; fidx = (int)L; return true; }
    const long h = L - F; if (h >= 2 * r) return false; fidx = F + (int)(h >> 1); hu = 1; hs = (int)(h & 1); return true;
}
struct StaticOrder {
    int nM, nN, nwg, G, c;
    __device__ void init(int nM_, int nN_, int G_, int c_) { nM = nM_; nN = nN_; nwg = nM * nN; G = G_; c = c_; }
    __device__ bool next(int i, int& pm, int& pn, int& hu, int& hs) const {
        int wgid; if (!tail_map((long)i * G + c, nwg, G, wgid, hu, hs)) return false;
        { const int q = nwg / NXCD, r = nwg % NXCD, xcd = wgid % NXCD, off = wgid / NXCD; wgid = (xcd < r ? xcd * (q + 1) : r * (q + 1) + (xcd - r) * q) + off; }
        const int nig = WGM * nN, gid = wgid / nig, fm = gid * WGM, gsz = (nM - fm) < WGM ? (nM - fm) : WGM;
        pm = fm + ((wgid % nig) % gsz); pn = (wgid % nig) / gsz; return true;
    }
};

template <class Epi, class Sched>
__device__ __forceinline__ void gemm_phase(LAS unsigned char* lds, const int tid, const Gemm g, const Sched& S, const Epi& E) {
    const int wid = __builtin_amdgcn_readfirstlane(tid >> 6), lane = tid & 63, wr = wid >> 2, wc = wid & 3, fr = lane & 15, fq = lane >> 4;
    const int K = g.K, nt = K / BK;
    unsigned voffA[2], voffB[2];
#pragma unroll
    for (int i = 0; i < 2; ++i) { int R, C; stage_rc(tid * 16 + i * 8192, R, C); const int Rb = Epi::PERM ? ((R & ~31) + perm32(R & 31)) : R;
        voffA[i] = (unsigned)(R * g.lda + C) * 2u; voffB[i] = (unsigned)(Rb * g.ldb + C) * 2u; }
    constexpr bool GA = Sched::GATHER, F8 = Sched::F8;
    const unsigned long long _pa = (unsigned long long)g.A, _pb = (unsigned long long)g.B;
    void* const uA = (void*)(((unsigned long long)(unsigned)__builtin_amdgcn_readfirstlane((int)(_pa >> 32)) << 32) | (unsigned)__builtin_amdgcn_readfirstlane((int)_pa));
    void* const uB = (void*)(((unsigned long long)(unsigned)__builtin_amdgcn_readfirstlane((int)(_pb >> 32)) << 32) | (unsigned)__builtin_amdgcn_readfirstlane((int)_pb));
    const __amdgpu_buffer_rsrc_t rsA = __builtin_amdgcn_make_buffer_rsrc(uA, 0, 0x7fffffff, 0x00020000), rsB = __builtin_amdgcn_make_buffer_rsrc(uB, 0, 0x7fffffff, 0x00020000);
    const unsigned kstep = (unsigned)(BK * 2);
    const unsigned hstepA = GA ? 0u : (unsigned)HALF * g.lda * 2, hstepB = (unsigned)HALF * g.ldb * 2;
    unsigned vA[2][2], vN[2][2];
#define PG8_ROWS(u, v) do { if constexpr (GA) { unsigned _z = 0u; asm volatile("" : "+v"(_z)); const int _tid = wid * 64 + (int)__builtin_amdgcn_mbcnt_hi(~0u, __builtin_amdgcn_mbcnt_lo(~0u, _z)); const i32x4 _t = S.rowtab4[(u).pm * 512 + _tid]; const bool _hh = (u).hoff != 0;     \
        v[0][0] = (unsigned)(_hh ? _t.z : _t.x); v[0][1] = (unsigned)(_hh ? _t.w : _t.y); v[1][0] = (unsigned)_t.z; v[1][1] = (unsigned)_t.w; } \
        else { _Pragma("unroll") for (int _h = 0; _h < 2; ++_h) { v[_h][0] = voffA[0]; v[_h][1] = voffA[1]; } } } while (0)
#define PG8_SEL(h, usenext) unsigned vs[2] = { (usenext) ? vN[h][0] : vA[h][0], (usenext) ? vN[h][1] : vA[h][1] }
    const unsigned ldsw = (unsigned)wid * 1024u;
    const int aoff = lds_byte(wr * 64 + fr, fq * 8), boff = lds_byte(wc * 32 + fr, fq * 8);
#define PG8_SA(b, h) (((b) * 2 + (h)) * HTB)
#define PG8_SB(b, h) ((4 + (b) * 2 + (h)) * HTB)
#define PG8_STAGEX(rs, bufoff, soff, voff) do { _Pragma("unroll") for (int _i = 0; _i < 2; ++_i) \
        __builtin_amdgcn_raw_ptr_buffer_load_lds(rs, (LAS void*)(lds + (bufoff) + ldsw + _i * 8192), 16, (int)(voff)[_i], (int)(soff), 0, 0); } while (0)
#define PG8_STAGEA(bufoff, soff, voff) PG8_STAGEX(rsA, bufoff, soff, voff)
#define PG8_STAGEB(bufoff, soff, voff) PG8_STAGEX(rsB, bufoff, soff, voff)
#define PG8_LDA(dst, b, h) do { _Pragma("unroll") for (int m = 0; m < 4; ++m) _Pragma("unroll") for (int k = 0; k < 2; ++k) dst[m][k] = *(const LAS bf16x8*)(lds + PG8_SA(b, h) + aoff + m * 2048 + k * 1024); } while (0)
#define PG8_LDB(dst, b, h) do { _Pragma("unroll") for (int n = 0; n < 2; ++n) _Pragma("unroll") for (int k = 0; k < 2; ++k) dst[n][k] = *(const LAS bf16x8*)(lds + PG8_SB(b, h) + boff + n * 2048 + k * 1024); } while (0)
#define PG8_CAT(x) __builtin_shufflevector(__builtin_bit_cast(i32x4, (x)[0]), __builtin_bit_cast(i32x4, (x)[1]), 0, 1, 2, 3, 4, 5, 6, 7)
#define PG8_MMA(ai, bj, At, Bt) do { __builtin_amdgcn_s_setprio(1); if constexpr (F8) { _Pragma("unroll") for (int m = 0; m < 4; ++m) _Pragma("unroll") for (int n = 0; n < 2; ++n) \
        acc[ai][bj][m][n] = __builtin_amdgcn_mfma_scale_f32_16x16x128_f8f6f4(PG8_CAT(Bt[n]), PG8_CAT(At[m]), acc[ai][bj][m][n], 0, 0, 0, Sched::SCALE_B, 0, Sched::SCALE_A); } else { \
        _Pragma("unroll") for (int m = 0; m < 4; ++m) _Pragma("unroll") for (int n = 0; n < 2; ++n) _Pragma("unroll") for (int k = 0; k < 2; ++k) \
        acc[ai][bj][m][n] = __builtin_amdgcn_mfma_f32_16x16x32_bf16(Bt[n][k], At[m][k], acc[ai][bj][m][n], 0, 0, 0); } __builtin_amdgcn_s_setprio(0); } while (0)
#define PG8_WAIT_V(n) asm volatile("s_waitcnt vmcnt(" #n ")" ::: "memory")
#define PG8_WAIT_L(n) asm volatile("s_waitcnt lgkmcnt(" #n ")" ::: "memory")
#define PG8_BAR __builtin_amdgcn_s_barrier()
#define PG8_SCHED __builtin_amdgcn_sched_barrier(0)
    Unit cur, nxt; int ui = 0;
    if (!S.next(0, cur)) return;
    f32x4 acc[2][2][4][2];
#pragma unroll
    for (int a = 0; a < 2; ++a)
#pragma unroll
        for (int b = 0; b < 2; ++b)
#pragma unroll
            for (int m = 0; m < 4; ++m)
#pragma unroll
                for (int n = 0; n < 2; ++n) acc[a][b][m][n] = (f32x4){0.f, 0.f, 0.f, 0.f};
    bf16x8 At[4][2], B0[2][2], B1[2][2];
    unsigned cA = cur.a, cB = cur.b;
    PG8_ROWS(cur, vA);
    PG8_STAGEB(PG8_SB(0, 0), cB, voffB); PG8_STAGEB(PG8_SB(0, 1), cB + hstepB, voffB); PG8_STAGEA(PG8_SA(0, 0), cA, vA[0]); PG8_STAGEA(PG8_SA(0, 1), cA + hstepA, vA[1]);
    if (wr == 1) PG8_BAR;
    PG8_WAIT_V(2); PG8_BAR;
    PG8_STAGEB(PG8_SB(1, 0), cB + kstep, voffB); PG8_STAGEA(PG8_SA(1, 0), cA + kstep, vA[0]); PG8_STAGEB(PG8_SB(1, 1), cB + hstepB + kstep, voffB);
    PG8_WAIT_V(6); PG8_BAR;
    for (;;) {
        const bool has_next = S.next(ui + 1, nxt);
        const unsigned nA = has_next ? nxt.a : cA, nB = has_next ? nxt.b : cB;
        if (GA) { if (has_next) PG8_ROWS(nxt, vN); else { _Pragma("unroll") for (int _h = 0; _h < 2; ++_h) { vN[_h][0] = vA[_h][0]; vN[_h][1] = vA[_h][1]; } } }
#pragma unroll 1
        for (int t = 0; t < nt; t += 2) {
            const bool last = (t == nt - 2);
            const unsigned a1 = cA + (unsigned)(t + 1) * kstep;
            const unsigned a2 = last ? nA : cA + (unsigned)(t + 2) * kstep, b2 = last ? nB : cB + (unsigned)(t + 2) * kstep;
            const unsigned a3 = a2 + kstep, b3 = b2 + kstep;
            const bool un = GA && last, hu = cur.hu != 0;
            PG8_LDB(B0, 0, 0); PG8_LDB(B1, 0, 1); PG8_SCHED; PG8_LDA(At, 0, 0); PG8_STAGEA(PG8_SA(1, 1), a1 + hstepA, vA[1]);
            PG8_WAIT_V(8); PG8_WAIT_L(0); PG8_BAR; PG8_MMA(0, 0, At, B0); PG8_MMA(0, 1, At, B1); PG8_BAR; PG8_SCHED;
            { PG8_SEL(0, un); if (!hu) PG8_LDA(At, 0, 1); PG8_STAGEB(PG8_SB(0, 0), b2, voffB); PG8_STAGEB(PG8_SB(0, 1), b2 + hstepB, voffB); PG8_STAGEA(PG8_SA(0, 0), a2, vs); }
            PG8_WAIT_V(8); PG8_WAIT_L(0); PG8_BAR; if (!hu) { PG8_MMA(1, 0, At, B0); PG8_MMA(1, 1, At, B1); } PG8_BAR; PG8_SCHED;
            { PG8_SEL(1, un); PG8_LDB(B0, 1, 0); PG8_LDB(B1, 1, 1); PG8_SCHED; PG8_LDA(At, 1, 0); PG8_STAGEA(PG8_SA(0, 1), a2 + hstepA, vs); }
            PG8_WAIT_V(8); PG8_WAIT_L(0); PG8_BAR; PG8_MMA(0, 0, At, B0); PG8_MMA(0, 1, At, B1); PG8_BAR; PG8_SCHED;
            { PG8_SEL(0, un); if (!hu) PG8_LDA(At, 1, 1); PG8_STAGEB(PG8_SB(1, 0), b3, voffB); PG8_STAGEB(PG8_SB(1, 1), b3 + hstepB, voffB); PG8_STAGEA(PG8_SA(1, 0), a3, vs); }
            PG8_WAIT_V(8); PG8_WAIT_L(0); PG8_BAR; if (!hu) { PG8_MMA(1, 0, At, B0); PG8_MMA(1, 1, At, B1); } PG8_BAR; PG8_SCHED;
        }
        if (wr == 0) PG8_BAR;
        { unsigned z_ = 0u; asm volatile("" : "+v"(z_)); const int ln_ = (int)__builtin_amdgcn_mbcnt_hi(~0u, __builtin_amdgcn_mbcnt_lo(~0u, z_));
          E(acc, cur, wr, wc, ln_ & 15, ln_ >> 4); }
        if (!has_next) break;
#pragma unroll
        for (int a = 0; a < 2; ++a)
#pragma unroll
            for (int b = 0; b < 2; ++b)
#pragma unroll
                for (int m = 0; m < 4; ++m)
#pragma unroll
                    for (int n = 0; n < 2; ++n) acc[a][b][m][n] = (f32x4){0.f, 0.f, 0.f, 0.f};
        cur = nxt; cA = nA; cB = nB; ++ui;
        if (GA) {
#pragma unroll
            for (int _h = 0; _h < 2; ++_h) { vA[_h][0] = vN[_h][0]; vA[_h][1] = vN[_h][1]; } }
        if (wr == 1) PG8_BAR;
    }
    PG8_WAIT_V(0);
    PG8_BAR;
#undef PG8_SA
#undef PG8_CAT
#undef PG8_ROWS
#undef PG8_SEL
#undef PG8_SB
#undef PG8_STAGEX
#undef PG8_STAGEA
#undef PG8_STAGEB
#undef PG8_LDA
#undef PG8_LDB
#undef PG8_MMA
#undef PG8_WAIT_V
#undef PG8_WAIT_L
#undef PG8_BAR
#undef PG8_SCHED
}
}
using pg8::Unit;

#define XB_TMO      128
#define XB_XCNT(j)  (256  + 64 * (j))
#define XB_XSUB(j)  (1280 + 64 * (j))
#define XB_XGEN(j)  (2304 + 64 * (j))
#define XB_TOP      3328
#define XB_TOPGEN   3392
#define XCD_BAR_WORDS 3456
#define XB_SPIN_CAP (1u << 18)
__device__ __forceinline__ unsigned xb_ld(unsigned* p)              { return __hip_atomic_load(p, __ATOMIC_RELAXED, __HIP_MEMORY_SCOPE_AGENT); }
__device__ __forceinline__ unsigned xb_add(unsigned* p, unsigned v) { return __hip_atomic_fetch_add(p, v, __ATOMIC_RELAXED, __HIP_MEMORY_SCOPE_AGENT); }
__device__ __forceinline__ unsigned xb_xcc_id() { return (unsigned)__builtin_amdgcn_s_getreg((3 << 11) | 20) & 0xFu; }
#define XB_SPIN(cond, bar) do { unsigned _sp = 0; while (cond) { __builtin_amdgcn_s_sleep(1); \
    if ((++_sp & 255u) == 0u) { if (xb_ld(&(bar)[XB_TMO])) break; if (_sp > XB_SPIN_CAP) { atomicAdd(&(bar)[XB_TMO], 1u); break; } } } } while (0)
struct XcdBarrier { unsigned* bar; unsigned x; volatile LAS unsigned* st; };
__device__ __forceinline__ XcdBarrier xcd_barrier_post(unsigned* bar, volatile LAS unsigned* st) {
    XcdBarrier b; b.bar = bar; b.x = xb_xcc_id(); b.st = st;
    if (threadIdx.x == 0) (void)xb_add(&bar[XB_XCNT(b.x)], 1u);
    return b;
}
__device__ __forceinline__ void xcd_barrier_complete(unsigned* bar, unsigned x, unsigned& nloc, unsigned& nx) {
    const unsigned G = gridDim.x * gridDim.y * gridDim.z;
    unsigned sum, cnt, mine, sp = 0u;
    for (;;) {
        sum = 0u; cnt = 0u; mine = 0u;
#pragma unroll
        for (unsigned j = 0; j < 16; ++j) { const unsigned c = xb_ld(&bar[XB_XCNT(j)]); sum += c; cnt += (c > 0u) ? 1u : 0u; mine = (j == x) ? c : mine; }
        if (sum == G) break;
        __builtin_amdgcn_s_sleep(1);
        if ((++sp & 255u) == 0u) { if (xb_ld(&bar[XB_TMO])) break; if (sp > XB_SPIN_CAP) { atomicAdd(&bar[XB_TMO], 1u); break; } }
    }
    nloc = mine > 0u ? mine : 1u; nx = cnt > 0u ? cnt : 1u;
}
__device__ __forceinline__ void xcd_barrier(const XcdBarrier& b) {
    asm volatile("s_waitcnt vmcnt(0)" ::: "memory");
    __syncthreads();
    if (threadIdx.x == 0) {
        unsigned* bar = b.bar;
        __builtin_amdgcn_s_waitcnt(0);
        unsigned nloc = b.st[0], nx = b.st[1];
        if (nloc == 0u) { xcd_barrier_complete(bar, b.x, nloc, nx); b.st[0] = nloc; b.st[1] = nx; }
        const unsigned old = xb_add(&bar[XB_XSUB(b.x)], 1u);
        const unsigned gen = old / nloc;
        if (old + 1u == (gen + 1u) * nloc) {
            __builtin_amdgcn_fence(__ATOMIC_RELEASE, "agent");
            asm volatile("s_waitcnt vmcnt(0)" ::: "memory");
            const unsigned og = xb_add(&bar[XB_TOP], 1u);
            const unsigned tg = og / nx;
            if (og + 1u == (tg + 1u) * nx) xb_add(&bar[XB_TOPGEN], 1u);
            else XB_SPIN(xb_ld(&bar[XB_TOPGEN]) == tg, bar);
            __builtin_amdgcn_fence(__ATOMIC_ACQUIRE, "agent");
            xb_add(&bar[XB_XGEN(b.x)], 1u);
            asm volatile("s_waitcnt vmcnt(0)" ::: "memory");
        } else {
            XB_SPIN(xb_ld(&bar[XB_XGEN(b.x)]) == gen, bar);
            __builtin_amdgcn_fence(__ATOMIC_ACQUIRE, "agent");
            asm volatile("s_waitcnt vmcnt(0)" ::: "memory");
        }
    }
    __syncthreads();
}

constexpr size_t al256(size_t x) { return (x + 255) & ~(size_t)255; }
constexpr size_t WS_CTL = 0, CTL_ZERO_BYTES = 1u << 20;
constexpr int CW_QUEUE = 2048;
constexpr int CW_CNT = 1024;
constexpr int CW_BAR = 4096;
constexpr size_t WS_ADA   = CTL_ZERO_BYTES;
constexpr size_t WS_DEC   = al256(WS_ADA + (size_t)DEPTH * 17 * 6144 * 4);
constexpr size_t WS_W3T   = al256(WS_DEC + (size_t)DEPTH * 2 * 32 * 64 * 2 * 4);
constexpr size_t WS_FT    = al256(WS_W3T + (size_t)DEPTH * 32 * 256 * 512 * 2);
constexpr size_t WS_WINT  = al256(WS_FT + (size_t)DEPTH * 32 * 256 * 256 * 2);
constexpr size_t WS_WGLUT = al256(WS_WINT + (size_t)DEPTH * INW * D * 2);
constexpr size_t WS_WP5T  = al256(WS_WGLUT + (size_t)DEPTH * 512 * 512 * 2);
constexpr size_t WS_WPLT  = al256(WS_WP5T + (size_t)DEPTH * D * 512 * 2);
constexpr size_t WS_WOUTT = al256(WS_WPLT + (size_t)DEPTH * D * D * 2);
constexpr size_t WS_WUPT  = al256(WS_WOUTT + (size_t)DEPTH * D * D * 2);
constexpr size_t WS_WDNT  = al256(WS_WUPT + (size_t)DEPTH * NEXP * 2048 * D * 2);
constexpr size_t WS_X     = al256(WS_WDNT + (size_t)DEPTH * NEXP * D * D * 2);
constexpr size_t WS_HN    = al256(WS_X + (size_t)NTOK * D * 4);
constexpr size_t WS_A3    = al256(WS_HN + (size_t)NTOK * D * 2);
constexpr size_t WS_SB    = al256(WS_A3 + (size_t)NROW3 * 32 * 512 * 2);
constexpr size_t WS_XR    = al256(WS_SB + (size_t)NROW3 * 32 * 256 * 4);
constexpr size_t WS_GG    = al256(WS_XR + (size_t)NTOK * D * 2);
constexpr size_t WS_M5    = al256(WS_GG + (size_t)NTOK * D * 2);
constexpr size_t WS_ML    = al256(WS_M5 + (size_t)NTOK * D * 2);
constexpr size_t WS_HF    = al256(WS_ML + (size_t)NTOK * D * 2);
constexpr size_t WS_HB    = al256(WS_HF + (size_t)NTOK * D * 2);
constexpr size_t WS_OL    = al256(WS_HB + (size_t)NTOK * D * 2);
constexpr size_t WS_GY    = al256(WS_OL + (size_t)NTOK * D * 2);
constexpr size_t WS_O5    = al256(WS_GY + (size_t)NTOK * 512 * 2);
constexpr size_t WS_T1    = al256(WS_O5 + (size_t)NTOK * 512 * 2);
constexpr size_t WS_MG    = al256(WS_T1 + (size_t)NTOK * D * 2);
constexpr size_t WS_TOKE  = al256(WS_MG + (size_t)NTOK * D * 2);
constexpr size_t WS_TOKP  = al256(WS_TOKE + (size_t)NTOK * 4 * 4);
constexpr size_t WS_TOKW  = al256(WS_TOKP + (size_t)NTOK * 4 * 4);
constexpr size_t WS_SLOT  = al256(WS_TOKW + (size_t)NTOK * 4 * 4);
constexpr size_t WS_XS    = al256(WS_SLOT + (size_t)NTOK * 4 * 4);
constexpr size_t WS_ACT   = al256(WS_XS + (size_t)MAXSLOT * D * 2);
constexpr size_t WS_Y     = al256(WS_ACT + (size_t)MAXSLOT * D * 2);
constexpr size_t WS_END   = al256(WS_Y + (size_t)MAXSLOT * D * 2);

constexpr int LDS_BYTES = 147456;
constexpr int LDS_CTL = 143360;
constexpr int LC_MISC = LDS_CTL;
constexpr int LC_OFFS = LDS_CTL + 256;
constexpr int LC_LCNT = LDS_CTL + 512;
constexpr int LC_GB   = LDS_CTL + 768;
constexpr int LC_TILE = LDS_CTL + 1024;
constexpr int LC_PTRS = LDS_CTL + 2048;

struct Args { const float* in[36]; float* out; unsigned char* ws; int ph_lo, ph_hi; };

struct Ctx {
    float* out; unsigned char* ws; LAS unsigned char* lds; int tid, lane, wave, G;
    template <class T> __device__ __forceinline__ T* p(size_t off) const { return (T*)(ws + off); }
    __device__ __forceinline__ const float* in(int k) const { const LAS unsigned* t = (const LAS unsigned*)(lds + LC_PTRS) + 2 * k;
        const unsigned lo = __builtin_amdgcn_readfirstlane(t[0]), hi = __builtin_amdgcn_readfirstlane(t[1]); return (const float*)(((unsigned long long)hi << 32) | lo); }
};

struct SchedGrid {
    static constexpr bool GATHER = false, F8 = false; static constexpr int SCALE_A = 127 * 0x01010101, SCALE_B = 127 * 0x01010101, rowmax = 0; const __attribute__((address_space(1))) i32x4* rowtab4;
    pg8::StaticOrder so; unsigned atile, btile;
    __device__ __forceinline__ bool next(int i, Unit& u) const { int hs; if (!so.next(i, u.pm, u.pn, u.hu, hs)) return false; u.grp = 0; u.hoff = hs * 128; u.a = (unsigned)u.pm * atile + (unsigned)hs * (atile >> 1); u.b = (unsigned)u.pn * btile; return true; }
};
struct SchedS5 {
    static constexpr bool GATHER = false, F8 = false; static constexpr int SCALE_A = 127 * 0x01010101, SCALE_B = 127 * 0x01010101, rowmax = 0; const __attribute__((address_space(1))) i32x4* rowtab4; int G, c; unsigned bgrp;
    __device__ __forceinline__ bool next(int i, Unit& u) const { int L, hs; if (!pg8::tail_map((long)i * G + c, 288, G, L, u.hu, hs)) return false; const int g = L / 9, pm = L - g * 9; u.pm = pm; u.pn = 0; u.grp = g; u.hoff = hs * 128;
        u.a = ((unsigned)(pm * 256 + hs * 128) * 16384 + (unsigned)g * 512) * 2; u.b = (unsigned)g * bgrp; return true; }
};
template <bool GA, bool F8_>
struct SchedMoe {
    int rowmax; static constexpr bool GATHER = GA, F8 = F8_; static constexpr int SCALE_A = (127 - pg8::ACT8_SHIFT) * 0x01010101, SCALE_B = (127 - pg8::W8_SHIFT) * 0x01010101;
    const __attribute__((address_space(1))) i32x4* rowtab4; pg8::StaticOrder so; unsigned atile, btile, bexp; const LAS unsigned char* tile_e;
    __device__ __forceinline__ bool next(int i, Unit& u) const { int hs; if (!so.next(i, u.pm, u.pn, u.hu, hs)) return false; u.grp = __builtin_amdgcn_readfirstlane((int)tile_e[u.pm]);     u.hoff = hs * 128; u.a = GA ? 0u : (unsigned)u.pm * atile + (unsigned)hs * (atile >> 1); u.b = (unsigned)u.grp * bexp + (unsigned)u.pn * btile; return true; }
};

#define EPI_ROWS_BEGIN  _Pragma("unroll") for (int ai = 0; ai < 2; ++ai) _Pragma("unroll") for (int m = 0; m < 4; ++m) { if (ai == 1 && u.hu) continue; const int row = u.pm * 256 + u.hoff + ai * 128 + wr * 64 + m * 16 + fr;
#define EPI_ROWS_END    asm volatile("" ::: "memory"); }
__device__ __forceinline__ u32x4 pack8(const f32x4 a, const f32x4 b) { u32x4 w; w.x = cvt_pk_bf16(a[0], a[1]); w.y = cvt_pk_bf16(a[2], a[3]); w.z = cvt_pk_bf16(b[0], b[1]); w.w = cvt_pk_bf16(b[2], b[3]); return w; }
__device__ __forceinline__ void unpack8(const u32x4 w, f32x4& a, f32x4& b) { a = (f32x4){bflo(w.x), bfhi(w.x), bflo(w.y), bfhi(w.y)}; b = (f32x4){bflo(w.z), bfhi(w.z), bflo(w.w), bfhi(w.w)}; }

struct EpiInProj {
    static constexpr bool PERM = true;
    bf16_t *A3, *XR, *GG, *M5, *ML;
    __device__ __forceinline__ void operator()(const f32x4 (&acc)[2][2][4][2], const Unit& u, int wr, int wc, int fr, int fq) const {
        const int pn = u.pn;
        EPI_ROWS_BEGIN
#pragma unroll
            for (int bj = 0; bj < 2; ++bj) {
                const int col = pn * 256 + bj * 128 + wc * 32 + 8 * fq; f32x4 v0 = acc[ai][bj][m][0], v1 = acc[ai][bj][m][1];
                if (pn < 2) {
                    int b, cidx, j; if (row < NLAT) { b = row >> 11; const int t = row & 2047; cidx = 16 + (t >> 4); j = t & 15; } else { const int rr = row - NLAT; b = rr >> 8; const int tc = rr & 255; cidx = tc >> 4; j = tc & 15; }
                    const int g = col >> 4, h = col & 15;
                    *(u32x4*)(A3 + ((size_t)((b * NCH + cidx) * 32 + g)) * 512 + j * 16 + h) = pack8(v0, v1);
                } else if (pn < 6) {
                    *(u32x4*)(XR + (size_t)row * D + (col - 512)) = pack8(v0, v1);
                } else if (pn < 10) {
#pragma unroll
                    for (int q = 0; q < 4; ++q) { v0[q] = gelu_tanh(v0[q]); v1[q] = gelu_tanh(v1[q]); }
                    *(u32x4*)(GG + (size_t)row * D + (col - 1536)) = pack8(v0, v1);
                } else {
#pragma unroll
                    for (int q = 0; q < 4; ++q) { v0[q] = sigmoidf_(v0[q]); v1[q] = sigmoidf_(v1[q]); }
                    bf16_t* dst = pn < 14 ? M5 + (size_t)row * D + (col - 2560) : ML + (size_t)row * D + (col - 3584);
                    *(u32x4*)dst = pack8(v0, v1);
                }
            }
        EPI_ROWS_END
    }
};
struct EpiS5L1 {
    static constexpr bool PERM = false;
    float* S;
    __device__ __forceinline__ void operator()(const f32x4 (&acc)[2][2][4][2], const Unit& u, int wr, int wc, int fr, int fq) const {
        EPI_ROWS_BEGIN
            float* rowp = S + ((size_t)row * 32 + u.grp) * 256 + wc * 32 + 4 * fq;
#pragma unroll
            for (int bj = 0; bj < 2; ++bj)
#pragma unroll
                for (int n = 0; n < 2; ++n) *(f32x4*)(rowp + bj * 128 + n * 16) = acc[ai][bj][m][n];
        EPI_ROWS_END
    }
};
struct EpiS5Y {
    static constexpr bool PERM = true;
    bf16_t* GY;
    __device__ __forceinline__ void operator()(const f32x4 (&acc)[2][2][4][2], const Unit& u, int wr, int wc, int fr, int fq) const {
        EPI_ROWS_BEGIN
            const int b = row / NCH, cidx = row - b * NCH;
            const int tok0 = cidx < 16 ? NLAT + b * 256 + cidx * 16 : b * 2048 + (cidx - 16) * 16;
#pragma unroll
            for (int bj = 0; bj < 2; ++bj) {
                const int col = bj * 128 + wc * 32 + 8 * fq, j = col >> 4, h = col & 15; f32x4 v0 = acc[ai][bj][m][0], v1 = acc[ai][bj][m][1];
#pragma unroll
                for (int q = 0; q < 4; ++q) { v0[q] = gelu_tanh(v0[q]); v1[q] = gelu_tanh(v1[q]); }
                *(u32x4*)(GY + (size_t)(tok0 + j) * 512 + u.grp * 16 + h) = pack8(v0, v1);
            }
        EPI_ROWS_END
    }
};
#define GAS __attribute__((address_space(1)))
struct EpiGlu {
    static constexpr bool PERM = true;
    const bf16_t* GY; bf16_t* O5; const float* bias;
    __device__ __forceinline__ void operator()(const f32x4 (&acc)[2][2][4][2], const Unit& u, int wr, int wc, int fr, int fq) const {
        const int col0 = u.pn * 256 + wc * 32 + 8 * fq;
        f32x4 bb[2][2];
#pragma unroll
        for (int bj = 0; bj < 2; ++bj) { bb[bj][0] = *(const GAS f32x4*)(bias + col0 + bj * 128); bb[bj][1] = *(const GAS f32x4*)(bias + col0 + bj * 128 + 4); }
#pragma unroll
        for (int ai = 0; ai < 2; ++ai) {
            if (ai == 1 && u.hu) break;
            const size_t r0 = (size_t)(u.pm * 256 + u.hoff + ai * 128 + wr * 64 + fr) * 512 + col0;
            u32x4 gy[4][2];
#pragma unroll
            for (int m = 0; m < 4; ++m)
#pragma unroll
                for (int bj = 0; bj < 2; ++bj) gy[m][bj] = *(const GAS u32x4*)(GY + r0 + (size_t)m * 16 * 512 + bj * 128);
#pragma unroll
            for (int m = 0; m < 4; ++m)
#pragma unroll
                for (int bj = 0; bj < 2; ++bj) { f32x4 v0 = acc[ai][bj][m][0], v1 = acc[ai][bj][m][1], g0, g1; unpack8(gy[m][bj], g0, g1);
#pragma unroll
                    for (int q = 0; q < 4; ++q) { v0[q] = g0[q] * sigmoidf_(v0[q] + bb[bj][0][q]); v1[q] = g1[q] * sigmoidf_(v1[q] + bb[bj][1][q]); }
                    *(GAS u32x4*)(O5 + r0 + (size_t)m * 16 * 512 + bj * 128) = pack8(v0, v1); }
            asm volatile("" ::: "memory");
        }
    }
};
struct EpiMulGate {
    static constexpr bool PERM = true;
    const bf16_t* GATE; const bf16_t* ADD; bf16_t* O;
    __device__ __forceinline__ void operator()(const f32x4 (&acc)[2][2][4][2], const Unit& u, int wr, int wc, int fr, int fq) const {
#pragma unroll
        for (int ai = 0; ai < 2; ++ai) {
            if (ai == 1 && u.hu) break;
            const size_t r0 = (size_t)(u.pm * 256 + u.hoff + ai * 128 + wr * 64 + fr) * D + u.pn * 256 + wc * 32 + 8 * fq;
            u32x4 gt[4][2], ad[4][2];
#pragma unroll
            for (int m = 0; m < 4; ++m)
#pragma unroll
                for (int bj = 0; bj < 2; ++bj) { gt[m][bj] = *(const GAS u32x4*)(GATE + r0 + (size_t)m * 16 * D + bj * 128); if (ADD) ad[m][bj] = *(const GAS u32x4*)(ADD + r0 + (size_t)m * 16 * D + bj * 128); }
#pragma unroll
            for (int m = 0; m < 4; ++m)
#pragma unroll
                for (int bj = 0; bj < 2; ++bj) { f32x4 v0 = acc[ai][bj][m][0], v1 = acc[ai][bj][m][1], g0, g1; unpack8(gt[m][bj], g0, g1); v0 = v0 * g0; v1 = v1 * g1;
                    if (ADD) { f32x4 a0, a1; unpack8(ad[m][bj], a0, a1); v0 = v0 + a0; v1 = v1 + a1; }
                    *(GAS u32x4*)(O + r0 + (size_t)m * 16 * D + bj * 128) = pack8(v0, v1); }
            asm volatile("" ::: "memory");
        }
    }
};
struct EpiOut {
    static constexpr bool PERM = true;
    const float* xlat; const float* xctx; bf16_t* X; const float* ada; int l;
    __device__ __forceinline__ void operator()(const f32x4 (&acc)[2][2][4][2], const Unit& u, int wr, int wc, int fr, int fq) const {
        const int bsel = u.pm < 128 ? (u.pm >> 3) : 16;
        const float* gate = ada + ((size_t)(l * 17 + bsel) * 6 + 2) * D;
        const int col0 = u.pn * 256 + wc * 32 + 8 * fq;
        f32x4 gv[2][2];
#pragma unroll
        for (int bj = 0; bj < 2; ++bj)
#pragma unroll
            for (int n = 0; n < 2; ++n) gv[bj][n] = *(const GAS f32x4*)(gate + col0 + bj * 128 + n * 4);
        const float* srcb = u.pm < 128 ? xlat + (size_t)u.pm * 256 * D : xctx + (size_t)(u.pm - 128) * 256 * D;
        bf16_t* xb = X + (size_t)u.pm * 256 * D;
#pragma unroll
        for (int ai = 0; ai < 2; ++ai) {
            if (ai == 1 && u.hu) break;
            const size_t rr = (size_t)(u.hoff + ai * 128 + wr * 64 + fr) * D + col0;
            f32x4 xs[4][2][2];
            if (l == 0) {
#pragma unroll
                for (int m = 0; m < 4; ++m)
#pragma unroll
                    for (int bj = 0; bj < 2; ++bj)
#pragma unroll
                        for (int n = 0; n < 2; ++n) xs[m][bj][n] = *(const GAS f32x4*)(srcb + rr + (size_t)m * 16 * D + bj * 128 + n * 4);
            } else {
                u32x4 xr[4][2];
#pragma unroll
                for (int m = 0; m < 4; ++m)
#pragma unroll
                    for (int bj = 0; bj < 2; ++bj) xr[m][bj] = *(const GAS u32x4*)(xb + rr + (size_t)m * 16 * D + bj * 128);
#pragma unroll
                for (int m = 0; m < 4; ++m)
#pragma unroll
                    for (int bj = 0; bj < 2; ++bj) unpack8(xr[m][bj], xs[m][bj][0], xs[m][bj][1]);
            }
#pragma unroll
            for (int m = 0; m < 4; ++m)
#pragma unroll
                for (int bj = 0; bj < 2; ++bj)
                    *(GAS u32x4*)(xb + rr + (size_t)m * 16 * D + bj * 128) = pack8(xs[m][bj][0] + gv[bj][0] * acc[ai][bj][m][0], xs[m][bj][1] + gv[bj][1] * acc[ai][bj][m][1]);
            asm volatile("" ::: "memory");
        }
    }
};
struct EpiUp {
    static constexpr bool PERM = true;
    bf16_t* ACT; const float* bup;
    __device__ __forceinline__ void operator()(const f32x4 (&acc)[2][2][4][2], const Unit& u, int wr, int wc, int fr, int fq) const {
        const int a0 = u.pn * 128 + wc * 32 + 8 * fq;
        const float* bp = bup + (size_t)u.grp * 2048 + 2 * a0;
        constexpr float SC = (float)(1 << pg8::ACT8_SHIFT);
        float bg[8], bu4[8];
#pragma unroll
        for (int q = 0; q < 4; ++q) { const f32x4 t = *(const GAS f32x4*)(bp + 4 * q); bg[2 * q] = t[0]; bu4[2 * q] = SC * t[1] + SC; bg[2 * q + 1] = t[2]; bu4[2 * q + 1] = SC * t[3] + SC; }
        EPI_ROWS_BEGIN
            float o[8];
#pragma unroll
            for (int q = 0; q < 8; ++q) {
                const float gt = fminf(acc[ai][0][m][q >> 2][q & 3] + bg[q], 7.0f);
                const float u4 = __builtin_amdgcn_fmed3f(fmaf(acc[ai][1][m][q >> 2][q & 3], SC, bu4[q]), -6.0f * SC, 8.0f * SC);
                const float e = __builtin_amdgcn_exp2f(gt * (-1.702f * 1.4426950409f));
                o[q] = (gt * __builtin_amdgcn_rcpf(1.0f + e)) * u4;
            }
            int p0 = 0, p1 = 0;
            p0 = __builtin_amdgcn_cvt_pk_fp8_f32(o[0], o[1], p0, false); p0 = __builtin_amdgcn_cvt_pk_fp8_f32(o[2], o[3], p0, true);
            p1 = __builtin_amdgcn_cvt_pk_fp8_f32(o[4], o[5], p1, false); p1 = __builtin_amdgcn_cvt_pk_fp8_f32(o[6], o[7], p1, true);
            *(GAS u32x2*)((unsigned char*)ACT + (size_t)row * D + a0) = (u32x2){(unsigned)p0, (unsigned)p1};
        EPI_ROWS_END
    }
};
struct EpiDown {
    static constexpr bool PERM = true;
    bf16_t* Y; const float* bdn; const int* TS;
    __device__ __forceinline__ void operator()(const f32x4 (&acc)[2][2][4][2], const Unit& u, int wr, int wc, int fr, int fq) const {
        int dst[2][4];
#pragma unroll
        for (int ai = 0; ai < 2; ++ai)
#pragma unroll
            for (int m = 0; m < 4; ++m) dst[ai][m] = (ai == 1 && u.hu) ? -1 : TS[u.pm * 256 + u.hoff + ai * 128 + wr * 64 + m * 16 + fr];
#pragma unroll
        for (int bj = 0; bj < 2; ++bj) {
            const int col = u.pn * 256 + bj * 128 + wc * 32 + 8 * fq;
            const f32x4 b0 = *(const f32x4*)(bdn + (size_t)u.grp * D + col), b1 = *(const f32x4*)(bdn + (size_t)u.grp * D + col + 4);
#pragma unroll
            for (int ai = 0; ai < 2; ++ai)
#pragma unroll
                for (int m = 0; m < 4; ++m) if (dst[ai][m] >= 0) { f32x4 v0 = (acc[ai][bj][m][0] + b0) * 4.0f, v1 = (acc[ai][bj][m][1] + b1) * 4.0f; int p0 = 0, p1 = 0;
#pragma unroll
                    for (int q = 0; q < 4; ++q) { v0[q] = __builtin_amdgcn_fmed3f(v0[q], -448.0f, 448.0f); v1[q] = __builtin_amdgcn_fmed3f(v1[q], -448.0f, 448.0f); }
                    p0 = __builtin_amdgcn_cvt_pk_fp8_f32(v0[0], v0[1], p0, false); p0 = __builtin_amdgcn_cvt_pk_fp8_f32(v0[2], v0[3], p0, true); p1 = __builtin_amdgcn_cvt_pk_fp8_f32(v1[0], v1[1], p1, false); p1 = __builtin_amdgcn_cvt_pk_fp8_f32(v1[2], v1[3], p1, true);
                    *(u32x2*)((unsigned char*)Y + (size_t)dst[ai][m] * D + col) = (u32x2){(unsigned)p0, (unsigned)p1}; }
            asm volatile("" ::: "memory");
        }
    }
};

struct TItem { const float* W; unsigned char* WT; int K, N, k0, n0, kind; };
__device__ __forceinline__ TItem titem_decode(const Ctx& C, int it) {
    constexpr int I_IN = 16 * 72, I_GLU = 8 * 8, I_P5 = 8 * 16, I_PL = 16 * 16, I_OUT = 16 * 16, I_UP1 = 16 * 32, I_UP = 32 * I_UP1, I_DN1 = 16 * 16, I_DN = 32 * I_DN1;
    constexpr int PER_L = I_IN + I_GLU + I_P5 + I_PL + I_OUT + I_UP + I_DN;
    TItem t; const int l = it / PER_L; int r = it - l * PER_L, item;
    if (r < I_IN) { t.W = C.in(8) + (size_t)l * D * INW; t.K = D; t.N = INW; t.WT = C.p<unsigned char>(WS_WINT) + (size_t)l * INW * D * 2; t.kind = 0; item = r; }
    else if ((r -= I_IN) < I_GLU) { t.W = C.in(17) + (size_t)l * 512 * 512; t.K = 512; t.N = 512; t.WT = C.p<unsigned char>(WS_WGLUT) + (size_t)l * 512 * 512 * 2; t.kind = 0; item = r; }
    else if ((r -= I_GLU) < I_P5) { t.W = C.in(26) + (size_t)l * 512 * D; t.K = 512; t.N = D; t.WT = C.p<unsigned char>(WS_WP5T) + (size_t)l * D * 512 * 2; t.kind = 0; item = r; }
    else if ((r -= I_P5) < I_PL) { t.W = C.in(27) + (size_t)l * D * D; t.K = D; t.N = D; t.WT = C.p<unsigned char>(WS_WPLT) + (size_t)l * D * D * 2; t.kind = 0; item = r; }
    else if ((r -= I_PL) < I_OUT) { t.W = C.in(28) + (size_t)l * D * D; t.K = D; t.N = D; t.WT = C.p<unsigned char>(WS_WOUTT) + (size_t)l * D * D * 2; t.kind = 0; item = r; }
    else if ((r -= I_OUT) < I_UP) { const int e = r / I_UP1; t.W = C.in(31) + ((size_t)l * NEXP + e) * D * 2048; t.K = D; t.N = 2048; t.WT = C.p<unsigned char>(WS_WUPT) + ((size_t)l * NEXP + e) * 2048 * D; t.kind = 2; item = r - e * I_UP1; }
    else { r -= I_UP; const int e = r / I_DN1; t.W = C.in(33) + ((size_t)l * NEXP + e) * D * D; t.K = D; t.N = D; t.WT = C.p<unsigned char>(WS_WDNT) + ((size_t)l * NEXP + e) * D * D; t.kind = 1; item = r - e * I_DN1; }
    const int nblk = t.N / 64, kb = item / nblk; t.k0 = 64 * kb; t.n0 = 64 * (item - kb * nblk); return t;
}
__device__ __forceinline__ void titem_load(const TItem& t, int lane, f32x4 (&v)[16]) {
    const int r = lane >> 4, c4 = lane & 15;
#pragma unroll
    for (int i = 0; i < 16; ++i) v[i] = *(const f32x4*)(t.W + (size_t)(t.k0 + 4 * i + r) * t.N + t.n0 + 4 * c4);
}
__device__ __forceinline__ void titem_to_lds(const f32x4 (&v)[16], LAS float* scr, int lane) {
    const int r = lane >> 4, c4 = lane & 15;
#pragma unroll
    for (int i = 0; i < 16; ++i) { LAS float* d = scr + (4 * i + r) * 65 + 4 * c4; d[0] = v[i][0]; d[1] = v[i][1]; d[2] = v[i][2]; d[3] = v[i][3]; }
    asm volatile("s_waitcnt lgkmcnt(0)" ::: "memory");
}
__device__ __forceinline__ void titem_store(const TItem& t, const LAS float* scr, int lane) {
    const int c = lane & 7, nn = lane >> 3;
#pragma unroll
    for (int j = 0; j < 8; ++j) { const int n = nn + 8 * j; const LAS float* sp = scr + (8 * c) * 65 + n;
        int orow = t.n0 + n;
        if (t.kind == 2) { const int a = orow >> 1, sft = orow & 1; orow = (a >> 7) * 256 + sft * 128 + (a & 127); }
        if (t.kind != 0) {
            const float sc = (float)(1 << pg8::W8_SHIFT); int p0 = 0, p1 = 0;
            p0 = __builtin_amdgcn_cvt_pk_fp8_f32(sp[0 * 65] * sc, sp[1 * 65] * sc, p0, false); p0 = __builtin_amdgcn_cvt_pk_fp8_f32(sp[2 * 65] * sc, sp[3 * 65] * sc, p0, true);
            p1 = __builtin_amdgcn_cvt_pk_fp8_f32(sp[4 * 65] * sc, sp[5 * 65] * sc, p1, false); p1 = __builtin_amdgcn_cvt_pk_fp8_f32(sp[6 * 65] * sc, sp[7 * 65] * sc, p1, true);
            *(u32x2*)(t.WT + (size_t)orow * t.K + t.k0 + 8 * c) = (u32x2){(unsigned)p0, (unsigned)p1}; }
        else { u32x4 o; o.x = cvt_pk_bf16(sp[0 * 65], sp[1 * 65]); o.y = cvt_pk_bf16(sp[2 * 65], sp[3 * 65]); o.z = cvt_pk_bf16(sp[4 * 65], sp[5 * 65]); o.w = cvt_pk_bf16(sp[6 * 65], sp[7 * 65]);
            *(u32x4*)(t.WT + ((size_t)orow * t.K + t.k0 + 8 * c) * 2) = o; } }
    asm volatile("s_waitcnt lgkmcnt(0)" ::: "memory");
}
__device__ __forceinline__ void phase_transposes(const Ctx& C) {
    LAS float* scr = (LAS float*)(C.lds + C.wave * 17408);
    constexpr int NITEMS = DEPTH * (16 * 72 + 8 * 8 + 8 * 16 + 16 * 16 + 16 * 16 + 32 * 16 * 32 + 32 * 16 * 16), CHUNK = 16;
    static_assert(NITEMS % CHUNK == 0, "items per chunk");
    unsigned* q = C.p<unsigned>(WS_CTL) + CW_QUEUE;
    for (;;) {
        unsigned base = 0; if (C.lane == 0) base = __hip_atomic_fetch_add(q, (unsigned)CHUNK, __ATOMIC_RELAXED, __HIP_MEMORY_SCOPE_AGENT);
        base = (unsigned)__builtin_amdgcn_readfirstlane((int)base); if (base >= (unsigned)NITEMS) break;
        f32x4 va[16]; TItem ta = titem_decode(C, (int)base); titem_load(ta, C.lane, va);
#pragma unroll 1
        for (int i = 0; i < CHUNK; ++i) {
            titem_to_lds(va, scr, C.lane);
            const TItem tcur = ta;
            if (i + 1 < CHUNK) { ta = titem_decode(C, (int)base + i + 1); titem_load(ta, C.lane, va); }
            titem_store(tcur, scr, C.lane);
        }
    }
}

__device__ __forceinline__ void phase_s5prep(const Ctx& C) {
    LAS float* PW = (LAS float*)(C.lds);
    LAS float* BB = (LAS float*)(C.lds + 17408);
    LAS float* CC = (LAS float*)(C.lds + 17408 + 16384);
    LAS float* KT = (LAS float*)(C.lds + 17408 + 32768);
    const int tid = C.tid;
    for (int item = blockIdx.x; item < DEPTH * 32; item += C.G) {
        const int l = item >> 5, g = item & 31;
        __syncthreads();
        if (tid < 128) {
            const int dr = tid >> 6, p = tid & 63; const size_t ix = ((size_t)(l * 2 + dr) * 32 + g) * 64 + p;
            const double lr = (double)C.in(9)[ix], li = (double)C.in(10)[ix], dt = exp((double)C.in(11)[(l * 2 + dr) * 32 + g]);
            for (int k = 0; k <= 16; ++k) { const double mag = exp(lr * dt * k), ang = li * dt * k; PW[((dr * 17 + k) * 64 + p) * 2] = (float)(mag * cos(ang)); PW[((dr * 17 + k) * 64 + p) * 2 + 1] = (float)(mag * sin(ang)); }
            const double m1 = exp(lr * dt), abr = m1 * cos(li * dt), abi = m1 * sin(li * dt), den = lr * lr + li * li, zr = abr - 1.0;
            const double qr = (zr * lr + abi * li) / den, qi = (abi * lr - zr * li) / den;
            for (int h = 0; h < 16; ++h) { const double br = (double)C.in(12)[ix * 16 + h], bi = (double)C.in(13)[ix * 16 + h];
                BB[((dr * 64 + p) * 16 + h) * 2] = (float)(qr * br - qi * bi); BB[((dr * 64 + p) * 16 + h) * 2 + 1] = (float)(qr * bi + qi * br); }
            float* dec = C.p<float>(WS_DEC) + ix * 2; const double m16 = exp(lr * dt * 16), a16 = li * dt * 16; dec[0] = (float)(m16 * cos(a16)); dec[1] = (float)(m16 * sin(a16));
        }
        for (int e = tid; e < 2 * 16 * 64; e += 512) { const int dr = e >> 10, h = (e >> 6) & 15, p = e & 63; const size_t ix = (((size_t)(l * 2 + dr) * 32 + g) * 16 + h) * 64 + p;
            CC[e * 2] = C.in(14)[ix]; CC[e * 2 + 1] = C.in(15)[ix]; }
        __syncthreads();
        for (int e = tid; e < 8192; e += 512) { const int dr = e >> 12, tau = (e >> 8) & 15, i = (e >> 4) & 15, ip = e & 15; float s = 0.f;
            for (int p = 0; p < 64; ++p) { const float cr = CC[((dr * 16 + i) * 64 + p) * 2], ci = CC[((dr * 16 + i) * 64 + p) * 2 + 1], pr = PW[((dr * 17 + tau) * 64 + p) * 2], pi = PW[((dr * 17 + tau) * 64 + p) * 2 + 1];
                const float xr = cr * pr - ci * pi, xi = cr * pi + ci * pr; s += xr * BB[((dr * 64 + p) * 16 + ip) * 2] - xi * BB[((dr * 64 + p) * 16 + ip) * 2 + 1]; }
            KT[e] = s; }
        __syncthreads();
        bf16_t* W3 = C.p<bf16_t>(WS_W3T) + (size_t)item * 256 * 512; bf16_t* FT = C.p<bf16_t>(WS_FT) + (size_t)item * 256 * 256;
        const float* dvec = C.in(16) + (size_t)l * 512 + g * 16;
        for (int e2 = tid; e2 < 256 * 256; e2 += 512) {
            const int row = e2 >> 8, col0 = (e2 & 255) * 2, j = row >> 4, i = row & 15; float v[2];
#pragma unroll
            for (int q = 0; q < 2; ++q) { const int col = col0 + q;
                if (col < 256) { const int jp = col >> 4, ip = col & 15; float s = 0.f; if (j >= jp) s += KT[((0 * 16 + (j - jp)) * 16 + i) * 16 + ip]; if (jp >= j) s += KT[((1 * 16 + (jp - j)) * 16 + i) * 16 + ip]; if (row == col) s += dvec[i]; v[q] = s; }
                else { const int cc = col - 256, dr = cc >> 7, isim = (cc >> 6) & 1, p = cc & 63, pw = dr ? 16 - j : j + 1;
                    const float cr = CC[((dr * 16 + i) * 64 + p) * 2], ci = CC[((dr * 16 + i) * 64 + p) * 2 + 1], pr = PW[((dr * 17 + pw) * 64 + p) * 2], pi = PW[((dr * 17 + pw) * 64 + p) * 2 + 1];
                    v[q] = isim ? -(cr * pi + ci * pr) : (cr * pr - ci * pi); } }
            *(unsigned*)(W3 + (size_t)row * 512 + col0) = cvt_pk_bf16(v[0], v[1]);
        }
        for (int e2 = tid; e2 < 256 * 128; e2 += 512) {
            const int n = e2 >> 7, col0 = (e2 & 127) * 2, blk = n >> 6, p = n & 63, dr = blk >> 1; float v[2];
#pragma unroll
            for (int q = 0; q < 2; ++q) { const int col = col0 + q, jp = col >> 4, ip = col & 15, pw = dr ? jp : 15 - jp;
                const float pr = PW[((dr * 17 + pw) * 64 + p) * 2], pi = PW[((dr * 17 + pw) * 64 + p) * 2 + 1], br = BB[((dr * 64 + p) * 16 + ip) * 2], bi = BB[((dr * 64 + p) * 16 + ip) * 2 + 1];
                v[q] = (blk & 1) ? (pr * bi + pi * br) : (pr * br - pi * bi); }
            *(unsigned*)(FT + (size_t)n * 256 + col0) = cvt_pk_bf16(v[0], v[1]);
        }
    }
    __syncthreads();
}

__device__ __forceinline__ void phase_ada(const Ctx& C) {
    LAS float* cond = (LAS float*)(C.lds);
    LAS float* red = (LAS float*)(C.lds + 17 * 1024 * 4);
    const int tid = C.tid;
    for (int e = tid; e < 17 * 1024; e += 512) { const float v = e < 16 * 1024 ? C.in(1)[e] : C.in(3)[e - 16 * 1024]; cond[e] = v * sigmoidf_(v); }
    __syncthreads();
    const int c = tid & 63, ks = tid >> 6;
    for (int item = C.G - 1 - (int)blockIdx.x; item < DEPTH * 96; item += C.G) {
        const int l = item / 96, cb = item - l * 96, col = cb * 64 + c;
        const float* W = C.in(4) + (size_t)l * D * 6144 + col;
        float acc[17];
#pragma unroll
        for (int r = 0; r < 17; ++r) acc[r] = 0.f;
        for (int k = ks * 128; k < ks * 128 + 128; k += 4) {
            const float w0 = W[(size_t)k * 6144], w1 = W[(size_t)(k + 1) * 6144], w2 = W[(size_t)(k + 2) * 6144], w3 = W[(size_t)(k + 3) * 6144];
#pragma unroll
            for (int r = 0; r < 17; ++r) { const f32x4 cv = *(const LAS f32x4*)(cond + r * 1024 + k); acc[r] += cv[0] * w0 + cv[1] * w1 + cv[2] * w2 + cv[3] * w3; }
        }
#pragma unroll
        for (int r = 0; r < 17; ++r) red[(ks * 17 + r) * 64 + c] = acc[r];
        __syncthreads();
        for (int e = tid; e < 17 * 64; e += 512) { const int r = e >> 6, cc = e & 63; float s = 0.f;
#pragma unroll
            for (int q = 0; q < 8; ++q) s += red[(q * 17 + r) * 64 + cc];
            C.p<float>(WS_ADA)[(size_t)(l * 17 + r) * 6144 + cb * 64 + cc] = s + C.in(5)[(size_t)l * 6144 + cb * 64 + cc]; }
        __syncthreads();
    }
}

__device__ __forceinline__ void load_row(const Ctx& C, bool from_input, int m, bool combine, int lc  , f32x4 (&v)[4]) {
    if (from_input) { const float* src = m < NLAT ? C.in(0) + (size_t)m * D : C.in(2) + (size_t)(m - NLAT) * D;
#pragma unroll
        for (int j = 0; j < 4; ++j) v[j] = *(const f32x4*)(src + 4 * C.lane + 256 * j); }
    else { const bf16_t* src = C.p<bf16_t>(WS_X) + (size_t)m * D;
#pragma unroll
        for (int j = 0; j < 4; ++j) { const u32x2 t = *(const u32x2*)(src + 4 * C.lane + 256 * j); v[j] = (f32x4){bflo(t.x), bfhi(t.x), bflo(t.y), bfhi(t.y)}; } }
    if (combine) {
        const int bsel = m < NLAT ? (m >> 11) : 16;
        const float* g2 = C.p<float>(WS_ADA) + ((size_t)(lc * 17 + bsel) * 6 + 5) * D;
        f32x4 s[4];
#pragma unroll
        for (int j = 0; j < 4; ++j) s[j] = (f32x4){0.f, 0.f, 0.f, 0.f};
#pragma unroll
        for (int k = 0; k < 4; ++k) {
            const float w = C.p<float>(WS_TOKW)[m * 4 + k] * (1.0f / 4.0f);
            const unsigned char* y = C.p<unsigned char>(WS_Y) + (size_t)(m * 4 + k) * D;
#pragma unroll
            for (int j = 0; j < 4; ++j) { const int t = *(const int*)(y + 4 * C.lane + 256 * j); const f32x2 lo = __builtin_amdgcn_cvt_pk_f32_fp8(t, false), hi = __builtin_amdgcn_cvt_pk_f32_fp8(t, true); s[j] += w * (f32x4){lo.x, lo.y, hi.x, hi.y}; }
        }
#pragma unroll
        for (int j = 0; j < 4; ++j) v[j] += *(const f32x4*)(g2 + 4 * C.lane + 256 * j) * s[j];
    }
}
__device__ __forceinline__ float row_rstd(const f32x4 (&v)[4], int lane) {
    float s = 0.f;
#pragma unroll
    for (int j = 0; j < 4; ++j) s += (v[j][0] * v[j][0] + v[j][1] * v[j][1]) + (v[j][2] * v[j][2] + v[j][3] * v[j][3]);
    return rsqrtf(wave_sum(s, lane) * (1.0f / D) + 1e-6f);
}
__device__ __forceinline__ void norm_mod(const Ctx& C, f32x4 (&v)[4], const float* gain, const float* shift, const float* scale) {
    const float rstd = row_rstd(v, C.lane);
#pragma unroll
    for (int j = 0; j < 4; ++j) { const int c = 4 * C.lane + 256 * j; const f32x4 gn = *(const f32x4*)(gain + c), sh = *(const f32x4*)(shift + c), sc = *(const f32x4*)(scale + c);
        v[j] = (v[j] * rstd * gn) * (sc + 1.0f) + sh; }
}
constexpr int Y8_SHIFT = 2;
__device__ __forceinline__ void unpack8_fp8(const u32x2 w, f32x4& a, f32x4& b) {
    const f32x2 a0 = __builtin_amdgcn_cvt_pk_f32_fp8((int)w.x, false), a1 = __builtin_amdgcn_cvt_pk_f32_fp8((int)w.x, true), b0 = __builtin_amdgcn_cvt_pk_f32_fp8((int)w.y, false), b1 = __builtin_amdgcn_cvt_pk_f32_fp8((int)w.y, true);
    a = (f32x4){a0.x, a0.y, a1.x, a1.y}; b = (f32x4){b0.x, b0.y, b1.x, b1.y}; }
struct RowV { f32x4 a[4]; };
__device__ __forceinline__ void n1_vec(const float* p, int lane, f32x4 (&o)[4]) { const GAS f32x4* q = (const GAS f32x4*)(p + 8 * lane); o[0] = q[0]; o[1] = q[1]; o[2] = q[128]; o[3] = q[129]; }
__device__ __forceinline__ void phase_norm1(const Ctx& C, int l) {
    const int gw = blockIdx.x * 8 + C.wave, NGW = C.G * 8, lane = C.lane;
    const int per = (NTOK + NGW - 1) / NGW, mb = gw * per, me = min(mb + per, NTOK);
    f32x4 gain[4], sh[4], sc[4], g2[4]; int cur_b = -1;
    n1_vec(C.in(6) + (size_t)l * D, lane, gain);
    const bool comb = l > 0;
    for (int m0 = mb; m0 < me; m0 += 2) {
        const bool has1 = m0 + 1 < me; const int m1 = has1 ? m0 + 1 : m0;
        RowV x[2]; u32x2 y[2][4][2]; f32x4 w[2];
#pragma unroll
        for (int r = 0; r < 2; ++r) { const int m = r ? m1 : m0;
            if (l == 0) { const float* src = m < NLAT ? C.in(0) + (size_t)m * D : C.in(2) + (size_t)(m - NLAT) * D; n1_vec(src, lane, x[r].a); }
            else { const GAS u32x4* q = (const GAS u32x4*)(C.p<bf16_t>(WS_X) + (size_t)m * D + 8 * lane); const u32x4 t0 = q[0], t1 = q[64]; unpack8(t0, x[r].a[0], x[r].a[1]); unpack8(t1, x[r].a[2], x[r].a[3]); }
            if (comb) { w[r] = *(const GAS f32x4*)(C.p<float>(WS_TOKW) + (size_t)m * 4);
#pragma unroll
                for (int k = 0; k < 4; ++k) { const GAS u32x2* q = (const GAS u32x2*)(C.p<unsigned char>(WS_Y) + (size_t)(m * 4 + k) * D + 8 * lane); y[r][k][0] = q[0]; y[r][k][1] = q[64]; } }
        }
#pragma unroll
        for (int r = 0; r < 2; ++r) { const int m = r ? m1 : m0; if (r == 1 && !has1) break;
            const int bsel = m < NLAT ? (m >> 11) : 16;
            if (bsel != cur_b) { cur_b = bsel; const float* ada = C.p<float>(WS_ADA) + (size_t)(l * 17 + bsel) * 6 * D; n1_vec(ada, lane, sh); n1_vec(ada + D, lane, sc);
                if (comb) n1_vec(C.p<float>(WS_ADA) + ((size_t)((l - 1) * 17 + bsel) * 6 + 5) * D, lane, g2); }
            if (comb) {
                f32x4 s4[4];
#pragma unroll
                for (int q = 0; q < 4; ++q) s4[q] = (f32x4){0.f, 0.f, 0.f, 0.f};
#pragma unroll
                for (int k = 0; k < 4; ++k) { f32x4 t0, t1, t2, t3; unpack8_fp8(y[r][k][0], t0, t1); unpack8_fp8(y[r][k][1], t2, t3); const float wk = w[r][k] * (1.0f / (float)(1 << Y8_SHIFT)); s4[0] += wk * t0; s4[1] += wk * t1; s4[2] += wk * t2; s4[3] += wk * t3; }
#pragma unroll
                for (int q = 0; q < 4; ++q) x[r].a[q] += g2[q] * s4[q];
                GAS u32x4* xo = (GAS u32x4*)(C.p<bf16_t>(WS_X) + (size_t)m * D + 8 * lane); xo[0] = pack8(x[r].a[0], x[r].a[1]); xo[64] = pack8(x[r].a[2], x[r].a[3]);
            }
            float ss = 0.f;
#pragma unroll
            for (int q = 0; q < 4; ++q) ss += (x[r].a[q][0] * x[r].a[q][0] + x[r].a[q][1] * x[r].a[q][1]) + (x[r].a[q][2] * x[r].a[q][2] + x[r].a[q][3] * x[r].a[q][3]);
            const float rstd = rsqrtf(wave_sum(ss, lane) * (1.0f / D) + 1e-6f);
            f32x4 h[4];
#pragma unroll
            for (int q = 0; q < 4; ++q) h[q] = (x[r].a[q] * rstd * gain[q]) * (sc[q] + 1.0f) + sh[q];
            GAS u32x4* ho = (GAS u32x4*)(C.p<bf16_t>(WS_HN) + (size_t)m * D + 8 * lane); ho[0] = pack8(h[0], h[1]); ho[64] = pack8(h[2], h[3]);
        }
    }
}
__device__ __forceinline__ void split_bf16(const f32x4 a, const f32x4 b, bf16x8& hi, bf16x8& lo) {
    u32x4 h = pack8(a, b); f32x4 ha, hb; unpack8(h, ha, hb); u32x4 lw = pack8(a - ha, b - hb); hi = __builtin_bit_cast(bf16x8, h); lo = __builtin_bit_cast(bf16x8, lw);
}
__device__ __forceinline__ void phase_norm2(const Ctx& C, int l, int ntok) {
    LAS float* T = (LAS float*)C.lds;
    LAS float* LG = (LAS float*)(C.lds + 131584);
    LAS int* lcnt = (LAS int*)(C.lds + LC_LCNT); LAS int* gb = (LAS int*)(C.lds + LC_GB);
    unsigned* CNT = C.p<unsigned>(WS_CTL) + CW_CNT + l * 32;
    const float* wr = C.in(29) + (size_t)l * D * 32; const float* br = C.in(30) + l * 32;
    const int tid = C.tid, lane = C.lane, w = C.wave;
    bf16x8 bhi[4][2], blo[4][2];
#pragma unroll
    for (int s = 0; s < 4; ++s)
#pragma unroll
        for (int nt = 0; nt < 2; ++nt) { const int k = 128 * w + 32 * s + 8 * (lane >> 4), e = 16 * nt + (lane & 15); f32x4 a, b;
#pragma unroll
            for (int j = 0; j < 4; ++j) { a[j] = wr[(size_t)(k + j) * 32 + e]; b[j] = wr[(size_t)(k + 4 + j) * 32 + e]; }
            split_bf16(a, b, bhi[s][nt], blo[s][nt]); }
    for (int blk = blockIdx.x; blk < ntok / 32; blk += C.G) {
        {
            f32x4 v[4][4]; const int mb = blk * 32 + w * 4;
#pragma unroll
            for (int rr = 0; rr < 4; ++rr) load_row(C, false, mb + rr, false, 0, v[rr]);
#pragma unroll
            for (int rr = 0; rr < 4; ++rr) { const int r = w * 4 + rr, m = mb + rr;
                const int bsel = m < NLAT ? (m >> 11) : 16; const float* ada = C.p<float>(WS_ADA) + (size_t)(l * 17 + bsel) * 6 * D;
                norm_mod(C, v[rr], C.in(7) + (size_t)l * D, ada + 3 * D, ada + 4 * D);
#pragma unroll
                for (int j = 0; j < 4; ++j) { const float sc = (float)(1 << pg8::ACT8_SHIFT); int pk = 0;
                    { f32x4 c4 = v[rr][j] * sc;
#pragma unroll
                      for (int q = 0; q < 4; ++q) c4[q] = __builtin_amdgcn_fmed3f(c4[q], -448.0f, 448.0f);
                      pk = __builtin_amdgcn_cvt_pk_fp8_f32(c4[0], c4[1], pk, false); pk = __builtin_amdgcn_cvt_pk_fp8_f32(c4[2], c4[3], pk, true); }
                    *(int*)(C.p<unsigned char>(WS_HN) + (size_t)m * D + 4 * lane + 256 * j) = pk;
                    *(LAS f32x4*)(T + r * 1028 + 4 * lane + 256 * j) = v[rr][j]; } }
        }
        if (tid < 32) lcnt[tid] = 0;
        __syncthreads();
        f32x4 acc[2][2];
#pragma unroll
        for (int mt = 0; mt < 2; ++mt)
#pragma unroll
            for (int nt = 0; nt < 2; ++nt) acc[mt][nt] = (f32x4){0.f, 0.f, 0.f, 0.f};
#pragma unroll
        for (int s = 0; s < 4; ++s)
#pragma unroll
            for (int mt = 0; mt < 2; ++mt) { const LAS float* tp = T + (16 * mt + (lane & 15)) * 1028 + 128 * w + 32 * s + 8 * (lane >> 4);
                bf16x8 ahi, alo; split_bf16(*(const LAS f32x4*)tp, *(const LAS f32x4*)(tp + 4), ahi, alo);
#pragma unroll
                for (int nt = 0; nt < 2; ++nt) {
                    acc[mt][nt] = __builtin_amdgcn_mfma_f32_16x16x32_bf16(ahi, bhi[s][nt], acc[mt][nt], 0, 0, 0);
                    acc[mt][nt] = __builtin_amdgcn_mfma_f32_16x16x32_bf16(alo, bhi[s][nt], acc[mt][nt], 0, 0, 0);
                    acc[mt][nt] = __builtin_amdgcn_mfma_f32_16x16x32_bf16(ahi, blo[s][nt], acc[mt][nt], 0, 0, 0); } }
        __syncthreads();
#pragma unroll
        for (int mt = 0; mt < 2; ++mt)
#pragma unroll
            for (int nt = 0; nt < 2; ++nt)
#pragma unroll
                for (int q = 0; q < 4; ++q) T[(w * 32 + 16 * mt + 4 * (lane >> 4) + q) * 33 + 16 * nt + (lane & 15)] = acc[mt][nt][q];
        __syncthreads();
#pragma unroll
        for (int o = tid; o < 1024; o += 512) { const int row = o >> 5, col = o & 31; float sum = 0.f;
#pragma unroll
            for (int q = 0; q < 8; ++q) sum += T[(q * 32 + row) * 33 + col];
            LG[row * 33 + col] = sum + br[col]; }
        __syncthreads();
        int te[4]; float tw[4]; int tp[4];
        if (tid < 32) {
            unsigned used = 0u; float tv[4];
#pragma unroll
            for (int k = 0; k < 4; ++k) { float best = -3.0e38f; int bi = 0;
                for (int e = 0; e < 32; ++e) { const float x = LG[tid * 33 + e]; if (!((used >> e) & 1u) && x > best) { best = x; bi = e; } }
                used |= 1u << bi; te[k] = bi; tv[k] = best; }
            float sm = 0.f;
#pragma unroll
            for (int k = 0; k < 4; ++k) { tw[k] = __expf(tv[k] - tv[0]); sm += tw[k]; }
#pragma unroll
            for (int k = 0; k < 4; ++k) { tw[k] /= sm; tp[k] = atomicAdd((int*)&lcnt[te[k]], 1); }
        }
        __syncthreads();
        if (tid < 32) { const int n = lcnt[tid]; gb[tid] = n > 0 ? (int)atomicAdd(CNT + tid, (unsigned)n) : 0; }
        __syncthreads();
        if (tid < 32) { const int m = blk * 32 + tid;
#pragma unroll
            for (int k = 0; k < 4; ++k) { C.p<int>(WS_TOKE)[m * 4 + k] = te[k]; C.p<int>(WS_TOKP)[m * 4 + k] = gb[te[k]] + tp[k]; C.p<float>(WS_TOKW)[m * 4 + k] = tw[k]; } }
        __syncthreads();
    }
}
__device__ __forceinline__ int moe_offsets(const Ctx& C, int l, bool tiles) {
    LAS int* offs = (LAS int*)(C.lds + LC_OFFS); LAS unsigned char* tile_e = (LAS unsigned char*)(C.lds + LC_TILE);
    unsigned* CNT = C.p<unsigned>(WS_CTL) + CW_CNT + l * 32;
    __syncthreads();
    if (C.tid < 64) {
        const int e = C.tid & 31; const int n = (int)__hip_atomic_load(CNT + e, __ATOMIC_RELAXED, __HIP_MEMORY_SCOPE_AGENT); const int pad = (n + 255) & ~255; int inc = pad;
#pragma unroll
        for (int d = 1; d < 32; d <<= 1) { const int t = __builtin_amdgcn_ds_bpermute(((C.tid & 63) - d) << 2, inc); if (e >= d) inc += t; }
        if (C.tid < 32) { offs[e] = inc - pad; if (e == 31) offs[32] = inc; }
    }
    __syncthreads();
    const int tt = offs[32] >> 8;
    if (tiles) { for (int t = C.tid; t < tt; t += 512) { int e = 0;
#pragma unroll 1
        while (e < 31 && offs[e + 1] <= t * 256) ++e; tile_e[t] = (unsigned char)e; } __syncthreads(); }
    return tt;
}
__device__ __forceinline__ void phase_slots(const Ctx& C, int l, int ntok) {
    moe_offsets(C, l, false);
    LAS int* offs = (LAS int*)(C.lds + LC_OFFS);
    unsigned* CNT = C.p<unsigned>(WS_CTL) + CW_CNT + l * 32;
    int* TS = C.p<int>(WS_XS);
    int* TS2 = (int*)(C.ws + WS_XS + (1u << 20));
    const int gt = blockIdx.x * 512 + C.tid, NGT = C.G * 512;
    for (int w = gt; w < ntok * 32; w += NGT) {
        const int idx = w >> 3, cc = w & 7;
        const int e = C.p<int>(WS_TOKE)[idx], slot = offs[e] + C.p<int>(WS_TOKP)[idx];
        if (cc == 0) TS[slot] = idx;
        const int tile = slot >> 8, r = slot & 255, h = r >> 7, R = r & 127, bb = pg8::lds_byte(R, 8 * cc), i = bb >> 13, t = (bb & 8191) >> 4;
        TS2[((tile * 512 + t) * 2 + h) * 2 + i] = (idx >> 2) * D + 16 * cc;
    }
#pragma unroll 1
    for (int e = 0; e < 32; ++e) { const int n = (int)__hip_atomic_load(CNT + e, __ATOMIC_RELAXED, __HIP_MEMORY_SCOPE_AGENT), p0 = offs[e] + n, p1 = offs[e + 1];
        if (gt < (p1 - p0) * 8) { const int slot = p0 + (gt >> 3), cc = gt & 7; if (cc == 0) TS[slot] = -1;
            const int tile = slot >> 8, r = slot & 255, h = r >> 7, R = r & 127, bb = pg8::lds_byte(R, 8 * cc), i = bb >> 13, t = (bb & 8191) >> 4;
            TS2[((tile * 512 + t) * 2 + h) * 2 + i] = 16 * cc; } }
}
__device__ __forceinline__ void phase_final(const Ctx& C) {
    const int gw = blockIdx.x * 8 + C.wave, NGW = C.G * 8;
    for (int m = gw; m < NLAT; m += NGW) {
        f32x4 v[4]; load_row(C, false, m, true, DEPTH - 1, v);
        const float rstd = row_rstd(v, C.lane);
#pragma unroll
        for (int j = 0; j < 4; ++j) { const int c = 4 * C.lane + 256 * j; *(f32x4*)(C.out + (size_t)m * D + c) = v[j] * rstd * *(const f32x4*)(C.in(35) + c); }
    }
}

__device__ __forceinline__ void phase_s5carry_ol(const Ctx& C, int l) {
    if (C.tid < 256) {
        for (int gid = blockIdx.x * 256 + C.tid; gid < 65536; gid += C.G * 256) {
            const int p = gid & 63, dr = (gid >> 6) & 1, g = (gid >> 7) & 31, b = gid >> 12;
            const f32x2 dec = *(const f32x2*)(C.p<float>(WS_DEC) + (((size_t)(l * 2 + dr) * 32 + g) * 64 + p) * 2);
            float hr = 0.f, hi = 0.f;
#pragma unroll 1
            for (int k0 = 0; k0 < NCH; k0 += 16) {
                float sr[16], si[16];
#pragma unroll
                for (int q = 0; q < 16; ++q) { const int k = k0 + q, cidx = dr == 0 ? k : (k < 16 ? 15 - k : 159 - k);
                    const float* sp = C.p<float>(WS_SB) + ((size_t)(b * NCH + cidx) * 32 + g) * 256 + dr * 128 + p; sr[q] = sp[0]; si[q] = sp[64]; }
#pragma unroll
                for (int q = 0; q < 16; ++q) { const int k = k0 + q, cidx = dr == 0 ? k : (k < 16 ? 15 - k : 159 - k);
                    bf16_t* a3 = C.p<bf16_t>(WS_A3) + ((size_t)(b * NCH + cidx) * 32 + g) * 512 + 256 + dr * 128 + p;
                    a3[0] = f2bf(hr); a3[64] = f2bf(hi);
                    const float nr = dec.x * hr - dec.y * hi + sr[q], ni = dec.x * hi + dec.y * hr + si[q]; hr = nr; hi = ni; }
            }
        }
    }
}

__device__ __forceinline__ int lru_row(int b, bool isctx, int p) { return isctx ? NLAT + b * 256 + p : b * 2048 + (p & 31) * 64 + (p >> 5); }
__device__ __forceinline__ void phase_lru(const Ctx& C, int l) {
    const int tid = C.tid, dir = tid >> 8, lt = tid & 255, lw = (tid >> 6) & 3, lane = tid & 63;
    const int mt = lw >> 1, ct = lw & 1, half = lane >> 5, cl = lane & 31;
    LAS unsigned char* R = C.lds + dir * 49152;
    LAS unsigned char* XT = R;
    LAS unsigned char* XC = R + 8704;
    LAS float* SEG = (LAS float*)(R + 17920);
    LAS unsigned char* OT = R + 19968;
    LAS unsigned char* G2 = R + 29184;
    LAS unsigned char* OUTT = R + 38400;
    const bf16_t* XR = C.p<bf16_t>(WS_XR); bf16_t* HOUT = C.p<bf16_t>(dir ? WS_HB : WS_HF);
    const bf16_t* HOTH = C.p<bf16_t>(dir ? WS_HF : WS_HB); const bf16_t* GGp = C.p<bf16_t>(WS_GG); bf16_t* OLp = C.p<bf16_t>(WS_OL);
    const int seg = 2 * mt + half, ch = 32 * ct + cl;
    const int srow = 16 * (2 * mt + ((cl >> 2) & 1)) + (cl & 3) + 4 * (cl >> 3);
    const int qrow = dir ? 63 - srow : srow;
    for (int task = blockIdx.x; task < 256; task += C.G) {
        const int b = task >> 4, n = task & 15;
        const float lam = C.in(21)[(size_t)(l * 2 + dir) * D + n * 64 + ch];
        const float coef2 = -8.0f * log1pf(__expf(-lam)) * 1.4426950409f;
        const int c2 = lt & 31, pg = lt >> 5;
        float cw[4][2], cb[2];
#pragma unroll
        for (int j = 0; j < 4; ++j) { cw[j][0] = C.in(19)[((size_t)l * 4 + j) * D + n * 64 + 2 * c2]; cw[j][1] = C.in(19)[((size_t)l * 4 + j) * D + n * 64 + 2 * c2 + 1]; }
        cb[0] = C.in(20)[(size_t)l * D + n * 64 + 2 * c2]; cb[1] = C.in(20)[(size_t)l * D + n * 64 + 2 * c2 + 1];
        const float* Wa = C.in(22) + ((size_t)((l * 2 + dir) * 16 + n) * 64) * 64; const float* Wx = C.in(24) + ((size_t)((l * 2 + dir) * 16 + n) * 64) * 64;
        bf16x8 bfa[4], bfx[4];
#pragma unroll
        for (int s = 0; s < 4; ++s) {
            unsigned wa[4], wx[4];
#pragma unroll
            for (int jj = 0; jj < 4; ++jj) { const int k = 16 * s + 8 * half + 2 * jj; wa[jj] = cvt_pk_bf16(Wa[(size_t)k * 64 + ch], Wa[(size_t)(k + 1) * 64 + ch]); wx[jj] = cvt_pk_bf16(Wx[(size_t)k * 64 + ch], Wx[(size_t)(k + 1) * 64 + ch]); }
            u32x4 ta = (u32x4){wa[0], wa[1], wa[2], wa[3]}, tx = (u32x4){wx[0], wx[1], wx[2], wx[3]}; bfa[s] = __builtin_bit_cast(bf16x8, ta); bfx[s] = __builtin_bit_cast(bf16x8, tx);
        }
        const float bias_a = C.in(23)[(size_t)(l * 2 + dir) * D + n * 64 + ch], bias_x = C.in(25)[(size_t)(l * 2 + dir) * D + n * 64 + ch];
        const float nba = -1.4426950409f * bias_a, nbx = -1.4426950409f * bias_x;
        float hrun = 0.f;
        u32x4 pf[3];
        auto issue_tile = [&](int it) {
            const bool isctx = it < 4; const int p0 = dir == 0 ? (isctx ? 64 * it : 64 * (it - 4)) : (isctx ? 64 * (3 - it) : 64 * (35 - it)); const int slen = isctx ? 256 : 2048;
#pragma unroll
            for (int r = 0; r < 3; ++r) { const int q = lt + 256 * r, rr = q >> 3, pc = q & 7, p = p0 - 1 + rr;
                pf[r] = (u32x4){0u, 0u, 0u, 0u};
                if (rr < 67 && p >= 0 && p < slen) pf[r] = *(const u32x4*)(XR + (size_t)lru_row(b, isctx, p) * D + n * 64 + pc * 8); }
        };
        auto lru_flush = [&](int itp) {
            const bool cx = itp < 4; const int pp = dir == 0 ? (cx ? 64 * itp : 64 * (itp - 4)) : (cx ? 64 * (3 - itp) : 64 * (35 - itp)); const bool sec = itp < 4 ? itp >= 2 : itp >= 20;
            bf16_t* dstb = sec ? OLp : HOUT;
#pragma unroll
            for (int r = 0; r < 2; ++r) { const int q = lt + 256 * r, rr = q >> 3, pc = q & 7; *(GAS u32x4*)(dstb + (size_t)lru_row(b, cx, pp + rr) * D + n * 64 + pc * 8) = *(const LAS u32x4*)(OUTT + rr * 144 + pc * 16); }
        };
        issue_tile(0);
#pragma unroll 1
        for (int it = 0; it < 36; ++it) {
            const bool isctx = it < 4; const int p0 = dir == 0 ? (isctx ? 64 * it : 64 * (it - 4)) : (isctx ? 64 * (3 - it) : 64 * (35 - it));
#pragma unroll
            for (int r = 0; r < 3; ++r) { const int q = lt + 256 * r, rr = q >> 3, pc = q & 7; if (rr < 67) *(LAS u32x4*)(XT + rr * 128 + pc * 16) = pf[r]; }
            __syncthreads();
            if (it + 1 < 36) issue_tile(it + 1);
            if (it > 0) lru_flush(it - 1);
            const bool second = it < 4 ? it >= 2 : it >= 20;
            {
                float x0[11], x1[11];
#pragma unroll
                for (int r = 0; r < 11; ++r) { const unsigned w = *(const LAS unsigned*)(XT + (8 * pg + r) * 128 + c2 * 4); x0[r] = bflo(w); x1[r] = bfhi(w); }
#pragma unroll
                for (int q = 0; q < 8; ++q) { float y0 = cb[0], y1 = cb[1];
#pragma unroll
                    for (int j = 0; j < 4; ++j) { y0 += cw[j][0] * x0[q + j]; y1 += cw[j][1] * x1[q + j]; }
                    *(LAS unsigned*)(XC + (8 * pg + q) * 144 + c2 * 4) = cvt_pk_bf16(y0, y1); }
            }
            if (it == 2 || it == 20) asm volatile("s_waitcnt vmcnt(0)" ::: "memory");
            __syncthreads();
            u32x4 po[2], pg2[2];
            if (second) {
#pragma unroll
                for (int r = 0; r < 2; ++r) { const int q = lt + 256 * r, rr = q >> 3, pc = q & 7; const size_t off = (size_t)lru_row(b, isctx, p0 + rr) * D + n * 64 + pc * 8;
                    po[r] = *(const GAS u32x4*)(HOTH + off); pg2[r] = *(const GAS u32x4*)(GGp + off); }
            }
            f32x16 accr, acci;
#pragma unroll
            for (int q = 0; q < 16; ++q) { accr[q] = 0.f; acci[q] = 0.f; }
#pragma unroll
            for (int s = 0; s < 4; ++s) {
                const bf16x8 a = *(const LAS bf16x8*)(XC + qrow * 144 + (16 * s + 8 * half) * 2);
                accr = __builtin_amdgcn_mfma_f32_32x32x16_bf16(a, bfa[s], accr, 0, 0, 0);
                acci = __builtin_amdgcn_mfma_f32_32x32x16_bf16(a, bfx[s], acci, 0, 0, 0);
            }
            float av[16], bv[16]; float P = 1.f, H = 0.f;
#pragma unroll
            for (int i = 0; i < 16; ++i) { const int s = 16 * seg + i, q = dir ? 63 - s : s;
                const float r = __builtin_amdgcn_rcpf(1.0f + __builtin_amdgcn_exp2f(fmaf(accr[i], -1.4426950409f, nba))), ig = __builtin_amdgcn_rcpf(1.0f + __builtin_amdgcn_exp2f(fmaf(acci[i], -1.4426950409f, nbx)));
                const float xc = bf2f(*(const LAS unsigned short*)(XC + q * 144 + ch * 2));
                const float a = __builtin_amdgcn_exp2f(coef2 * r);
                const float em = fmaxf(fmaf(-a, a, 1.0f), 0.0f);
                const float bb = __builtin_amdgcn_sqrtf(em) * (ig * xc);
                av[i] = a; bv[i] = bb; P *= a; H = a * H + bb; }
            SEG[(seg * 64 + ch) * 2] = P; SEG[(seg * 64 + ch) * 2 + 1] = H;
            if (second) {
#pragma unroll
                for (int r = 0; r < 2; ++r) { const int q = lt + 256 * r, rr = q >> 3, pc = q & 7; *(LAS u32x4*)(OT + rr * 144 + pc * 16) = po[r]; *(LAS u32x4*)(G2 + rr * 144 + pc * 16) = pg2[r]; }
            }
            __syncthreads();
            float carry = hrun, mine = 0.f;
#pragma unroll
            for (int s2 = 0; s2 < 4; ++s2) { if (s2 == seg) mine = carry; carry = SEG[(s2 * 64 + ch) * 2] * carry + SEG[(s2 * 64 + ch) * 2 + 1]; }
            hrun = carry;
            float h = mine;
#pragma unroll
            for (int i = 0; i < 16; ++i) { const int s = 16 * seg + i, q = dir ? 63 - s : s; h = av[i] * h + bv[i];
                const float val = second ? bf2f(*(const LAS unsigned short*)(G2 + q * 144 + ch * 2)) * (h + bf2f(*(const LAS unsigned short*)(OT + q * 144 + ch * 2))) : h;
                *(LAS unsigned short*)(OUTT + q * 144 + ch * 2) = f2bf(val); }
        }
        __syncthreads();
        lru_flush(35);
        __syncthreads();
    }
}

__global__ void __launch_bounds__(512, 2) fwd_kernel(Args args) {
    extern __shared__ __attribute__((aligned(16))) unsigned char lds_raw[];
    Ctx C0; C0.out = args.out; C0.ws = args.ws; C0.lds = (LAS unsigned char*)lds_raw;
    C0.tid = threadIdx.x; C0.lane = C0.tid & 63; C0.wave = __builtin_amdgcn_readfirstlane(C0.tid >> 6); C0.G = gridDim.x;
    for (int u = C0.tid; u < (LDS_BYTES - LDS_CTL) / 4; u += 512) ((LAS unsigned*)(C0.lds + LDS_CTL))[u] = 0u;
    __syncthreads();
    if (C0.tid < 36) { const unsigned long long pv = (unsigned long long)args.in[C0.tid]; LAS unsigned* t = (LAS unsigned*)(C0.lds + LC_PTRS) + 2 * C0.tid; t[0] = (unsigned)pv; t[1] = (unsigned)(pv >> 32); }
    __syncthreads();
    const Ctx& C = C0;
    XcdBarrier bar = xcd_barrier_post(C.p<unsigned>(WS_CTL) + CW_BAR, (volatile LAS unsigned*)(C.lds + LC_MISC) + 8);
    const int lo = args.ph_lo, hi = args.ph_hi;
    int ph = 0;
#ifndef PHMASK
#define PHMASK 0xffffffffu
#endif
#define PH_ON(id) (((PHMASK) >> (id)) & 1u)
#define PHASE_BEGIN(id) if (PH_ON(id) && lo <= ph && ph < hi) { Ctx C = C0; const int _pid = id; (void)_pid; unsigned _z = 0u; asm volatile("" : "+s"(C.ws), "+s"(C.out), "+s"(C.lds), "+v"(_z)); C.lane = (int)__builtin_amdgcn_mbcnt_hi(~0u, __builtin_amdgcn_mbcnt_lo(~0u, _z)); C.tid = C.wave * 64 + C.lane;
#ifdef PROBE_MASK
#define PROBE_TICK() do { const unsigned long long _t = __builtin_amdgcn_s_memrealtime(); if (((PROBE_MASK) >> _pid) & 1u) pr_acc += _t - pr_prev; pr_prev = _t; } while (0)
#else
#define PROBE_TICK() do { } while (0)
#endif
#define PHASE_END(last) if (ph + 1 < hi && !(last)) xcd_barrier(bar); PROBE_TICK(); } ++ph;
#define PHASE_JOIN __syncthreads(); }
    const int cid = (int)blockIdx.x;
#ifdef PROBE_MASK
    unsigned long long pr_acc = 0ull, pr_prev = __builtin_amdgcn_s_memrealtime();
#endif

    PHASE_BEGIN(0)
        phase_s5prep(C);
        phase_ada(C);
        __syncthreads();
        phase_transposes(C);
    PHASE_END(false)

#pragma unroll 1
    for (int l = 0; l < DEPTH; ++l) {
        const int nMtok = (l == DEPTH - 1) ? 128 : 144;
        const int ntok = nMtok * 256;
        PHASE_BEGIN(1) phase_norm1(C, l); PHASE_END(false)
        PHASE_BEGIN(2)
            pg8::Gemm g{D, D, D, C.p<bf16_t>(WS_HN), (C.p<bf16_t>(WS_WINT) + (size_t)l * INW * D)}; SchedGrid S; S.rowtab4 = nullptr; S.so.init(144, 18, C.G, cid);  S.atile = (unsigned)256 * D * 2; S.btile = (unsigned)256 * D * 2;
            EpiInProj E{C.p<bf16_t>(WS_A3), C.p<bf16_t>(WS_XR), C.p<bf16_t>(WS_GG), C.p<bf16_t>(WS_M5), C.p<bf16_t>(WS_ML)};
            pg8::gemm_phase(C.lds, C.tid, g, S, E);
        PHASE_END(false)
        PHASE_BEGIN(3)
            pg8::Gemm g{16384, 256, 256, C.p<bf16_t>(WS_A3), (C.p<bf16_t>(WS_FT) + (size_t)l * 32 * 256 * 256)}; SchedS5 S{nullptr, C.G, cid, (unsigned)(256 * 256 * 2)};
            EpiS5L1 E{C.p<float>(WS_SB)};
            pg8::gemm_phase(C.lds, C.tid, g, S, E);
        PHASE_JOIN
        PHASE_BEGIN(15) phase_lru(C, l); PHASE_END(false)
        PHASE_BEGIN(4) phase_s5carry_ol(C, l); PHASE_END(false)
        PHASE_BEGIN(5)
            { pg8::Gemm g{16384, 512, 512, C.p<bf16_t>(WS_A3), (C.p<bf16_t>(WS_W3T) + (size_t)l * 32 * 256 * 512)}; SchedS5 S{nullptr, C.G, cid, (unsigned)(256 * 512 * 2)};
              EpiS5Y E{C.p<bf16_t>(WS_GY)};
              pg8::gemm_phase(C.lds, C.tid, g, S, E); }
            __syncthreads();
            { pg8::Gemm g{D, D, D, C.p<bf16_t>(WS_OL), (C.p<bf16_t>(WS_WPLT) + (size_t)l * D * D)}; SchedGrid S; S.rowtab4 = nullptr; S.so.init(nMtok, 4, C.G, C.G - 1 - cid);  S.atile = (unsigned)256 * D * 2; S.btile = (unsigned)256 * D * 2;
              EpiMulGate E{C.p<bf16_t>(WS_ML), nullptr, C.p<bf16_t>(WS_T1)};
              pg8::gemm_phase(C.lds, C.tid, g, S, E); }
        PHASE_END(false)
        PHASE_BEGIN(6)
            pg8::Gemm g{512, 512, 512, C.p<bf16_t>(WS_GY), (C.p<bf16_t>(WS_WGLUT) + (size_t)l * 512 * 512)}; SchedGrid S; S.rowtab4 = nullptr; S.so.init(nMtok, 2, C.G, cid);  S.atile = (unsigned)256 * 512 * 2; S.btile = (unsigned)256 * 512 * 2;
            EpiGlu E{C.p<bf16_t>(WS_GY), C.p<bf16_t>(WS_O5), C.in(18) + (size_t)l * 512};
            pg8::gemm_phase(C.lds, C.tid, g, S, E);
        PHASE_END(false)
        PHASE_BEGIN(7)
            pg8::Gemm g{512, 512, 512, C.p<bf16_t>(WS_O5), (C.p<bf16_t>(WS_WP5T) + (size_t)l * D * 512)}; SchedGrid S; S.rowtab4 = nullptr; S.so.init(nMtok, 4, C.G, cid);  S.atile = (unsigned)256 * 512 * 2; S.btile = (unsigned)256 * 512 * 2;
            EpiMulGate E{C.p<bf16_t>(WS_M5), C.p<bf16_t>(WS_T1), C.p<bf16_t>(WS_MG)};
            pg8::gemm_phase(C.lds, C.tid, g, S, E);
        PHASE_END(false)
        PHASE_BEGIN(9)
            pg8::Gemm g{D, D, D, C.p<bf16_t>(WS_MG), (C.p<bf16_t>(WS_WOUTT) + (size_t)l * D * D)}; SchedGrid S; S.rowtab4 = nullptr; S.so.init(nMtok, 4, C.G, cid);  S.atile = (unsigned)256 * D * 2; S.btile = (unsigned)256 * D * 2;
            EpiOut E{C.in(0), C.in(2), C.p<bf16_t>(WS_X), C.p<float>(WS_ADA), l};
            pg8::gemm_phase(C.lds, C.tid, g, S, E);
        PHASE_END(false)
        PHASE_BEGIN(10) phase_norm2(C, l, ntok); PHASE_END(false)
        PHASE_BEGIN(11) phase_slots(C, l, ntok); PHASE_END(false)
        PHASE_BEGIN(12)
            const int tt = moe_offsets(C, l, true);
            pg8::Gemm g{D / 2, D / 2, D / 2, C.p<unsigned char>(WS_HN), (C.p<unsigned char>(WS_WUPT) + (size_t)l * NEXP * 2048 * D)}; SchedMoe<true, true> S; S.rowtab4 = (const __attribute__((address_space(1))) i32x4*)(C.ws + WS_XS + (1u << 20)); S.rowmax = 0; S.so.init(tt, 8, C.G, cid);
            S.atile = (unsigned)256 * D; S.btile = (unsigned)256 * D; S.bexp = (unsigned)2048 * D;   S.tile_e = (const LAS unsigned char*)(C.lds + LC_TILE);
            EpiUp E{C.p<bf16_t>(WS_ACT), C.in(32) + (size_t)l * NEXP * 2048};
            pg8::gemm_phase(C.lds, C.tid, g, S, E);
        PHASE_END(false)
        PHASE_BEGIN(13)
            const int tt = moe_offsets(C, l, true);
            pg8::Gemm g{D / 2, D / 2, D / 2, C.p<unsigned char>(WS_ACT), (C.p<unsigned char>(WS_WDNT) + (size_t)l * NEXP * D * D)}; SchedMoe<false, true> S; S.rowtab4 = nullptr; S.rowmax = 0; S.so.init(tt, 4, C.G, cid);
            S.atile = (unsigned)256 * D; S.btile = (unsigned)256 * D; S.bexp = (unsigned)D * D; S.tile_e = (const LAS unsigned char*)(C.lds + LC_TILE);
            EpiDown E{C.p<bf16_t>(WS_Y), C.in(34) + (size_t)l * NEXP * D, C.p<int>(WS_XS)};
            pg8::gemm_phase(C.lds, C.tid, g, S, E);
        PHASE_END(false)
    }
    PHASE_BEGIN(14) phase_final(C); PHASE_END(true)
#ifdef PROBE_MASK
    if (blockIdx.x == 0) { const unsigned long long t0 = __builtin_amdgcn_s_memrealtime(); while (__builtin_amdgcn_s_memrealtime() - t0 < pr_acc * (PROBE_AMP)) __builtin_amdgcn_s_sleep(8); }
#endif
}

constexpr int N_PHASES = 1 + DEPTH * 12 + 1;
extern "C" void kernel_launch(void* const* d_in, const int* in_sizes, int n_in, void* d_out, int out_size, void* d_ws, size_t ws_size, hipStream_t stream) {
    static int grid = 0;
    if (grid == 0) {
        if (n_in != 36 || ws_size < WS_END) { fprintf(stderr, "kernel_launch: need 36 inputs and >= %zu bytes of workspace; got %d, %zu\n", (size_t)WS_END, n_in, ws_size); grid = -1; return; }
        int dev = 0, cus = 0, per_cu = 0;
        if (hipGetDevice(&dev) != hipSuccess || hipDeviceGetAttribute(&cus, hipDeviceAttributeMultiprocessorCount, dev) != hipSuccess) { grid = -1; return; }
        if (hipFuncSetAttribute((const void*)fwd_kernel, hipFuncAttributeMaxDynamicSharedMemorySize, LDS_BYTES) != hipSuccess) { fprintf(stderr, "kernel_launch: hipFuncSetAttribute failed\n"); grid = -1; return; }
        if (hipOccupancyMaxActiveBlocksPerMultiprocessor(&per_cu, (const void*)fwd_kernel, 512, LDS_BYTES) != hipSuccess || per_cu < 1) fprintf(stderr, "kernel_launch: occupancy query says %d\n", per_cu);
        (void)hipGetLastError();
        grid = cus;
    }
    if (grid < 0) return;
    (void)hipMemsetAsync((char*)d_ws + WS_CTL, 0, CTL_ZERO_BYTES, stream);
    Args a{};
    for (int i = 0; i < 36; ++i) a.in[i] = (const float*)d_in[i];
    a.out = (float*)d_out; a.ws = (unsigned char*)d_ws;
#ifndef MK_SPLIT
    a.ph_lo = 0; a.ph_hi = N_PHASES;
    hipLaunchKernelGGL(fwd_kernel, dim3(grid), dim3(512), LDS_BYTES, stream, a);
#else
    for (int p = 0; p < N_PHASES; ++p) { a.ph_lo = p; a.ph_hi = p + 1; hipLaunchKernelGGL(fwd_kernel, dim3(grid), dim3(512), LDS_BYTES, stream, a); }
#endif
}
```

```cpp
#include <hip/hip_runtime.h>
#include <cstdio>
#include <cstdint>

#define LAS __attribute__((address_space(3)))
typedef unsigned short bf16_t;
typedef short bf16x8 __attribute__((ext_vector_type(8)));
typedef float f32x4 __attribute__((ext_vector_type(4)));
typedef float f32x2 __attribute__((ext_vector_type(2)));
typedef float f32x16 __attribute__((ext_vector_type(16)));
typedef unsigned u32x4 __attribute__((ext_vector_type(4)));
typedef unsigned u32x2 __attribute__((ext_vector_type(2)));
typedef int i32x4 __attribute__((ext_vector_type(4)));
typedef int i32x8 __attribute__((ext_vector_type(8)));

constexpr int D = 1024, NB = 16, SEQ = 2048, CTXL = 256, DEPTH = 4;
constexpr int NLAT = NB * SEQ, NCTX = NB * CTXL, NTOK = NLAT + NCTX;
constexpr int INW = 4608, NEXP = 32;
constexpr int NCH = 144;
constexpr int NROW3 = NB * NCH;
constexpr int MAXSLOT = NTOK * 4 + NEXP * 256;

__device__ __forceinline__ float bf2f(unsigned short b) { return __uint_as_float(((unsigned)b) << 16); }
__device__ __forceinline__ float bflo(unsigned w) { return __uint_as_float(w << 16); }
__device__ __forceinline__ float bfhi(unsigned w) { return __uint_as_float(w & 0xffff0000u); }
typedef __bf16 bf16x2_n __attribute__((ext_vector_type(2)));
__device__ __forceinline__ unsigned cvt_pk_bf16(float lo, float hi) { f32x2 v = {lo, hi}; bf16x2_n b = __builtin_convertvector(v, bf16x2_n); return __builtin_bit_cast(unsigned, b); }
__device__ __forceinline__ unsigned short f2bf(float f) { return (unsigned short)(cvt_pk_bf16(f, 0.f) & 0xffffu); }
__device__ __forceinline__ float sigmoidf_(float x) { return __builtin_amdgcn_rcpf(1.0f + __expf(-x)); }
__device__ __forceinline__ float gelu_tanh(float x) { const float z = 1.5957691216f * (x + 0.044715f * x * x * x); return x * __builtin_amdgcn_rcpf(1.0f + __expf(-z)); }
__device__ __forceinline__ float wave_sum(float v, int lane) {
#pragma unroll
    for (int o = 1; o < 64; o <<= 1) v += __builtin_bit_cast(float, __builtin_amdgcn_ds_bpermute((lane ^ o) << 2, __builtin_bit_cast(int, v)));
    return v;
}

namespace pg8 {
constexpr int BM = 256, BK = 64, HALF = 128, HTB = HALF * BK * 2, STAGE_BYTES = 8 * HTB, NXCD = 8, WGM = 8;
__host__ __device__ __forceinline__ int lds_byte(int r, int c) { const int st = (r >> 4) * 2 + (c >> 5), rr = r & 15, cc = c & 31, ob = rr * 64 + cc * 2; return st * 1024 + (ob ^ (((ob >> 9) & 1) << 5)); }
__host__ __device__ __forceinline__ void stage_rc(int b, int& R, int& C) { const int st = b / 1024, sb = b % 1024, swz = sb ^ (((sb >> 9) & 1) << 5); R = (st >> 1) * 16 + swz / 64; C = (st & 1) * 32 + (swz % 64) / 2; }
__host__ __device__ __forceinline__ int perm32(int rho) { const int n = rho >> 4, i = rho & 15; return 8 * (i >> 2) + 4 * n + (i & 3); }

constexpr int ACT8_SHIFT = 2, W8_SHIFT = 6;
struct Unit { int pm, pn, grp, hu, hoff; unsigned a, b; };
struct Gemm { int lda, ldb, K; const void* A; const void* B; };

constexpr bool TAIL_SPLIT = false;
__device__ __forceinline__ bool tail_map(long L, int nwg, int G, int& fidx, int& hu, int& hs) {
    const int r = nwg % G, F = nwg - r; hu = 0; hs = 0;
    if (!TAIL_SPLIT || r == 0 || 2 * r > G || L < F) { if (L >= nwg) return false; fidx = (int)L; return true; }
    const long h = L - F; if (h >= 2 * r) return false; fidx = F + (int)(h >> 1); hu = 1; hs = (int)(h & 1); return true;
}
struct StaticOrder {
    int nM, nN, nwg, G, c;
    __device__ void init(int nM_, int nN_, int G_, int c_) { nM = nM_; nN = nN_; nwg = nM * nN; G = G_; c = c_; }
    __device__ bool next(int i, int& pm, int& pn, int& hu, int& hs) const {
        int wgid; if (!tail_map((long)i * G + c, nwg, G, wgid, hu, hs)) return false;
        { const int q = nwg / NXCD, r = nwg % NXCD, xcd = wgid % NXCD, off = wgid / NXCD; wgid = (xcd < r ? xcd * (q + 1) : r * (q + 1) + (xcd - r) * q) + off; }
        const int nig = WGM * nN, gid = wgid / nig, fm = gid * WGM, gsz = (nM - fm) < WGM ? (nM - fm) : WGM;
        pm = fm + ((wgid % nig) % gsz); pn = (wgid % nig) / gsz; return true;
    }
};

template <class Epi, class Sched>
__device__ __forceinline__ void gemm_phase(LAS unsigned char* lds, const int tid, const Gemm g, const Sched& S, const Epi& E) {
    const int wid = __builtin_amdgcn_readfirstlane(tid >> 6), lane = tid & 63, wr = wid >> 2, wc = wid & 3, fr = lane & 15, fq = lane >> 4;
    const int K = g.K, nt = K / BK;
    unsigned voffA[2], voffB[2];
#pragma unroll
    for (int i = 0; i < 2; ++i) { int R, C; stage_rc(tid * 16 + i * 8192, R, C); const int Rb = Epi::PERM ? ((R & ~31) + perm32(R & 31)) : R;
        voffA[i] = (unsigned)(R * g.lda + C) * 2u; voffB[i] = (unsigned)(Rb * g.ldb + C) * 2u; }
    constexpr bool GA = Sched::GATHER, F8 = Sched::F8;
    const unsigned long long _pa = (unsigned long long)g.A, _pb = (unsigned long long)g.B;
    void* const uA = (void*)(((unsigned long long)(unsigned)__builtin_amdgcn_readfirstlane((int)(_pa >> 32)) << 32) | (unsigned)__builtin_amdgcn_readfirstlane((int)_pa));
    void* const uB = (void*)(((unsigned long long)(unsigned)__builtin_amdgcn_readfirstlane((int)(_pb >> 32)) << 32) | (unsigned)__builtin_amdgcn_readfirstlane((int)_pb));
    const __amdgpu_buffer_rsrc_t rsA = __builtin_amdgcn_make_buffer_rsrc(uA, 0, 0x7fffffff, 0x00020000), rsB = __builtin_amdgcn_make_buffer_rsrc(uB, 0, 0x7fffffff, 0x00020000);
    const unsigned kstep = (unsigned)(BK * 2);
    const unsigned hstepA = GA ? 0u : (unsigned)HALF * g.lda * 2, hstepB = (unsigned)HALF * g.ldb * 2;
    unsigned vA[2][2], vN[2][2];
#define PG8_ROWS(u, v) do { if constexpr (GA) { unsigned _z = 0u; asm volatile("" : "+v"(_z)); const int _tid = wid * 64 + (int)__builtin_amdgcn_mbcnt_hi(~0u, __builtin_amdgcn_mbcnt_lo(~0u, _z)); const i32x4 _t = S.rowtab4[(u).pm * 512 + _tid]; const bool _hh = (u).hoff != 0;     \
        v[0][0] = (unsigned)(_hh ? _t.z : _t.x); v[0][1] = (unsigned)(_hh ? _t.w : _t.y); v[1][0] = (unsigned)_t.z; v[1][1] = (unsigned)_t.w; } \
        else { _Pragma("unroll") for (int _h = 0; _h < 2; ++_h) { v[_h][0] = voffA[0]; v[_h][1] = voffA[1]; } } } while (0)
#define PG8_SEL(h, usenext) unsigned vs[2] = { vA[h][0], vA[h][1] }
    const unsigned ldsw = (unsigned)wid * 1024u;
    const int aoff = lds_byte(wr * 64 + fr, fq * 8), boff = lds_byte(wc * 32 + fr, fq * 8);
#define PG8_SA(b, h) (((b) * 2 + (h)) * HTB)
#define PG8_SB(b, h) ((4 + (b) * 2 + (h)) * HTB)
#define PG8_STAGEX(rs, bufoff, soff, voff) do { _Pragma("unroll") for (int _i = 0; _i < 2; ++_i) \
        __builtin_amdgcn_raw_ptr_buffer_load_lds(rs, (LAS void*)(lds + (bufoff) + ldsw + _i * 8192), 16, (int)(voff)[_i], (int)(soff), 0, 0); } while (0)
#define PG8_STAGEA(bufoff, soff, voff) PG8_STAGEX(rsA, bufoff, soff, voff)
#define PG8_STAGEB(bufoff, soff, voff) PG8_STAGEX(rsB, bufoff, soff, voff)
#define PG8_LDA(dst, b, h) do { _Pragma("unroll") for (int m = 0; m < 4; ++m) _Pragma("unroll") for (int k = 0; k < 2; ++k) dst[m][k] = *(const LAS bf16x8*)(lds + PG8_SA(b, h) + aoff + m * 2048 + k * 1024); } while (0)
#define PG8_LDB(dst, b, h) do { _Pragma("unroll") for (int n = 0; n < 2; ++n) _Pragma("unroll") for (int k = 0; k < 2; ++k) dst[n][k] = *(const LAS bf16x8*)(lds + PG8_SB(b, h) + boff + n * 2048 + k * 1024); } while (0)
#define PG8_CAT(x) __builtin_shufflevector(__builtin_bit_cast(i32x4, (x)[0]), __builtin_bit_cast(i32x4, (x)[1]), 0, 1, 2, 3, 4, 5, 6, 7)
#define PG8_MMA(ai, bj, At, Bt) do { __builtin_amdgcn_s_setprio(1); if constexpr (F8) { _Pragma("unroll") for (int m = 0; m < 4; ++m) _Pragma("unroll") for (int n = 0; n < 2; ++n) \
        acc[ai][bj][m][n] = __builtin_amdgcn_mfma_scale_f32_16x16x128_f8f6f4(PG8_CAT(Bt[n]), PG8_CAT(At[m]), acc[ai][bj][m][n], 0, 0, 0, Sched::SCALE_B, 0, Sched::SCALE_A); } else { \
        _Pragma("unroll") for (int m = 0; m < 4; ++m) _Pragma("unroll") for (int n = 0; n < 2; ++n) _Pragma("unroll") for (int k = 0; k < 2; ++k) \
        acc[ai][bj][m][n] = __builtin_amdgcn_mfma_f32_16x16x32_bf16(Bt[n][k], At[m][k], acc[ai][bj][m][n], 0, 0, 0); } __builtin_amdgcn_s_setprio(0); } while (0)
#define PG8_WAIT_V(n) asm volatile("s_waitcnt vmcnt(" #n ")" ::: "memory")
#define PG8_WAIT_L(n) asm volatile("s_waitcnt lgkmcnt(" #n ")" ::: "memory")
#define PG8_BAR __builtin_amdgcn_s_barrier()
#define PG8_SCHED __builtin_amdgcn_sched_barrier(0)
    Unit cur, nxt; int ui = 0;
    if (!S.next(0, cur)) return;
    f32x4 acc[2][2][4][2];
#pragma unroll
    for (int a = 0; a < 2; ++a)
#pragma unroll
        for (int b = 0; b < 2; ++b)
#pragma unroll
            for (int m = 0; m < 4; ++m)
#pragma unroll
                for (int n = 0; n < 2; ++n) acc[a][b][m][n] = (f32x4){0.f, 0.f, 0.f, 0.f};
    bf16x8 At[4][2], B0[2][2], B1[2][2];
    unsigned cA = cur.a, cB = cur.b;
    PG8_ROWS(cur, vA);
    PG8_STAGEB(PG8_SB(0, 0), cB, voffB); PG8_STAGEB(PG8_SB(0, 1), cB + hstepB, voffB); PG8_STAGEA(PG8_SA(0, 0), cA, vA[0]); PG8_STAGEA(PG8_SA(0, 1), cA + hstepA, vA[1]);
    if (wr == 1) PG8_BAR;
    PG8_WAIT_V(2); PG8_BAR;
    PG8_STAGEB(PG8_SB(1, 0), cB + kstep, voffB); PG8_STAGEA(PG8_SA(1, 0), cA + kstep, vA[0]); PG8_STAGEB(PG8_SB(1, 1), cB + hstepB + kstep, voffB);
    PG8_WAIT_V(6); PG8_BAR;
    for (;;) {
        const bool has_next = S.next(ui + 1, nxt);
        const unsigned nA = has_next ? nxt.a : cA, nB = has_next ? nxt.b : cB;
        if (GA) { if (has_next) PG8_ROWS(nxt, vN); else { _Pragma("unroll") for (int _h = 0; _h < 2; ++_h) { vN[_h][0] = vA[_h][0]; vN[_h][1] = vA[_h][1]; } } }
#pragma unroll 1
        for (int t = 0; t < nt; t += 2) {
            const bool last = (t == nt - 2);
            const unsigned a1 = cA + (unsigned)(t + 1) * kstep;
            const unsigned a2 = last ? nA : cA + (unsigned)(t + 2) * kstep, b2 = last ? nB : cB + (unsigned)(t + 2) * kstep;
            const unsigned a3 = a2 + kstep, b3 = b2 + kstep;
            const bool un = GA && last, hu = cur.hu != 0;
            PG8_LDB(B0, 0, 0); PG8_LDB(B1, 0, 1); PG8_SCHED; PG8_LDA(At, 0, 0); PG8_STAGEA(PG8_SA(1, 1), a1 + hstepA, vA[1]);
            if (un) { _Pragma("unroll") for (int _h = 0; _h < 2; ++_h) { vA[_h][0] = vN[_h][0]; vA[_h][1] = vN[_h][1]; } }
            PG8_WAIT_V(8); PG8_WAIT_L(0); PG8_BAR; PG8_MMA(0, 0, At, B0); PG8_MMA(0, 1, At, B1); PG8_BAR; PG8_SCHED;
            { PG8_SEL(0, un); if (!hu) PG8_LDA(At, 0, 1); PG8_STAGEB(PG8_SB(0, 0), b2, voffB); PG8_STAGEB(PG8_SB(0, 1), b2 + hstepB, voffB); PG8_STAGEA(PG8_SA(0, 0), a2, vs); }
            PG8_WAIT_V(8); PG8_WAIT_L(0); PG8_BAR; if (!hu) { PG8_MMA(1, 0, At, B0); PG8_MMA(1, 1, At, B1); } PG8_BAR; PG8_SCHED;
            { PG8_SEL(1, un); PG8_LDB(B0, 1, 0); PG8_LDB(B1, 1, 1); PG8_SCHED; PG8_LDA(At, 1, 0); PG8_STAGEA(PG8_SA(0, 1), a2 + hstepA, vs); }
            PG8_WAIT_V(8); PG8_WAIT_L(0); PG8_BAR; PG8_MMA(0, 0, At, B0); PG8_MMA(0, 1, At, B1); PG8_BAR; PG8_SCHED;
            { PG8_SEL(0, un); if (!hu) PG8_LDA(At, 1, 1); PG8_STAGEB(PG8_SB(1, 0), b3, voffB); PG8_STAGEB(PG8_SB(1, 1), b3 + hstepB, voffB); PG8_STAGEA(PG8_SA(1, 0), a3, vs); }
            PG8_WAIT_V(8); PG8_WAIT_L(0); PG8_BAR; if (!hu) { PG8_MMA(1, 0, At, B0); PG8_MMA(1, 1, At, B1); } PG8_BAR; PG8_SCHED;
        }
        if (wr == 0) PG8_BAR;
        { unsigned z_ = 0u; asm volatile("" : "+v"(z_)); const int ln_ = (int)__builtin_amdgcn_mbcnt_hi(~0u, __builtin_amdgcn_mbcnt_lo(~0u, z_));
          E(acc, cur, wr, wc, ln_ & 15, ln_ >> 4); }
        if (!has_next) break;
#pragma unroll
        for (int a = 0; a < 2; ++a)
#pragma unroll
            for (int b = 0; b < 2; ++b)
#pragma unroll
                for (int m = 0; m < 4; ++m)
#pragma unroll
                    for (int n = 0; n < 2; ++n) acc[a][b][m][n] = (f32x4){0.f, 0.f, 0.f, 0.f};
        cur = nxt; cA = nA; cB = nB; ++ui;
        if (GA) {
#pragma unroll
            for (int _h = 0; _h < 2; ++_h) { vA[_h][0] = vN[_h][0]; vA[_h][1] = vN[_h][1]; } }
        if (wr == 1) PG8_BAR;
    }
    PG8_WAIT_V(0);
    PG8_BAR;
#undef PG8_SA
#undef PG8_CAT
#undef PG8_ROWS
#undef PG8_SEL
#undef PG8_SB
#undef PG8_STAGEX
#undef PG8_STAGEA
#undef PG8_STAGEB
#undef PG8_LDA
#undef PG8_LDB
#undef PG8_MMA
#undef PG8_WAIT_V
#undef PG8_WAIT_L
#undef PG8_BAR
#undef PG8_SCHED
}
}
using pg8::Unit;

#define XB_TMO      128
#define XB_XCNT(j)  (256  + 64 * (j))
#define XB_XSUB(j)  (1280 + 64 * (j))
#define XB_XGEN(j)  (2304 + 64 * (j))
#define XB_TOP      3328
#define XB_TOPGEN   3392
#define XCD_BAR_WORDS 3456
#define XB_SPIN_CAP (1u << 18)
__device__ __forceinline__ unsigned xb_ld(unsigned* p)              { return __hip_atomic_load(p, __ATOMIC_RELAXED, __HIP_MEMORY_SCOPE_AGENT); }
__device__ __forceinline__ unsigned xb_add(unsigned* p, unsigned v) { return __hip_atomic_fetch_add(p, v, __ATOMIC_RELAXED, __HIP_MEMORY_SCOPE_AGENT); }
__device__ __forceinline__ unsigned xb_xcc_id() { return (unsigned)__builtin_amdgcn_s_getreg((3 << 11) | 20) & 0xFu; }
#define XB_SPIN(cond, bar) do { unsigned _sp = 0; while (cond) { __builtin_amdgcn_s_sleep(1); \
    if ((++_sp & 255u) == 0u) { if (xb_ld(&(bar)[XB_TMO])) break; if (_sp > XB_SPIN_CAP) { atomicAdd(&(bar)[XB_TMO], 1u); break; } } } } while (0)
struct XcdBarrier { unsigned* bar; unsigned x; volatile LAS unsigned* st; };
__device__ __forceinline__ XcdBarrier xcd_barrier_post(unsigned* bar, volatile LAS unsigned* st) {
    XcdBarrier b; b.bar = bar; b.x = xb_xcc_id(); b.st = st;
    if (threadIdx.x == 0) (void)xb_add(&bar[XB_XCNT(b.x)], 1u);
    return b;
}
__device__ __forceinline__ void xcd_barrier_complete(unsigned* bar, unsigned x, unsigned& nloc, unsigned& nx) {
    const unsigned G = gridDim.x * gridDim.y * gridDim.z;
    unsigned sum, cnt, mine, sp = 0u;
    for (;;) {
        sum = 0u; cnt = 0u; mine = 0u;
#pragma unroll
        for (unsigned j = 0; j < 16; ++j) { const unsigned c = xb_ld(&bar[XB_XCNT(j)]); sum += c; cnt += (c > 0u) ? 1u : 0u; mine = (j == x) ? c : mine; }
        if (sum == G) break;
        __builtin_amdgcn_s_sleep(1);
        if ((++sp & 255u) == 0u) { if (xb_ld(&bar[XB_TMO])) break; if (sp > XB_SPIN_CAP) { atomicAdd(&bar[XB_TMO], 1u); break; } }
    }
    nloc = mine > 0u ? mine : 1u; nx = cnt > 0u ? cnt : 1u;
}
__device__ __forceinline__ void xcd_barrier(const XcdBarrier& b) {
    asm volatile("s_waitcnt vmcnt(0)" ::: "memory");
    __syncthreads();
    if (threadIdx.x == 0) {
        unsigned* bar = b.bar;
        __builtin_amdgcn_s_waitcnt(0);
        unsigned nloc = b.st[0], nx = b.st[1];
        if (nloc == 0u) { xcd_barrier_complete(bar, b.x, nloc, nx); b.st[0] = nloc; b.st[1] = nx; }
        const unsigned old = xb_add(&bar[XB_XSUB(b.x)], 1u);
        const unsigned gen = old / nloc;
        if (old + 1u == (gen + 1u) * nloc) {
            __builtin_amdgcn_fence(__ATOMIC_RELEASE, "agent");
            asm volatile("s_waitcnt vmcnt(0)" ::: "memory");
            const unsigned og = xb_add(&bar[XB_TOP], 1u);
            const unsigned tg = og / nx;
            if (og + 1u == (tg + 1u) * nx) xb_add(&bar[XB_TOPGEN], 1u);
            else XB_SPIN(xb_ld(&bar[XB_TOPGEN]) == tg, bar);
            __builtin_amdgcn_fence(__ATOMIC_ACQUIRE, "agent");
            xb_add(&bar[XB_XGEN(b.x)], 1u);
            asm volatile("s_waitcnt vmcnt(0)" ::: "memory");
        } else {
            XB_SPIN(xb_ld(&bar[XB_XGEN(b.x)]) == gen, bar);
            __builtin_amdgcn_fence(__ATOMIC_ACQUIRE, "agent");
            asm volatile("s_waitcnt vmcnt(0)" ::: "memory");
        }
    }
    __syncthreads();
}

constexpr size_t al256(size_t x) { return (x + 255) & ~(size_t)255; }
constexpr size_t WS_CTL = 0, CTL_ZERO_BYTES = 1u << 20;
constexpr int CW_QUEUE = 2048;
constexpr int CW_CNT = 1024;
constexpr int CW_BAR = 4096;
constexpr size_t WS_ADA   = CTL_ZERO_BYTES;
constexpr size_t WS_DEC   = al256(WS_ADA + (size_t)DEPTH * 17 * 6144 * 4);
constexpr size_t WS_W3T   = al256(WS_DEC + (size_t)DEPTH * 2 * 32 * 64 * 2 * 4);
constexpr size_t WS_FT    = al256(WS_W3T + (size_t)DEPTH * 32 * 256 * 512 * 2);
constexpr size_t WS_WINT  = al256(WS_FT + (size_t)DEPTH * 32 * 256 * 256 * 2);
constexpr size_t WS_WGLUT = al256(WS_WINT + (size_t)DEPTH * INW * D * 2);
constexpr size_t WS_WP5T  = al256(WS_WGLUT + (size_t)DEPTH * 512 * 512 * 2);
constexpr size_t WS_WPLT  = al256(WS_WP5T + (size_t)DEPTH * D * 512 * 2);
constexpr size_t WS_WOUTT = al256(WS_WPLT + (size_t)DEPTH * D * D * 2);
constexpr size_t WS_WUPT  = al256(WS_WOUTT + (size_t)DEPTH * D * D * 2);
constexpr size_t WS_WDNT  = al256(WS_WUPT + (size_t)DEPTH * NEXP * 2048 * D * 2);
constexpr size_t WS_X     = al256(WS_WDNT + (size_t)DEPTH * NEXP * D * D * 2);
constexpr size_t WS_HN    = al256(WS_X + (size_t)NTOK * D * 4);
constexpr size_t WS_A3    = al256(WS_HN + (size_t)NTOK * D * 2);
constexpr size_t WS_SB    = al256(WS_A3 + (size_t)NROW3 * 32 * 512 * 2);
constexpr size_t WS_XR    = al256(WS_SB + (size_t)NROW3 * 32 * 256 * 4);
constexpr size_t WS_GG    = al256(WS_XR + (size_t)NTOK * D * 2);
constexpr size_t WS_M5    = al256(WS_GG + (size_t)NTOK * D * 2);
constexpr size_t WS_ML    = al256(WS_M5 + (size_t)NTOK * D * 2);
constexpr size_t WS_HF    = al256(WS_ML + (size_t)NTOK * D * 2);
constexpr size_t WS_HB    = al256(WS_HF + (size_t)NTOK * D * 2);
constexpr size_t WS_OL    = al256(WS_HB + (size_t)NTOK * D * 2);
constexpr size_t WS_GY    = al256(WS_OL + (size_t)NTOK * D * 2);
constexpr size_t WS_O5    = al256(WS_GY + (size_t)NTOK * 512 * 2);
constexpr size_t WS_T1    = al256(WS_O5 + (size_t)NTOK * 512 * 2);
constexpr size_t WS_MG    = al256(WS_T1 + (size_t)NTOK * D * 2);
constexpr size_t WS_TOKE  = al256(WS_MG + (size_t)NTOK * D * 2);
constexpr size_t WS_TOKP  = al256(WS_TOKE + (size_t)NTOK * 4 * 4);
constexpr size_t WS_TOKW  = al256(WS_TOKP + (size_t)NTOK * 4 * 4);
constexpr size_t WS_SLOT  = al256(WS_TOKW + (size_t)NTOK * 4 * 4);
constexpr size_t WS_XS    = al256(WS_SLOT + (size_t)NTOK * 4 * 4);
constexpr size_t WS_ACT   = al256(WS_XS + (size_t)MAXSLOT * D * 2);
constexpr size_t WS_Y     = al256(WS_ACT + (size_t)MAXSLOT * D * 2);
constexpr size_t WS_END   = al256(WS_Y + (size_t)MAXSLOT * D * 2);

constexpr int LDS_BYTES = 147456;
constexpr int LDS_CTL = 143360;
constexpr int LC_MISC = LDS_CTL;
constexpr int LC_OFFS = LDS_CTL + 256;
constexpr int LC_LCNT = LDS_CTL + 512;
constexpr int LC_GB   = LDS_CTL + 768;
constexpr int LC_TILE = LDS_CTL + 1024;
constexpr int LC_PTRS = LDS_CTL + 2048;

struct Args { const float* in[36]; float* out; unsigned char* ws; int ph_lo, ph_hi; };

struct Ctx {
    float* out; unsigned char* ws; LAS unsigned char* lds; int tid, lane, wave, G;
    template <class T> __device__ __forceinline__ T* p(size_t off) const { return (T*)(ws + off); }
    __device__ __forceinline__ const float* in(int k) const { const LAS unsigned* t = (const LAS unsigned*)(lds + LC_PTRS) + 2 * k;
        const unsigned lo = __builtin_amdgcn_readfirstlane(t[0]), hi = __builtin_amdgcn_readfirstlane(t[1]); return (const float*)(((unsigned long long)hi << 32) | lo); }
};

struct SchedGrid {
    static constexpr bool GATHER = false, F8 = false; static constexpr int SCALE_A = 127 * 0x01010101, SCALE_B = 127 * 0x01010101, rowmax = 0; const __attribute__((address_space(1))) i32x4* rowtab4;
    pg8::StaticOrder so; unsigned atile, btile;
    __device__ __forceinline__ bool next(int i, Unit& u) const { int hs; if (!so.next(i, u.pm, u.pn, u.hu, hs)) return false; u.grp = 0; u.hoff = hs * 128; u.a = (unsigned)u.pm * atile + (unsigned)hs * (atile >> 1); u.b = (unsigned)u.pn * btile; return true; }
};
struct SchedS5 {
    static constexpr bool GATHER = false, F8 = false; static constexpr int SCALE_A = 127 * 0x01010101, SCALE_B = 127 * 0x01010101, rowmax = 0; const __attribute__((address_space(1))) i32x4* rowtab4; int G, c; unsigned bgrp;
    __device__ __forceinline__ bool next(int i, Unit& u) const { int L, hs; if (!pg8::tail_map((long)i * G + c, 288, G, L, u.hu, hs)) return false; const int xo = L >> 3, gl = (xo * 57) >> 9, pm = xo - gl * 9, g = gl * 8 + (L & 7);     u.pm = pm; u.pn = 0; u.grp = g; u.hoff = hs * 128;
        u.a = ((unsigned)g * (unsigned)NROW3 + (unsigned)(pm * 256 + hs * 128)) * 1024u; u.b = (unsigned)g * bgrp; return true; }
};
template <bool GA, bool F8_>
struct SchedMoe {
    int rowmax; static constexpr bool GATHER = GA, F8 = F8_; static constexpr int SCALE_A = (127 - pg8::ACT8_SHIFT) * 0x01010101, SCALE_B = (127 - pg8::W8_SHIFT) * 0x01010101;
    const __attribute__((address_space(1))) i32x4* rowtab4; pg8::StaticOrder so; unsigned atile, btile, bexp; const LAS unsigned char* tile_e;
    __device__ __forceinline__ bool next(int i, Unit& u) const { int hs; if (!so.next(i, u.pm, u.pn, u.hu, hs)) return false; u.grp = __builtin_amdgcn_readfirstlane((int)tile_e[u.pm]);     u.hoff = hs * 128; u.a = GA ? 0u : (unsigned)u.pm * atile + (unsigned)hs * (atile >> 1); u.b = (unsigned)u.grp * bexp + (unsigned)u.pn * btile; return true; }
};

#define EPI_ROWS_BEGIN  _Pragma("unroll") for (int ai = 0; ai < 2; ++ai) _Pragma("unroll") for (int m = 0; m < 4; ++m) { if (ai == 1 && u.hu) continue; const int row = u.pm * 256 + u.hoff + ai * 128 + wr * 64 + m * 16 + fr;
#define EPI_ROWS_END    asm volatile("" ::: "memory"); }
__device__ __forceinline__ u32x4 pack8(const f32x4 a, const f32x4 b) { u32x4 w; w.x = cvt_pk_bf16(a[0], a[1]); w.y = cvt_pk_bf16(a[2], a[3]); w.z = cvt_pk_bf16(b[0], b[1]); w.w = cvt_pk_bf16(b[2], b[3]); return w; }
__device__ __forceinline__ void unpack8(const u32x4 w, f32x4& a, f32x4& b) { a = (f32x4){bflo(w.x), bfhi(w.x), bflo(w.y), bfhi(w.y)}; b = (f32x4){bflo(w.z), bfhi(w.z), bflo(w.w), bfhi(w.w)}; }

struct EpiInProj {
    static constexpr bool PERM = true;
    bf16_t *A3, *XR, *GG, *M5, *ML;
    __device__ __forceinline__ void operator()(const f32x4 (&acc)[2][2][4][2], const Unit& u, int wr, int wc, int fr, int fq) const {
        const int pn = u.pn;
        EPI_ROWS_BEGIN
#pragma unroll
            for (int bj = 0; bj < 2; ++bj) {
                const int col = pn * 256 + bj * 128 + wc * 32 + 8 * fq; f32x4 v0 = acc[ai][bj][m][0], v1 = acc[ai][bj][m][1];
                if (pn < 2) {
                    int b, cidx, j; if (row < NLAT) { b = row >> 11; const int t = row & 2047; cidx = 16 + (t >> 4); j = t & 15; } else { const int rr = row - NLAT; b = rr >> 8; const int tc = rr & 255; cidx = tc >> 4; j = tc & 15; }
                    const int g = col >> 4, h = col & 15;
                    *(u32x4*)(A3 + ((size_t)g * NROW3 + (b * NCH + cidx)) * 512 + j * 16 + h) = pack8(v0, v1);
                } else if (pn < 6) {
                    *(u32x4*)(XR + (size_t)row * D + (col - 512)) = pack8(v0, v1);
                } else if (pn < 10) {
#pragma unroll
                    for (int q = 0; q < 4; ++q) { v0[q] = gelu_tanh(v0[q]); v1[q] = gelu_tanh(v1[q]); }
                    *(u32x4*)(GG + (size_t)row * D + (col - 1536)) = pack8(v0, v1);
                } else {
#pragma unroll
                    for (int q = 0; q < 4; ++q) { v0[q] = sigmoidf_(v0[q]); v1[q] = sigmoidf_(v1[q]); }
                    bf16_t* dst = pn < 14 ? M5 + (size_t)row * D + (col - 2560) : ML + (size_t)row * D + (col - 3584);
                    *(u32x4*)dst = pack8(v0, v1);
                }
            }
        EPI_ROWS_END
    }
};
struct EpiS5L1 {
    static constexpr bool PERM = false;
    float* S;
    __device__ __forceinline__ void operator()(const f32x4 (&acc)[2][2][4][2], const Unit& u, int wr, int wc, int fr, int fq) const {
        EPI_ROWS_BEGIN
            float* rowp = S + ((size_t)u.grp * NROW3 + row) * 256 + wc * 32 + 4 * fq;
#pragma unroll
            for (int bj = 0; bj < 2; ++bj)
#pragma unroll
                for (int n = 0; n < 2; ++n) *(f32x4*)(rowp + bj * 128 + n * 16) = acc[ai][bj][m][n];
        EPI_ROWS_END
    }
};
struct EpiS5Y {
    static constexpr bool PERM = true;
    bf16_t* GY;
    __device__ __forceinline__ void operator()(const f32x4 (&acc)[2][2][4][2], const Unit& u, int wr, int wc, int fr, int fq) const {
        EPI_ROWS_BEGIN
            const int b = row / NCH, cidx = row - b * NCH;
            const int tok0 = cidx < 16 ? NLAT + b * 256 + cidx * 16 : b * 2048 + (cidx - 16) * 16;
#pragma unroll
            for (int bj = 0; bj < 2; ++bj) {
                const int col = bj * 128 + wc * 32 + 8 * fq, j = col >> 4, h = col & 15; f32x4 v0 = acc[ai][bj][m][0], v1 = acc[ai][bj][m][1];
#pragma unroll
                for (int q = 0; q < 4; ++q) { v0[q] = gelu_tanh(v0[q]); v1[q] = gelu_tanh(v1[q]); }
                *(u32x4*)(GY + (size_t)(tok0 + j) * 512 + u.grp * 16 + h) = pack8(v0, v1);
            }
        EPI_ROWS_END
    }
};
#define GAS __attribute__((address_space(1)))
struct EpiGlu {
    static constexpr bool PERM = true;
    const bf16_t* GY; bf16_t* O5; const float* bias;
    __device__ __forceinline__ void operator()(const f32x4 (&acc)[2][2][4][2], const Unit& u, int wr, int wc, int fr, int fq) const {
        const int col0 = u.pn * 256 + wc * 32 + 8 * fq;
        f32x4 bb[2][2];
#pragma unroll
        for (int bj = 0; bj < 2; ++bj) { bb[bj][0] = *(const GAS f32x4*)(bias + col0 + bj * 128); bb[bj][1] = *(const GAS f32x4*)(bias + col0 + bj * 128 + 4); }
#pragma unroll
        for (int ai = 0; ai < 2; ++ai) {
            if (ai == 1 && u.hu) break;
            const size_t r0 = (size_t)(u.pm * 256 + u.hoff + ai * 128 + wr * 64 + fr) * 512 + col0;
            u32x4 gy[4][2];
#pragma unroll
            for (int m = 0; m < 4; ++m)
#pragma unroll
                for (int bj = 0; bj < 2; ++bj) gy[m][bj] = *(const GAS u32x4*)(GY + r0 + (size_t)m * 16 * 512 + bj * 128);
#pragma unroll
            for (int m = 0; m < 4; ++m)
#pragma unroll
                for (int bj = 0; bj < 2; ++bj) { f32x4 v0 = acc[ai][bj][m][0], v1 = acc[ai][bj][m][1], g0, g1; unpack8(gy[m][bj], g0, g1);
#pragma unroll
                    for (int q = 0; q < 4; ++q) { v0[q] = g0[q] * sigmoidf_(v0[q] + bb[bj][0][q]); v1[q] = g1[q] * sigmoidf_(v1[q] + bb[bj][1][q]); }
                    *(GAS u32x4*)(O5 + r0 + (size_t)m * 16 * 512 + bj * 128) = pack8(v0, v1); }
            asm volatile("" ::: "memory");
        }
    }
};
struct EpiMulGate {
    static constexpr bool PERM = true;
    const bf16_t* GATE; const bf16_t* ADD; bf16_t* O;
    __device__ __forceinline__ void operator()(const f32x4 (&acc)[2][2][4][2], const Unit& u, int wr, int wc, int fr, int fq) const {
#pragma unroll
        for (int ai = 0; ai < 2; ++ai) {
            if (ai == 1 && u.hu) break;
            const size_t r0 = (size_t)(u.pm * 256 + u.hoff + ai * 128 + wr * 64 + fr) * D + u.pn * 256 + wc * 32 + 8 * fq;
            u32x4 gt[4][2], ad[4][2];
#pragma unroll
            for (int m = 0; m < 4; ++m)
#pragma unroll
                for (int bj = 0; bj < 2; ++bj) { gt[m][bj] = *(const GAS u32x4*)(GATE + r0 + (size_t)m * 16 * D + bj * 128); if (ADD) ad[m][bj] = *(const GAS u32x4*)(ADD + r0 + (size_t)m * 16 * D + bj * 128); }
#pragma unroll
            for (int m = 0; m < 4; ++m)
#pragma unroll
                for (int bj = 0; bj < 2; ++bj) { f32x4 v0 = acc[ai][bj][m][0], v1 = acc[ai][bj][m][1], g0, g1; unpack8(gt[m][bj], g0, g1); v0 = v0 * g0; v1 = v1 * g1;
                    if (ADD) { f32x4 a0, a1; unpack8(ad[m][bj], a0, a1); v0 = v0 + a0; v1 = v1 + a1; }
                    *(GAS u32x4*)(O + r0 + (size_t)m * 16 * D + bj * 128) = pack8(v0, v1); }
            asm volatile("" ::: "memory");
        }
    }
};
struct EpiOut {
    static constexpr bool PERM = true;
    const float* xlat; const float* xctx; bf16_t* X; const float* ada; int l;
    __device__ __forceinline__ void operator()(const f32x4 (&acc)[2][2][4][2], const Unit& u, int wr, int wc, int fr, int fq) const {
        const int bsel = u.pm < 128 ? (u.pm >> 3) : 16;
        const float* gate = ada + ((size_t)(l * 17 + bsel) * 6 + 2) * D;
        const int col0 = u.pn * 256 + wc * 32 + 8 * fq;
        f32x4 gv[2][2];
#pragma unroll
        for (int bj = 0; bj < 2; ++bj)
#pragma unroll
            for (int n = 0; n < 2; ++n) gv[bj][n] = *(const GAS f32x4*)(gate + col0 + bj * 128 + n * 4);
        const float* srcb = u.pm < 128 ? xlat + (size_t)u.pm * 256 * D : xctx + (size_t)(u.pm - 128) * 256 * D;
        bf16_t* xb = X + (size_t)u.pm * 256 * D;
#pragma unroll
        for (int ai = 0; ai < 2; ++ai) {
            if (ai == 1 && u.hu) break;
            const size_t rr = (size_t)(u.hoff + ai * 128 + wr * 64 + fr) * D + col0;
            f32x4 xs[4][2][2];
            if (l == 0) {
#pragma unroll
                for (int m = 0; m < 4; ++m)
#pragma unroll
                    for (int bj = 0; bj < 2; ++bj)
#pragma unroll
                        for (int n = 0; n < 2; ++n) xs[m][bj][n] = *(const GAS f32x4*)(srcb + rr + (size_t)m * 16 * D + bj * 128 + n * 4);
            } else {
                u32x4 xr[4][2];
#pragma unroll
                for (int m = 0; m < 4; ++m)
#pragma unroll
                    for (int bj = 0; bj < 2; ++bj) xr[m][bj] = *(const GAS u32x4*)(xb + rr + (size_t)m * 16 * D + bj * 128);
#pragma unroll
                for (int m = 0; m < 4; ++m)
#pragma unroll
                    for (int bj = 0; bj < 2; ++bj) unpack8(xr[m][bj], xs[m][bj][0], xs[m][bj][1]);
            }
#pragma unroll
            for (int m = 0; m < 4; ++m)
#pragma unroll
                for (int bj = 0; bj < 2; ++bj)
                    *(GAS u32x4*)(xb + rr + (size_t)m * 16 * D + bj * 128) = pack8(xs[m][bj][0] + gv[bj][0] * acc[ai][bj][m][0], xs[m][bj][1] + gv[bj][1] * acc[ai][bj][m][1]);
            asm volatile("" ::: "memory");
        }
    }
};
struct EpiUp {
    static constexpr bool PERM = true;
    bf16_t* ACT; const float* bup;
    __device__ __forceinline__ void operator()(const f32x4 (&acc)[2][2][4][2], const Unit& u, int wr, int wc, int fr, int fq) const {
        const int a0 = u.pn * 128 + wc * 32 + 8 * fq;
        const float* bp = bup + (size_t)u.grp * 2048 + 2 * a0;
        constexpr float SC = (float)(1 << pg8::ACT8_SHIFT);
        float bg[8], bu4[8];
#pragma unroll
        for (int q = 0; q < 4; ++q) { const f32x4 t = *(const GAS f32x4*)(bp + 4 * q); bg[2 * q] = t[0]; bu4[2 * q] = SC * t[1] + SC; bg[2 * q + 1] = t[2]; bu4[2 * q + 1] = SC * t[3] + SC; }
        EPI_ROWS_BEGIN
            float o[8];
#pragma unroll
            for (int q = 0; q < 8; ++q) {
                const float gt = fminf(acc[ai][0][m][q >> 2][q & 3] + bg[q], 7.0f);
                const float u4 = __builtin_amdgcn_fmed3f(fmaf(acc[ai][1][m][q >> 2][q & 3], SC, bu4[q]), -6.0f * SC, 8.0f * SC);
                const float e = __builtin_amdgcn_exp2f(gt * (-1.702f * 1.4426950409f));
                o[q] = (gt * __builtin_amdgcn_rcpf(1.0f + e)) * u4;
            }
            int p0 = 0, p1 = 0;
            p0 = __builtin_amdgcn_cvt_pk_fp8_f32(o[0], o[1], p0, false); p0 = __builtin_amdgcn_cvt_pk_fp8_f32(o[2], o[3], p0, true);
            p1 = __builtin_amdgcn_cvt_pk_fp8_f32(o[4], o[5], p1, false); p1 = __builtin_amdgcn_cvt_pk_fp8_f32(o[6], o[7], p1, true);
            *(GAS u32x2*)((unsigned char*)ACT + (size_t)row * D + a0) = (u32x2){(unsigned)p0, (unsigned)p1};
        EPI_ROWS_END
    }
};
struct EpiDown {
    static constexpr bool PERM = true;
    bf16_t* Y; const float* bdn; const int* TS;
    __device__ __forceinline__ void operator()(const f32x4 (&acc)[2][2][4][2], const Unit& u, int wr, int wc, int fr, int fq) const {
        int dst[2][4];
#pragma unroll
        for (int ai = 0; ai < 2; ++ai)
#pragma unroll
            for (int m = 0; m < 4; ++m) dst[ai][m] = (ai == 1 && u.hu) ? -1 : TS[u.pm * 256 + u.hoff + ai * 128 + wr * 64 + m * 16 + fr];
#pragma unroll
        for (int bj = 0; bj < 2; ++bj) {
            const int col = u.pn * 256 + bj * 128 + wc * 32 + 8 * fq;
            const f32x4 b0 = *(const f32x4*)(bdn + (size_t)u.grp * D + col), b1 = *(const f32x4*)(bdn + (size_t)u.grp * D + col + 4);
#pragma unroll
            for (int ai = 0; ai < 2; ++ai)
#pragma unroll
                for (int m = 0; m < 4; ++m) if (dst[ai][m] >= 0) { f32x4 v0 = (acc[ai][bj][m][0] + b0) * 4.0f, v1 = (acc[ai][bj][m][1] + b1) * 4.0f; int p0 = 0, p1 = 0;
#pragma unroll
                    for (int q = 0; q < 4; ++q) { v0[q] = __builtin_amdgcn_fmed3f(v0[q], -448.0f, 448.0f); v1[q] = __builtin_amdgcn_fmed3f(v1[q], -448.0f, 448.0f); }
                    p0 = __builtin_amdgcn_cvt_pk_fp8_f32(v0[0], v0[1], p0, false); p0 = __builtin_amdgcn_cvt_pk_fp8_f32(v0[2], v0[3], p0, true); p1 = __builtin_amdgcn_cvt_pk_fp8_f32(v1[0], v1[1], p1, false); p1 = __builtin_amdgcn_cvt_pk_fp8_f32(v1[2], v1[3], p1, true);
                    *(u32x2*)((unsigned char*)Y + (size_t)dst[ai][m] * D + col) = (u32x2){(unsigned)p0, (unsigned)p1}; }
            asm volatile("" ::: "memory");
        }
    }
};

struct TItem { const float* W; unsigned char* WT; int K, N, k0, n0, kind; };
__device__ __forceinline__ TItem titem_decode(const Ctx& C, int it) {
    constexpr int I_IN = 16 * 72, I_GLU = 8 * 8, I_P5 = 8 * 16, I_PL = 16 * 16, I_OUT = 16 * 16, I_UP1 = 16 * 32, I_UP = 32 * I_UP1, I_DN1 = 16 * 16, I_DN = 32 * I_DN1;
    constexpr int PER_L = I_IN + I_GLU + I_P5 + I_PL + I_OUT + I_UP + I_DN;
    TItem t; const int l = it / PER_L; int r = it - l * PER_L, item;
    if (r < I_IN) { t.W = C.in(8) + (size_t)l * D * INW; t.K = D; t.N = INW; t.WT = C.p<unsigned char>(WS_WINT) + (size_t)l * INW * D * 2; t.kind = 0; item = r; }
    else if ((r -= I_IN) < I_GLU) { t.W = C.in(17) + (size_t)l * 512 * 512; t.K = 512; t.N = 512; t.WT = C.p<unsigned char>(WS_WGLUT) + (size_t)l * 512 * 512 * 2; t.kind = 0; item = r; }
    else if ((r -= I_GLU) < I_P5) { t.W = C.in(26) + (size_t)l * 512 * D; t.K = 512; t.N = D; t.WT = C.p<unsigned char>(WS_WP5T) + (size_t)l * D * 512 * 2; t.kind = 0; item = r; }
    else if ((r -= I_P5) < I_PL) { t.W = C.in(27) + (size_t)l * D * D; t.K = D; t.N = D; t.WT = C.p<unsigned char>(WS_WPLT) + (size_t)l * D * D * 2; t.kind = 0; item = r; }
    else if ((r -= I_PL) < I_OUT) { t.W = C.in(28) + (size_t)l * D * D; t.K = D; t.N = D; t.WT = C.p<unsigned char>(WS_WOUTT) + (size_t)l * D * D * 2; t.kind = 0; item = r; }
    else if ((r -= I_OUT) < I_UP) { const int e = r / I_UP1; t.W = C.in(31) + ((size_t)l * NEXP + e) * D * 2048; t.K = D; t.N = 2048; t.WT = C.p<unsigned char>(WS_WUPT) + ((size_t)l * NEXP + e) * 2048 * D; t.kind = 2; item = r - e * I_UP1; }
    else { r -= I_UP; const int e = r / I_DN1; t.W = C.in(33) + ((size_t)l * NEXP + e) * D * D; t.K = D; t.N = D; t.WT = C.p<unsigned char>(WS_WDNT) + ((size_t)l * NEXP + e) * D * D; t.kind = 1; item = r - e * I_DN1; }
    const int nblk = t.N / 64, kb = item / nblk; t.k0 = 64 * kb; t.n0 = 64 * (item - kb * nblk); return t;
}
__device__ __forceinline__ void titem_load(const TItem& t, int lane, f32x4 (&v)[16]) {
    const int r = lane >> 4, c4 = lane & 15;
#pragma unroll
    for (int i = 0; i < 16; ++i) v[i] = *(const f32x4*)(t.W + (size_t)(t.k0 + 4 * i + r) * t.N + t.n0 + 4 * c4);
}
__device__ __forceinline__ void titem_to_lds(const f32x4 (&v)[16], LAS float* scr, int lane) {
    const int r = lane >> 4, c4 = lane & 15;
#pragma unroll
    for (int i = 0; i < 16; ++i) { LAS float* d = scr + (4 * i + r) * 65 + 4 * c4; d[0] = v[i][0]; d[1] = v[i][1]; d[2] = v[i][2]; d[3] = v[i][3]; }
    asm volatile("s_waitcnt lgkmcnt(0)" ::: "memory");
}
__device__ __forceinline__ void titem_store(const TItem& t, const LAS float* scr, int lane) {
    const int c = lane & 7, nn = lane >> 3;
#pragma unroll
    for (int j = 0; j < 8; ++j) { const int n = nn + 8 * j; const LAS float* sp = scr + (8 * c) * 65 + n;
        int orow = t.n0 + n;
        if (t.kind == 2) { const int a = orow >> 1, sft = orow & 1; orow = (a >> 7) * 256 + sft * 128 + (a & 127); }
        if (t.kind != 0) {
            const float sc = (float)(1 << pg8::W8_SHIFT); int p0 = 0, p1 = 0;
            p0 = __builtin_amdgcn_cvt_pk_fp8_f32(sp[0 * 65] * sc, sp[1 * 65] * sc, p0, false); p0 = __builtin_amdgcn_cvt_pk_fp8_f32(sp[2 * 65] * sc, sp[3 * 65] * sc, p0, true);
            p1 = __builtin_amdgcn_cvt_pk_fp8_f32(sp[4 * 65] * sc, sp[5 * 65] * sc, p1, false); p1 = __builtin_amdgcn_cvt_pk_fp8_f32(sp[6 * 65] * sc, sp[7 * 65] * sc, p1, true);
            *(u32x2*)(t.WT + (size_t)orow * t.K + t.k0 + 8 * c) = (u32x2){(unsigned)p0, (unsigned)p1}; }
        else { u32x4 o; o.x = cvt_pk_bf16(sp[0 * 65], sp[1 * 65]); o.y = cvt_pk_bf16(sp[2 * 65], sp[3 * 65]); o.z = cvt_pk_bf16(sp[4 * 65], sp[5 * 65]); o.w = cvt_pk_bf16(sp[6 * 65], sp[7 * 65]);
            *(u32x4*)(t.WT + ((size_t)orow * t.K + t.k0 + 8 * c) * 2) = o; } }
    asm volatile("s_waitcnt lgkmcnt(0)" ::: "memory");
}
__device__ __forceinline__ void phase_transposes(const Ctx& C) {
    LAS float* scr = (LAS float*)(C.lds + C.wave * 17408);
    constexpr int NITEMS = DEPTH * (16 * 72 + 8 * 8 + 8 * 16 + 16 * 16 + 16 * 16 + 32 * 16 * 32 + 32 * 16 * 16), CHUNK = 16;
    static_assert(NITEMS % CHUNK == 0, "items per chunk");
    unsigned* q = C.p<unsigned>(WS_CTL) + CW_QUEUE;
    for (;;) {
        unsigned base = 0; if (C.lane == 0) base = __hip_atomic_fetch_add(q, (unsigned)CHUNK, __ATOMIC_RELAXED, __HIP_MEMORY_SCOPE_AGENT);
        base = (unsigned)__builtin_amdgcn_readfirstlane((int)base); if (base >= (unsigned)NITEMS) break;
        f32x4 va[16]; TItem ta = titem_decode(C, (int)base); titem_load(ta, C.lane, va);
#pragma unroll 1
        for (int i = 0; i < CHUNK; ++i) {
            titem_to_lds(va, scr, C.lane);
            const TItem tcur = ta;
            if (i + 1 < CHUNK) { ta = titem_decode(C, (int)base + i + 1); titem_load(ta, C.lane, va); }
            titem_store(tcur, scr, C.lane);
        }
    }
}

__device__ __forceinline__ void phase_s5prep(const Ctx& C) {
    LAS float* PW = (LAS float*)(C.lds);
    LAS float* BB = (LAS float*)(C.lds + 17408);
    LAS float* CC = (LAS float*)(C.lds + 17408 + 16384);
    LAS float* KT = (LAS float*)(C.lds + 17408 + 32768);
    const int tid = C.tid;
    for (int item = blockIdx.x; item < DEPTH * 32; item += C.G) {
        const int l = item >> 5, g = item & 31;
        __syncthreads();
        if (tid < 128) {
            const int dr = tid >> 6, p = tid & 63; const size_t ix = ((size_t)(l * 2 + dr) * 32 + g) * 64 + p;
            const double lr = (double)C.in(9)[ix], li = (double)C.in(10)[ix], dt = exp((double)C.in(11)[(l * 2 + dr) * 32 + g]);
            for (int k = 0; k <= 16; ++k) { const double mag = exp(lr * dt * k), ang = li * dt * k; PW[((dr * 17 + k) * 64 + p) * 2] = (float)(mag * cos(ang)); PW[((dr * 17 + k) * 64 + p) * 2 + 1] = (float)(mag * sin(ang)); }
            const double m1 = exp(lr * dt), abr = m1 * cos(li * dt), abi = m1 * sin(li * dt), den = lr * lr + li * li, zr = abr - 1.0;
            const double qr = (zr * lr + abi * li) / den, qi = (abi * lr - zr * li) / den;
            for (int h = 0; h < 16; ++h) { const double br = (double)C.in(12)[ix * 16 + h], bi = (double)C.in(13)[ix * 16 + h];
                BB[((dr * 64 + p) * 16 + h) * 2] = (float)(qr * br - qi * bi); BB[((dr * 64 + p) * 16 + h) * 2 + 1] = (float)(qr * bi + qi * br); }
            float* dec = C.p<float>(WS_DEC) + ix * 2; const double m16 = exp(lr * dt * 16), a16 = li * dt * 16; dec[0] = (float)(m16 * cos(a16)); dec[1] = (float)(m16 * sin(a16));
        }
        for (int e = tid; e < 2 * 16 * 64; e += 512) { const int dr = e >> 10, h = (e >> 6) & 15, p = e & 63; const size_t ix = (((size_t)(l * 2 + dr) * 32 + g) * 16 + h) * 64 + p;
            CC[e * 2] = C.in(14)[ix]; CC[e * 2 + 1] = C.in(15)[ix]; }
        __syncthreads();
        for (int e = tid; e < 8192; e += 512) { const int dr = e >> 12, tau = (e >> 8) & 15, i = (e >> 4) & 15, ip = e & 15; float s = 0.f;
            for (int p = 0; p < 64; ++p) { const float cr = CC[((dr * 16 + i) * 64 + p) * 2], ci = CC[((dr * 16 + i) * 64 + p) * 2 + 1], pr = PW[((dr * 17 + tau) * 64 + p) * 2], pi = PW[((dr * 17 + tau) * 64 + p) * 2 + 1];
                const float xr = cr * pr - ci * pi, xi = cr * pi + ci * pr; s += xr * BB[((dr * 64 + p) * 16 + ip) * 2] - xi * BB[((dr * 64 + p) * 16 + ip) * 2 + 1]; }
            KT[e] = s; }
        __syncthreads();
        bf16_t* W3 = C.p<bf16_t>(WS_W3T) + (size_t)item * 256 * 512; bf16_t* FT = C.p<bf16_t>(WS_FT) + (size_t)item * 256 * 256;
        const float* dvec = C.in(16) + (size_t)l * 512 + g * 16;
        for (int e2 = tid; e2 < 256 * 256; e2 += 512) {
            const int row = e2 >> 8, col0 = (e2 & 255) * 2, j = row >> 4, i = row & 15; float v[2];
#pragma unroll
            for (int q = 0; q < 2; ++q) { const int col = col0 + q;
                if (col < 256) { const int jp = col >> 4, ip = col & 15; float s = 0.f; if (j >= jp) s += KT[((0 * 16 + (j - jp)) * 16 + i) * 16 + ip]; if (jp >= j) s += KT[((1 * 16 + (jp - j)) * 16 + i) * 16 + ip]; if (row == col) s += dvec[i]; v[q] = s; }
                else { const int cc = col - 256, dr = cc >> 7, isim = (cc >> 6) & 1, p = cc & 63, pw = dr ? 16 - j : j + 1;
                    const float cr = CC[((dr * 16 + i) * 64 + p) * 2], ci = CC[((dr * 16 + i) * 64 + p) * 2 + 1], pr = PW[((dr * 17 + pw) * 64 + p) * 2], pi = PW[((dr * 17 + pw) * 64 + p) * 2 + 1];
                    v[q] = isim ? -(cr * pi + ci * pr) : (cr * pr - ci * pi); } }
            *(unsigned*)(W3 + (size_t)row * 512 + col0) = cvt_pk_bf16(v[0], v[1]);
        }
        for (int e2 = tid; e2 < 256 * 128; e2 += 512) {
            const int n = e2 >> 7, col0 = (e2 & 127) * 2, blk = n >> 6, p = n & 63, dr = blk >> 1; float v[2];
#pragma unroll
            for (int q = 0; q < 2; ++q) { const int col = col0 + q, jp = col >> 4, ip = col & 15, pw = dr ? jp : 15 - jp;
                const float pr = PW[((dr * 17 + pw) * 64 + p) * 2], pi = PW[((dr * 17 + pw) * 64 + p) * 2 + 1], br = BB[((dr * 64 + p) * 16 + ip) * 2], bi = BB[((dr * 64 + p) * 16 + ip) * 2 + 1];
                v[q] = (blk & 1) ? (pr * bi + pi * br) : (pr * br - pi * bi); }
            *(unsigned*)(FT + (size_t)n * 256 + col0) = cvt_pk_bf16(v[0], v[1]);
        }
    }
    __syncthreads();
}

__device__ __forceinline__ void phase_ada(const Ctx& C) {
    LAS float* cond = (LAS float*)(C.lds);
    LAS float* red = (LAS float*)(C.lds + 17 * 1024 * 4);
    const int tid = C.tid;
    for (int e = tid; e < 17 * 1024; e += 512) { const float v = e < 16 * 1024 ? C.in(1)[e] : C.in(3)[e - 16 * 1024]; cond[e] = v * sigmoidf_(v); }
    __syncthreads();
    const int c = tid & 63, ks = tid >> 6;
    for (int item = C.G - 1 - (int)blockIdx.x; item < DEPTH * 96; item += C.G) {
        const int l = item / 96, cb = item - l * 96, col = cb * 64 + c;
        const float* W = C.in(4) + (size_t)l * D * 6144 + col;
        float acc[17];
#pragma unroll
        for (int r = 0; r < 17; ++r) acc[r] = 0.f;
        for (int k = ks * 128; k < ks * 128 + 128; k += 4) {
            const float w0 = W[(size_t)k * 6144], w1 = W[(size_t)(k + 1) * 6144], w2 = W[(size_t)(k + 2) * 6144], w3 = W[(size_t)(k + 3) * 6144];
#pragma unroll
            for (int r = 0; r < 17; ++r) { const f32x4 cv = *(const LAS f32x4*)(cond + r * 1024 + k); acc[r] += cv[0] * w0 + cv[1] * w1 + cv[2] * w2 + cv[3] * w3; }
        }
#pragma unroll
        for (int r = 0; r < 17; ++r) red[(ks * 17 + r) * 64 + c] = acc[r];
        __syncthreads();
        for (int e = tid; e < 17 * 64; e += 512) { const int r = e >> 6, cc = e & 63; float s = 0.f;
#pragma unroll
            for (int q = 0; q < 8; ++q) s += red[(q * 17 + r) * 64 + cc];
            C.p<float>(WS_ADA)[(size_t)(l * 17 + r) * 6144 + cb * 64 + cc] = s + C.in(5)[(size_t)l * 6144 + cb * 64 + cc]; }
        __syncthreads();
    }
}

__device__ __forceinline__ void load_row(const Ctx& C, bool from_input, int m, bool combine, int lc  , f32x4 (&v)[4]) {
    if (from_input) { const float* src = m < NLAT ? C.in(0) + (size_t)m * D : C.in(2) + (size_t)(m - NLAT) * D;
#pragma unroll
        for (int j = 0; j < 4; ++j) v[j] = *(const f32x4*)(src + 4 * C.lane + 256 * j); }
    else { const bf16_t* src = C.p<bf16_t>(WS_X) + (size_t)m * D;
#pragma unroll
        for (int j = 0; j < 4; ++j) { const u32x2 t = *(const u32x2*)(src + 4 * C.lane + 256 * j); v[j] = (f32x4){bflo(t.x), bfhi(t.x), bflo(t.y), bfhi(t.y)}; } }
    if (combine) {
        const int bsel = m < NLAT ? (m >> 11) : 16;
        const float* g2 = C.p<float>(WS_ADA) + ((size_t)(lc * 17 + bsel) * 6 + 5) * D;
        f32x4 s[4];
#pragma unroll
        for (int j = 0; j < 4; ++j) s[j] = (f32x4){0.f, 0.f, 0.f, 0.f};
#pragma unroll
        for (int k = 0; k < 4; ++k) {
            const float w = C.p<float>(WS_TOKW)[m * 4 + k] * (1.0f / 4.0f);
            const unsigned char* y = C.p<unsigned char>(WS_Y) + (size_t)(m * 4 + k) * D;
#pragma unroll
            for (int j = 0; j < 4; ++j) { const int t = *(const int*)(y + 4 * C.lane + 256 * j); const f32x2 lo = __builtin_amdgcn_cvt_pk_f32_fp8(t, false), hi = __builtin_amdgcn_cvt_pk_f32_fp8(t, true); s[j] += w * (f32x4){lo.x, lo.y, hi.x, hi.y}; }
        }
#pragma unroll
        for (int j = 0; j < 4; ++j) v[j] += *(const f32x4*)(g2 + 4 * C.lane + 256 * j) * s[j];
    }
}
__device__ __forceinline__ float row_rstd(const f32x4 (&v)[4], int lane) {
    float s = 0.f;
#pragma unroll
    for (int j = 0; j < 4; ++j) s += (v[j][0] * v[j][0] + v[j][1] * v[j][1]) + (v[j][2] * v[j][2] + v[j][3] * v[j][3]);
    return rsqrtf(wave_sum(s, lane) * (1.0f / D) + 1e-6f);
}
__device__ __forceinline__ void norm_mod(const Ctx& C, f32x4 (&v)[4], const float* gain, const float* shift, const float* scale) {
    const float rstd = row_rstd(v, C.lane);
#pragma unroll
    for (int j = 0; j < 4; ++j) { const int c = 4 * C.lane + 256 * j; const f32x4 gn = *(const f32x4*)(gain + c), sh = *(const f32x4*)(shift + c), sc = *(const f32x4*)(scale + c);
        v[j] = (v[j] * rstd * gn) * (sc + 1.0f) + sh; }
}
constexpr int Y8_SHIFT = 2;
__device__ __forceinline__ void unpack8_fp8(const u32x2 w, f32x4& a, f32x4& b) {
    const f32x2 a0 = __builtin_amdgcn_cvt_pk_f32_fp8((int)w.x, false), a1 = __builtin_amdgcn_cvt_pk_f32_fp8((int)w.x, true), b0 = __builtin_amdgcn_cvt_pk_f32_fp8((int)w.y, false), b1 = __builtin_amdgcn_cvt_pk_f32_fp8((int)w.y, true);
    a = (f32x4){a0.x, a0.y, a1.x, a1.y}; b = (f32x4){b0.x, b0.y, b1.x, b1.y}; }
struct RowV { f32x4 a[4]; };
__device__ __forceinline__ void n1_vec(const float* p, int lane, f32x4 (&o)[4]) { const GAS f32x4* q = (const GAS f32x4*)(p + 8 * lane); o[0] = q[0]; o[1] = q[1]; o[2] = q[128]; o[3] = q[129]; }
__device__ __forceinline__ void phase_norm1(const Ctx& C, int l) {
    const int gw = blockIdx.x * 8 + C.wave, NGW = C.G * 8, lane = C.lane;
    const int per = (NTOK + NGW - 1) / NGW, mb = gw * per, me = min(mb + per, NTOK);
    f32x4 gain[4], sh[4], sc[4], g2[4]; int cur_b = -1;
    n1_vec(C.in(6) + (size_t)l * D, lane, gain);
    const bool comb = l > 0;
    for (int m0 = mb; m0 < me; m0 += 2) {
        const bool has1 = m0 + 1 < me; const int m1 = has1 ? m0 + 1 : m0;
        RowV x[2]; u32x2 y[2][4][2]; f32x4 w[2];
#pragma unroll
        for (int r = 0; r < 2; ++r) { const int m = r ? m1 : m0;
            if (l == 0) { const float* src = m < NLAT ? C.in(0) + (size_t)m * D : C.in(2) + (size_t)(m - NLAT) * D; n1_vec(src, lane, x[r].a); }
            else { const GAS u32x4* q = (const GAS u32x4*)(C.p<bf16_t>(WS_X) + (size_t)m * D + 8 * lane); const u32x4 t0 = q[0], t1 = q[64]; unpack8(t0, x[r].a[0], x[r].a[1]); unpack8(t1, x[r].a[2], x[r].a[3]); }
            if (comb) { w[r] = *(const GAS f32x4*)(C.p<float>(WS_TOKW) + (size_t)m * 4);
#pragma unroll
                for (int k = 0; k < 4; ++k) { const GAS u32x2* q = (const GAS u32x2*)(C.p<unsigned char>(WS_Y) + (size_t)(m * 4 + k) * D + 8 * lane); y[r][k][0] = q[0]; y[r][k][1] = q[64]; } }
        }
#pragma unroll
        for (int r = 0; r < 2; ++r) { const int m = r ? m1 : m0; if (r == 1 && !has1) break;
            const int bsel = m < NLAT ? (m >> 11) : 16;
            if (bsel != cur_b) { cur_b = bsel; const float* ada = C.p<float>(WS_ADA) + (size_t)(l * 17 + bsel) * 6 * D; n1_vec(ada, lane, sh); n1_vec(ada + D, lane, sc);
                if (comb) n1_vec(C.p<float>(WS_ADA) + ((size_t)((l - 1) * 17 + bsel) * 6 + 5) * D, lane, g2); }
            if (comb) {
                f32x4 s4[4];
#pragma unroll
                for (int q = 0; q < 4; ++q) s4[q] = (f32x4){0.f, 0.f, 0.f, 0.f};
#pragma unroll
                for (int k = 0; k < 4; ++k) { f32x4 t0, t1, t2, t3; unpack8_fp8(y[r][k][0], t0, t1); unpack8_fp8(y[r][k][1], t2, t3); const float wk = w[r][k] * (1.0f / (float)(1 << Y8_SHIFT)); s4[0] += wk * t0; s4[1] += wk * t1; s4[2] += wk * t2; s4[3] += wk * t3; }
#pragma unroll
                for (int q = 0; q < 4; ++q) x[r].a[q] += g2[q] * s4[q];
                GAS u32x4* xo = (GAS u32x4*)(C.p<bf16_t>(WS_X) + (size_t)m * D + 8 * lane); xo[0] = pack8(x[r].a[0], x[r].a[1]); xo[64] = pack8(x[r].a[2], x[r].a[3]);
            }
            float ss = 0.f;
#pragma unroll
            for (int q = 0; q < 4; ++q) ss += (x[r].a[q][0] * x[r].a[q][0] + x[r].a[q][1] * x[r].a[q][1]) + (x[r].a[q][2] * x[r].a[q][2] + x[r].a[q][3] * x[r].a[q][3]);
            const float rstd = rsqrtf(wave_sum(ss, lane) * (1.0f / D) + 1e-6f);
            f32x4 h[4];
#pragma unroll
            for (int q = 0; q < 4; ++q) h[q] = (x[r].a[q] * rstd * gain[q]) * (sc[q] + 1.0f) + sh[q];
            GAS u32x4* ho = (GAS u32x4*)(C.p<bf16_t>(WS_HN) + (size_t)m * D + 8 * lane); ho[0] = pack8(h[0], h[1]); ho[64] = pack8(h[2], h[3]);
        }
    }
}
__device__ __forceinline__ void split_bf16(const f32x4 a, const f32x4 b, bf16x8& hi, bf16x8& lo) {
    u32x4 h = pack8(a, b); f32x4 ha, hb; unpack8(h, ha, hb); u32x4 lw = pack8(a - ha, b - hb); hi = __builtin_bit_cast(bf16x8, h); lo = __builtin_bit_cast(bf16x8, lw);
}
__device__ __forceinline__ void phase_norm2(const Ctx& C, int l, int ntok) {
    LAS float* T = (LAS float*)C.lds;
    LAS float* LG = (LAS float*)(C.lds + 131584);
    LAS int* lcnt = (LAS int*)(C.lds + LC_LCNT); LAS int* gb = (LAS int*)(C.lds + LC_GB);
    unsigned* CNT = C.p<unsigned>(WS_CTL) + CW_CNT + l * 32;
    const float* wr = C.in(29) + (size_t)l * D * 32; const float* br = C.in(30) + l * 32;
    const int tid = C.tid, lane = C.lane, w = C.wave;
    bf16x8 bhi[4][2], blo[4][2];
#pragma unroll
    for (int s = 0; s < 4; ++s)
#pragma unroll
        for (int nt = 0; nt < 2; ++nt) { const int k = 128 * w + 32 * s + 8 * (lane >> 4), e = 16 * nt + (lane & 15); f32x4 a, b;
#pragma unroll
            for (int j = 0; j < 4; ++j) { a[j] = wr[(size_t)(k + j) * 32 + e]; b[j] = wr[(size_t)(k + 4 + j) * 32 + e]; }
            split_bf16(a, b, bhi[s][nt], blo[s][nt]); }
    const float brc = br[tid & 31];
    const int nblk = ntok / 32;
    int blk = blockIdx.x;
    u32x2 raw[4][4];
    if (blk < nblk) {
#pragma unroll
        for (int rr = 0; rr < 4; ++rr) { const bf16_t* src = C.p<bf16_t>(WS_X) + (size_t)(blk * 32 + w * 4 + rr) * D;
#pragma unroll
            for (int j = 0; j < 4; ++j) raw[rr][j] = *(const u32x2*)(src + 4 * lane + 256 * j); }
    }
    int pte[4] = {0, 0, 0, 0}, ptp[4] = {0, 0, 0, 0}, pm = -1; int gbv = 0;
    for (; blk < nblk; blk += C.G) {
        {
            const int mb = blk * 32 + w * 4, nb = blk + C.G;
            const int bsel = mb < NLAT ? (mb >> 11) : 16; const float* ada = C.p<float>(WS_ADA) + (size_t)(l * 17 + bsel) * 6 * D; const float* gain = C.in(7) + (size_t)l * D;
            f32x4 A4[4], S4[4];
#pragma unroll
            for (int j = 0; j < 4; ++j) { const int c = 4 * lane + 256 * j; const f32x4 gn = *(const f32x4*)(gain + c), sc = *(const f32x4*)(ada + 4 * D + c); S4[j] = *(const f32x4*)(ada + 3 * D + c); A4[j] = gn * (sc + 1.0f); }
#pragma unroll
            for (int rr = 0; rr < 4; ++rr) { const int r = w * 4 + rr, m = mb + rr; f32x4 v[4];
#pragma unroll
                for (int j = 0; j < 4; ++j) { const u32x2 t = raw[rr][j]; v[j] = (f32x4){bflo(t.x), bfhi(t.x), bflo(t.y), bfhi(t.y)}; }
                if (nb < nblk) { const bf16_t* src = C.p<bf16_t>(WS_X) + (size_t)(nb * 32 + w * 4 + rr) * D;
#pragma unroll
                    for (int j = 0; j < 4; ++j) raw[rr][j] = *(const u32x2*)(src + 4 * lane + 256 * j); }
                const float rstd = row_rstd(v, lane);
#pragma unroll
                for (int j = 0; j < 4; ++j) { v[j] = (v[j] * rstd) * A4[j] + S4[j];
                    const float sc = (float)(1 << pg8::ACT8_SHIFT); int pk = 0; f32x4 c4 = v[j] * sc;
#pragma unroll
                    for (int q = 0; q < 4; ++q) c4[q] = __builtin_amdgcn_fmed3f(c4[q], -448.0f, 448.0f);
                    pk = __builtin_amdgcn_cvt_pk_fp8_f32(c4[0], c4[1], pk, false); pk = __builtin_amdgcn_cvt_pk_fp8_f32(c4[2], c4[3], pk, true);
                    *(int*)(C.p<unsigned char>(WS_HN) + (size_t)m * D + 4 * lane + 256 * j) = pk;
                    *(LAS f32x4*)(T + r * 1028 + 4 * lane + 256 * j) = v[j]; }
                asm volatile("" ::: "memory");
            }
        }
        if (tid < 32) lcnt[tid] = 0;
        __syncthreads();
        f32x4 acc[2][2];
#pragma unroll
        for (int mt = 0; mt < 2; ++mt)
#pragma unroll
            for (int nt = 0; nt < 2; ++nt) acc[mt][nt] = (f32x4){0.f, 0.f, 0.f, 0.f};
#pragma unroll
        for (int s = 0; s < 4; ++s)
#pragma unroll
            for (int mt = 0; mt < 2; ++mt) { const LAS float* tp = T + (16 * mt + (lane & 15)) * 1028 + 128 * w + 32 * s + 8 * (lane >> 4);
                bf16x8 ahi, alo; split_bf16(*(const LAS f32x4*)tp, *(const LAS f32x4*)(tp + 4), ahi, alo);
#pragma unroll
                for (int nt = 0; nt < 2; ++nt) {
                    acc[mt][nt] = __builtin_amdgcn_mfma_f32_16x16x32_bf16(ahi, bhi[s][nt], acc[mt][nt], 0, 0, 0);
                    acc[mt][nt] = __builtin_amdgcn_mfma_f32_16x16x32_bf16(alo, bhi[s][nt], acc[mt][nt], 0, 0, 0);
                    acc[mt][nt] = __builtin_amdgcn_mfma_f32_16x16x32_bf16(ahi, blo[s][nt], acc[mt][nt], 0, 0, 0); } }
        __syncthreads();
#pragma unroll
        for (int mt = 0; mt < 2; ++mt)
#pragma unroll
            for (int nt = 0; nt < 2; ++nt)
#pragma unroll
                for (int q = 0; q < 4; ++q) T[(w * 32 + 16 * mt + 4 * (lane >> 4) + q) * 33 + 16 * nt + (lane & 15)] = acc[mt][nt][q];
        __syncthreads();
#pragma unroll
        for (int o = tid; o < 1024; o += 512) { const int row = o >> 5, col = o & 31; float sum = 0.f;
#pragma unroll
            for (int q = 0; q < 8; ++q) sum += T[(q * 32 + row) * 33 + col];
            LG[row * 33 + col] = sum + brc; }
        __syncthreads();
        int te[4]; int tp[4];
        if (tid < 32) {
            gb[tid] = gbv;
            unsigned used = 0u; float tv[4], tw[4];
#pragma unroll
            for (int k = 0; k < 4; ++k) { float best = -3.0e38f; int bi = 0;
                for (int e = 0; e < 32; ++e) { const float x = LG[tid * 33 + e]; if (!((used >> e) & 1u) && x > best) { best = x; bi = e; } }
                used |= 1u << bi; te[k] = bi; tv[k] = best; }
            float sm = 0.f;
#pragma unroll
            for (int k = 0; k < 4; ++k) { tw[k] = __expf(tv[k] - tv[0]); sm += tw[k]; }
            const int m = blk * 32 + tid;
#pragma unroll
            for (int k = 0; k < 4; ++k) { tw[k] /= sm; tp[k] = atomicAdd((int*)&lcnt[te[k]], 1); C.p<int>(WS_TOKE)[m * 4 + k] = te[k]; C.p<float>(WS_TOKW)[m * 4 + k] = tw[k]; }
        }
        __syncthreads();
        if (tid < 32) {
            if (pm >= 0) {
#pragma unroll
                for (int k = 0; k < 4; ++k) C.p<int>(WS_TOKP)[pm * 4 + k] = gb[pte[k]] + ptp[k]; }
            const int n = lcnt[tid]; gbv = n > 0 ? (int)atomicAdd(CNT + tid, (unsigned)n) : 0;
            pm = blk * 32 + tid;
#pragma unroll
            for (int k = 0; k < 4; ++k) { pte[k] = te[k]; ptp[k] = tp[k]; }
        }
    }
    if (tid < 32 && pm >= 0) {
        gb[tid] = gbv; __builtin_amdgcn_fence(__ATOMIC_RELEASE, "workgroup"); __builtin_amdgcn_wave_barrier();
#pragma unroll
        for (int k = 0; k < 4; ++k) C.p<int>(WS_TOKP)[pm * 4 + k] = gb[pte[k]] + ptp[k];
    }
}
__device__ __forceinline__ int moe_offsets(const Ctx& C, int l, bool tiles) {
    LAS int* offs = (LAS int*)(C.lds + LC_OFFS); LAS unsigned char* tile_e = (LAS unsigned char*)(C.lds + LC_TILE);
    unsigned* CNT = C.p<unsigned>(WS_CTL) + CW_CNT + l * 32;
    __syncthreads();
    if (C.tid < 64) {
        const int e = C.tid & 31; const int n = (int)__hip_atomic_load(CNT + e, __ATOMIC_RELAXED, __HIP_MEMORY_SCOPE_AGENT); const int pad = (n + 255) & ~255; int inc = pad;
#pragma unroll
        for (int d = 1; d < 32; d <<= 1) { const int t = __builtin_amdgcn_ds_bpermute(((C.tid & 63) - d) << 2, inc); if (e >= d) inc += t; }
        if (C.tid < 32) { offs[e] = inc - pad; if (e == 31) offs[32] = inc; }
    }
    __syncthreads();
    const int tt = offs[32] >> 8;
    if (tiles) { for (int t = C.tid; t < tt; t += 512) { int e = 0;
#pragma unroll 1
        while (e < 31 && offs[e + 1] <= t * 256) ++e; tile_e[t] = (unsigned char)e; } __syncthreads(); }
    return tt;
}
__device__ __forceinline__ void phase_slots(const Ctx& C, int l, int ntok) {
    moe_offsets(C, l, false);
    LAS int* offs = (LAS int*)(C.lds + LC_OFFS);
    unsigned* CNT = C.p<unsigned>(WS_CTL) + CW_CNT + l * 32;
    int* TS = C.p<int>(WS_XS);
    int* TS2 = (int*)(C.ws + WS_XS + (1u << 20));
    const int gt = blockIdx.x * 512 + C.tid, NGT = C.G * 512;
    for (int w = gt; w < ntok * 32; w += NGT) {
        const int idx = w >> 3, cc = w & 7;
        const int e = C.p<int>(WS_TOKE)[idx], slot = offs[e] + C.p<int>(WS_TOKP)[idx];
        if (cc == 0) TS[slot] = idx;
        const int tile = slot >> 8, r = slot & 255, h = r >> 7, R = r & 127, bb = pg8::lds_byte(R, 8 * cc), i = bb >> 13, t = (bb & 8191) >> 4;
        TS2[((tile * 512 + t) * 2 + h) * 2 + i] = (idx >> 2) * D + 16 * cc;
    }
#pragma unroll 1
    for (int e = 0; e < 32; ++e) { const int n = (int)__hip_atomic_load(CNT + e, __ATOMIC_RELAXED, __HIP_MEMORY_SCOPE_AGENT), p0 = offs[e] + n, p1 = offs[e + 1];
        if (gt < (p1 - p0) * 8) { const int slot = p0 + (gt >> 3), cc = gt & 7; if (cc == 0) TS[slot] = -1;
            const int tile = slot >> 8, r = slot & 255, h = r >> 7, R = r & 127, bb = pg8::lds_byte(R, 8 * cc), i = bb >> 13, t = (bb & 8191) >> 4;
            TS2[((tile * 512 + t) * 2 + h) * 2 + i] = 16 * cc; } }
}
__device__ __forceinline__ void phase_final(const Ctx& C) {
    const int gw = blockIdx.x * 8 + C.wave, NGW = C.G * 8;
    for (int m = gw; m < NLAT; m += NGW) {
        f32x4 v[4]; load_row(C, false, m, true, DEPTH - 1, v);
        const float rstd = row_rstd(v, C.lane);
#pragma unroll
        for (int j = 0; j < 4; ++j) { const int c = 4 * C.lane + 256 * j; *(f32x4*)(C.out + (size_t)m * D + c) = v[j] * rstd * *(const f32x4*)(C.in(35) + c); }
    }
}

__device__ __forceinline__ void phase_s5carry_ol(const Ctx& C, int l) {
    if (C.tid < 256) {
        for (int gid = blockIdx.x * 256 + C.tid; gid < 65536; gid += C.G * 256) {
            const int p = gid & 63, dr = (gid >> 6) & 1, g = (gid >> 7) & 31, b = gid >> 12;
            const f32x2 dec = *(const f32x2*)(C.p<float>(WS_DEC) + (((size_t)(l * 2 + dr) * 32 + g) * 64 + p) * 2);
            float hr = 0.f, hi = 0.f;
#pragma unroll 1
            for (int k0 = 0; k0 < NCH; k0 += 16) {
                float sr[16], si[16];
#pragma unroll
                for (int q = 0; q < 16; ++q) { const int k = k0 + q, cidx = dr == 0 ? k : (k < 16 ? 15 - k : 159 - k);
                    const float* sp = C.p<float>(WS_SB) + ((size_t)g * NROW3 + (b * NCH + cidx)) * 256 + dr * 128 + p; sr[q] = sp[0]; si[q] = sp[64]; }
#pragma unroll
                for (int q = 0; q < 16; ++q) { const int k = k0 + q, cidx = dr == 0 ? k : (k < 16 ? 15 - k : 159 - k);
                    bf16_t* a3 = C.p<bf16_t>(WS_A3) + ((size_t)g * NROW3 + (b * NCH + cidx)) * 512 + 256 + dr * 128 + p;
                    a3[0] = f2bf(hr); a3[64] = f2bf(hi);
                    const float nr = dec.x * hr - dec.y * hi + sr[q], ni = dec.x * hi + dec.y * hr + si[q]; hr = nr; hi = ni; }
            }
        }
    }
}

__device__ __forceinline__ int lru_row(int b, bool isctx, int p) { return isctx ? NLAT + b * 256 + p : b * 2048 + (p & 31) * 64 + (p >> 5); }
__device__ __forceinline__ void phase_lru(const Ctx& C, int l) {
    const int tid = C.tid, dir = tid >> 8, lt = tid & 255, lw = (tid >> 6) & 3, lane = tid & 63;
    const int mt = lw >> 1, ct = lw & 1, half = lane >> 5, cl = lane & 31;
    LAS unsigned char* R = C.lds + dir * 49152;
    LAS unsigned char* XT = R;
    LAS unsigned char* XC = R + 8704;
    LAS float* SEG = (LAS float*)(R + 17920);
    LAS unsigned char* OT = R + 19968;
    LAS unsigned char* G2 = R + 29184;
    LAS unsigned char* OUTT = R + 38400;
    const bf16_t* XR = C.p<bf16_t>(WS_XR); bf16_t* HOUT = C.p<bf16_t>(dir ? WS_HB : WS_HF);
    const bf16_t* HOTH = C.p<bf16_t>(dir ? WS_HF : WS_HB); const bf16_t* GGp = C.p<bf16_t>(WS_GG); bf16_t* OLp = C.p<bf16_t>(WS_OL);
    const int seg = 2 * mt + half, ch = 32 * ct + cl;
    const int srow = 16 * (2 * mt + ((cl >> 2) & 1)) + (cl & 3) + 4 * (cl >> 3);
    const int qrow = dir ? 63 - srow : srow;
    for (int task = blockIdx.x; task < 256; task += C.G) {
        const int b = task >> 4, n = task & 15;
        const float lam = C.in(21)[(size_t)(l * 2 + dir) * D + n * 64 + ch];
        const float coef2 = -8.0f * log1pf(__expf(-lam)) * 1.4426950409f;
        const int c2 = lt & 31, pg = lt >> 5;
        float cw[4][2], cb[2];
#pragma unroll
        for (int j = 0; j < 4; ++j) { cw[j][0] = C.in(19)[((size_t)l * 4 + j) * D + n * 64 + 2 * c2]; cw[j][1] = C.in(19)[((size_t)l * 4 + j) * D + n * 64 + 2 * c2 + 1]; }
        cb[0] = C.in(20)[(size_t)l * D + n * 64 + 2 * c2]; cb[1] = C.in(20)[(size_t)l * D + n * 64 + 2 * c2 + 1];
        const float* Wa = C.in(22) + ((size_t)((l * 2 + dir) * 16 + n) * 64) * 64; const float* Wx = C.in(24) + ((size_t)((l * 2 + dir) * 16 + n) * 64) * 64;
        bf16x8 bfa[4], bfx[4];
#pragma unroll
        for (int s = 0; s < 4; ++s) {
            unsigned wa[4], wx[4];
#pragma unroll
            for (int jj = 0; jj < 4; ++jj) { const int k = 16 * s + 8 * half + 2 * jj; wa[jj] = cvt_pk_bf16(Wa[(size_t)k * 64 + ch], Wa[(size_t)(k + 1) * 64 + ch]); wx[jj] = cvt_pk_bf16(Wx[(size_t)k * 64 + ch], Wx[(size_t)(k + 1) * 64 + ch]); }
            u32x4 ta = (u32x4){wa[0], wa[1], wa[2], wa[3]}, tx = (u32x4){wx[0], wx[1], wx[2], wx[3]}; bfa[s] = __builtin_bit_cast(bf16x8, ta); bfx[s] = __builtin_bit_cast(bf16x8, tx);
        }
        const float bias_a = C.in(23)[(size_t)(l * 2 + dir) * D + n * 64 + ch], bias_x = C.in(25)[(size_t)(l * 2 + dir) * D + n * 64 + ch];
        const float nba = -1.4426950409f * bias_a, nbx = -1.4426950409f * bias_x;
        float hrun = 0.f;
        u32x4 pf[3];
        auto issue_tile = [&](int it) {
            const bool isctx = it < 4; const int p0 = dir == 0 ? (isctx ? 64 * it : 64 * (it - 4)) : (isctx ? 64 * (3 - it) : 64 * (35 - it)); const int slen = isctx ? 256 : 2048;
#pragma unroll
            for (int r = 0; r < 3; ++r) { const int q = lt + 256 * r, rr = q >> 3, pc = q & 7, p = p0 - 1 + rr;
                pf[r] = (u32x4){0u, 0u, 0u, 0u};
                if (rr < 67 && p >= 0 && p < slen) pf[r] = *(const u32x4*)(XR + (size_t)lru_row(b, isctx, p) * D + n * 64 + pc * 8); }
        };
        auto lru_flush = [&](int itp) {
            const bool cx = itp < 4; const int pp = dir == 0 ? (cx ? 64 * itp : 64 * (itp - 4)) : (cx ? 64 * (3 - itp) : 64 * (35 - itp)); const bool sec = itp < 4 ? itp >= 2 : itp >= 20;
            bf16_t* dstb = sec ? OLp : HOUT;
#pragma unroll
            for (int r = 0; r < 2; ++r) { const int q = lt + 256 * r, rr = q >> 3, pc = q & 7; *(GAS u32x4*)(dstb + (size_t)lru_row(b, cx, pp + rr) * D + n * 64 + pc * 8) = *(const LAS u32x4*)(OUTT + rr * 144 + pc * 16); }
        };
        issue_tile(0);
#pragma unroll 1
        for (int it = 0; it < 36; ++it) {
            const bool isctx = it < 4; const int p0 = dir == 0 ? (isctx ? 64 * it : 64 * (it - 4)) : (isctx ? 64 * (3 - it) : 64 * (35 - it));
#pragma unroll
            for (int r = 0; r < 3; ++r) { const int q = lt + 256 * r, rr = q >> 3, pc = q & 7; if (rr < 67) *(LAS u32x4*)(XT + rr * 128 + pc * 16) = pf[r]; }
            __syncthreads();
            if (it + 1 < 36) issue_tile(it + 1);
            if (it > 0) lru_flush(it - 1);
            const bool second = it < 4 ? it >= 2 : it >= 20;
            {
                float x0[11], x1[11];
#pragma unroll
                for (int r = 0; r < 11; ++r) { const unsigned w = *(const LAS unsigned*)(XT + (8 * pg + r) * 128 + c2 * 4); x0[r] = bflo(w); x1[r] = bfhi(w); }
#pragma unroll
                for (int q = 0; q < 8; ++q) { float y0 = cb[0], y1 = cb[1];
#pragma unroll
                    for (int j = 0; j < 4; ++j) { y0 += cw[j][0] * x0[q + j]; y1 += cw[j][1] * x1[q + j]; }
                    *(LAS unsigned*)(XC + (8 * pg + q) * 144 + c2 * 4) = cvt_pk_bf16(y0, y1); }
            }
            if (it == 2 || it == 20) asm volatile("s_waitcnt vmcnt(0)" ::: "memory");
            __syncthreads();
            u32x4 po[2], pg2[2];
            if (second) {
#pragma unroll
                for (int r = 0; r < 2; ++r) { const int q = lt + 256 * r, rr = q >> 3, pc = q & 7; const size_t off = (size_t)lru_row(b, isctx, p0 + rr) * D + n * 64 + pc * 8;
                    po[r] = *(const GAS u32x4*)(HOTH + off); pg2[r] = *(const GAS u32x4*)(GGp + off); }
            }
            f32x16 accr, acci;
#pragma unroll
            for (int q = 0; q < 16; ++q) { accr[q] = 0.f; acci[q] = 0.f; }
#pragma unroll
            for (int s = 0; s < 4; ++s) {
                const bf16x8 a = *(const LAS bf16x8*)(XC + qrow * 144 + (16 * s + 8 * half) * 2);
                accr = __builtin_amdgcn_mfma_f32_32x32x16_bf16(a, bfa[s], accr, 0, 0, 0);
                acci = __builtin_amdgcn_mfma_f32_32x32x16_bf16(a, bfx[s], acci, 0, 0, 0);
            }
            float av[16], bv[16]; float P = 1.f, H = 0.f;
#pragma unroll
            for (int i = 0; i < 16; ++i) { const int s = 16 * seg + i, q = dir ? 63 - s : s;
                const float r = __builtin_amdgcn_rcpf(1.0f + __builtin_amdgcn_exp2f(fmaf(accr[i], -1.4426950409f, nba))), ig = __builtin_amdgcn_rcpf(1.0f + __builtin_amdgcn_exp2f(fmaf(acci[i], -1.4426950409f, nbx)));
                const float xc = bf2f(*(const LAS unsigned short*)(XC + q * 144 + ch * 2));
                const float a = __builtin_amdgcn_exp2f(coef2 * r);
                const float em = fmaxf(fmaf(-a, a, 1.0f), 0.0f);
                const float bb = __builtin_amdgcn_sqrtf(em) * (ig * xc);
                av[i] = a; bv[i] = bb; P *= a; H = a * H + bb; }
            SEG[(seg * 64 + ch) * 2] = P; SEG[(seg * 64 + ch) * 2 + 1] = H;
            if (second) {
#pragma unroll
                for (int r = 0; r < 2; ++r) { const int q = lt + 256 * r, rr = q >> 3, pc = q & 7; *(LAS u32x4*)(OT + rr * 144 + pc * 16) = po[r]; *(LAS u32x4*)(G2 + rr * 144 + pc * 16) = pg2[r]; }
            }
            __syncthreads();
            float carry = hrun, mine = 0.f;
#pragma unroll
            for (int s2 = 0; s2 < 4; ++s2) { if (s2 == seg) mine = carry; carry = SEG[(s2 * 64 + ch) * 2] * carry + SEG[(s2 * 64 + ch) * 2 + 1]; }
            hrun = carry;
            float h = mine;
#pragma unroll
            for (int i = 0; i < 16; ++i) { const int s = 16 * seg + i, q = dir ? 63 - s : s; h = av[i] * h + bv[i];
                const float val = second ? bf2f(*(const LAS unsigned short*)(G2 + q * 144 + ch * 2)) * (h + bf2f(*(const LAS unsigned short*)(OT + q * 144 + ch * 2))) : h;
                *(LAS unsigned short*)(OUTT + q * 144 + ch * 2) = f2bf(val); }
        }
        __syncthreads();
        lru_flush(35);
        __syncthreads();
    }
}

__global__ void __launch_bounds__(512, 2) fwd_kernel(Args args) {
    extern __shared__ __attribute__((aligned(16))) unsigned char lds_raw[];
    Ctx C0; C0.out = args.out; C0.ws = args.ws; C0.lds = (LAS unsigned char*)lds_raw;
    C0.tid = threadIdx.x; C0.lane = C0.tid & 63; C0.wave = __builtin_amdgcn_readfirstlane(C0.tid >> 6); C0.G = gridDim.x;
    for (int u = C0.tid; u < (LDS_BYTES - LDS_CTL) / 4; u += 512) ((LAS unsigned*)(C0.lds + LDS_CTL))[u] = 0u;
    __syncthreads();
    if (C0.tid < 36) { const unsigned long long pv = (unsigned long long)args.in[C0.tid]; LAS unsigned* t = (LAS unsigned*)(C0.lds + LC_PTRS) + 2 * C0.tid; t[0] = (unsigned)pv; t[1] = (unsigned)(pv >> 32); }
    __syncthreads();
    const Ctx& C = C0;
    XcdBarrier bar = xcd_barrier_post(C.p<unsigned>(WS_CTL) + CW_BAR, (volatile LAS unsigned*)(C.lds + LC_MISC) + 8);
    const int lo = args.ph_lo, hi = args.ph_hi;
    int ph = 0;
#ifndef PHMASK
#define PHMASK 0xffffffffu
#endif
#define PH_ON(id) (((PHMASK) >> (id)) & 1u)
#define PHASE_BEGIN(id) if (PH_ON(id) && lo <= ph && ph < hi) { Ctx C = C0; const int _pid = id; (void)_pid; unsigned _z = 0u; asm volatile("" : "+s"(C.ws), "+s"(C.out), "+s"(C.lds), "+v"(_z)); C.lane = (int)__builtin_amdgcn_mbcnt_hi(~0u, __builtin_amdgcn_mbcnt_lo(~0u, _z)); C.tid = C.wave * 64 + C.lane;
#ifdef PROBE_MASK
#define PROBE_TICK() do { const unsigned long long _t = __builtin_amdgcn_s_memrealtime(); if (((PROBE_MASK) >> _pid) & 1u) pr_acc += _t - pr_prev; pr_prev = _t; } while (0)
#else
#define PROBE_TICK() do { } while (0)
#endif
#define PHASE_END(last) if (ph + 1 < hi && !(last)) xcd_barrier(bar); PROBE_TICK(); } ++ph;
#define PHASE_JOIN __syncthreads(); }
    const int cid = (int)blockIdx.x;
#ifdef PROBE_MASK
    unsigned long long pr_acc = 0ull, pr_prev = __builtin_amdgcn_s_memrealtime();
#endif

    PHASE_BEGIN(0)
        phase_s5prep(C);
        phase_ada(C);
        __syncthreads();
        phase_transposes(C);
    PHASE_END(false)

#pragma unroll 1
    for (int l = 0; l < DEPTH; ++l) {
        const int nMtok = (l == DEPTH - 1) ? 128 : 144;
        const int ntok = nMtok * 256;
        PHASE_BEGIN(1) phase_norm1(C, l); PHASE_END(false)
        PHASE_BEGIN(2)
            pg8::Gemm g{D, D, D, C.p<bf16_t>(WS_HN), (C.p<bf16_t>(WS_WINT) + (size_t)l * INW * D)}; SchedGrid S; S.rowtab4 = nullptr; S.so.init(144, 18, C.G, cid);  S.atile = (unsigned)256 * D * 2; S.btile = (unsigned)256 * D * 2;
            EpiInProj E{C.p<bf16_t>(WS_A3), C.p<bf16_t>(WS_XR), C.p<bf16_t>(WS_GG), C.p<bf16_t>(WS_M5), C.p<bf16_t>(WS_ML)};
            pg8::gemm_phase(C.lds, C.tid, g, S, E);
        PHASE_END(false)
        PHASE_BEGIN(3)
            pg8::Gemm g{512, 256, 256, C.p<bf16_t>(WS_A3), (C.p<bf16_t>(WS_FT) + (size_t)l * 32 * 256 * 256)}; SchedS5 S{nullptr, C.G, cid, (unsigned)(256 * 256 * 2)};
            EpiS5L1 E{C.p<float>(WS_SB)};
            pg8::gemm_phase(C.lds, C.tid, g, S, E);
        PHASE_JOIN
        PHASE_BEGIN(15) phase_lru(C, l); PHASE_END(false)
        PHASE_BEGIN(4) phase_s5carry_ol(C, l); PHASE_END(false)
        PHASE_BEGIN(5)
            { pg8::Gemm g{512, 512, 512, C.p<bf16_t>(WS_A3), (C.p<bf16_t>(WS_W3T) + (size_t)l * 32 * 256 * 512)}; SchedS5 S{nullptr, C.G, cid, (unsigned)(256 * 512 * 2)};
              EpiS5Y E{C.p<bf16_t>(WS_GY)};
              pg8::gemm_phase(C.lds, C.tid, g, S, E); }
            __syncthreads();
            { pg8::Gemm g{D, D, D, C.p<bf16_t>(WS_OL), (C.p<bf16_t>(WS_WPLT) + (size_t)l * D * D)}; SchedGrid S; S.rowtab4 = nullptr; S.so.init(nMtok, 4, C.G, C.G - 1 - cid);  S.atile = (unsigned)256 * D * 2; S.btile = (unsigned)256 * D * 2;
              EpiMulGate E{C.p<bf16_t>(WS_ML), nullptr, C.p<bf16_t>(WS_T1)};
              pg8::gemm_phase(C.lds, C.tid, g, S, E); }
        PHASE_END(false)
        PHASE_BEGIN(6)
            pg8::Gemm g{512, 512, 512, C.p<bf16_t>(WS_GY), (C.p<bf16_t>(WS_WGLUT) + (size_t)l * 512 * 512)}; SchedGrid S; S.rowtab4 = nullptr; S.so.init(nMtok, 2, C.G, cid);  S.atile = (unsigned)256 * 512 * 2; S.btile = (unsigned)256 * 512 * 2;
            EpiGlu E{C.p<bf16_t>(WS_GY), C.p<bf16_t>(WS_O5), C.in(18) + (size_t)l * 512};
            pg8::gemm_phase(C.lds, C.tid, g, S, E);
        PHASE_END(false)
        PHASE_BEGIN(7)
            pg8::Gemm g{512, 512, 512, C.p<bf16_t>(WS_O5), (C.p<bf16_t>(WS_WP5T) + (size_t)l * D * 512)}; SchedGrid S; S.rowtab4 = nullptr; S.so.init(nMtok, 4, C.G, cid);  S.atile = (unsigned)256 * 512 * 2; S.btile = (unsigned)256 * 512 * 2;
            EpiMulGate E{C.p<bf16_t>(WS_M5), C.p<bf16_t>(WS_T1), C.p<bf16_t>(WS_MG)};
            pg8::gemm_phase(C.lds, C.tid, g, S, E);
        PHASE_END(false)
        PHASE_BEGIN(9)
            pg8::Gemm g{D, D, D, C.p<bf16_t>(WS_MG), (C.p<bf16_t>(WS_WOUTT) + (size_t)l * D * D)}; SchedGrid S; S.rowtab4 = nullptr; S.so.init(nMtok, 4, C.G, cid);  S.atile = (unsigned)256 * D * 2; S.btile = (unsigned)256 * D * 2;
            EpiOut E{C.in(0), C.in(2), C.p<bf16_t>(WS_X), C.p<float>(WS_ADA), l};
            pg8::gemm_phase(C.lds, C.tid, g, S, E);
        PHASE_END(false)
        PHASE_BEGIN(10) phase_norm2(C, l, ntok); PHASE_END(false)
        PHASE_BEGIN(11) phase_slots(C, l, ntok); PHASE_END(false)
        PHASE_BEGIN(12)
            const int tt = moe_offsets(C, l, true);
            pg8::Gemm g{D / 2, D / 2, D / 2, C.p<unsigned char>(WS_HN), (C.p<unsigned char>(WS_WUPT) + (size_t)l * NEXP * 2048 * D)}; SchedMoe<true, true> S; S.rowtab4 = (const __attribute__((address_space(1))) i32x4*)(C.ws + WS_XS + (1u << 20)); S.rowmax = 0; S.so.init(tt, 8, C.G, cid);
            S.atile = (unsigned)256 * D; S.btile = (unsigned)256 * D; S.bexp = (unsigned)2048 * D;   S.tile_e = (const LAS unsigned char*)(C.lds + LC_TILE);
            EpiUp E{C.p<bf16_t>(WS_ACT), C.in(32) + (size_t)l * NEXP * 2048};
            pg8::gemm_phase(C.lds, C.tid, g, S, E);
        PHASE_END(false)
        PHASE_BEGIN(13)
            const int tt = moe_offsets(C, l, true);
            pg8::Gemm g{D / 2, D / 2, D / 2, C.p<unsigned char>(WS_ACT), (C.p<unsigned char>(WS_WDNT) + (size_t)l * NEXP * D * D)}; SchedMoe<false, true> S; S.rowtab4 = nullptr; S.rowmax = 0; S.so.init(tt, 4, C.G, cid);
            S.atile = (unsigned)256 * D; S.btile = (unsigned)256 * D; S.bexp = (unsigned)D * D; S.tile_e = (const LAS unsigned char*)(C.lds + LC_TILE);
            EpiDown E{C.p<bf16_t>(WS_Y), C.in(34) + (size_t)l * NEXP * D, C.p<int>(WS_XS)};
            pg8::gemm_phase(C.lds, C.tid, g, S, E);
        PHASE_END(false)
    }
    PHASE_BEGIN(14) phase_final(C); PHASE_END(true)
#ifdef PROBE_MASK
    if (blockIdx.x == 0) { const unsigned long long t0 = __builtin_amdgcn_s_memrealtime(); while (__builtin_amdgcn_s_memrealtime() - t0 < pr_acc * (PROBE_AMP)) __builtin_amdgcn_s_sleep(8); }
#endif
}

constexpr int N_PHASES = 1 + DEPTH * 12 + 1;
extern "C" void kernel_launch(void* const* d_in, const int* in_sizes, int n_in, void* d_out, int out_size, void* d_ws, size_t ws_size, hipStream_t stream) {
    static int grid = 0;
    if (grid == 0) {
        if (n_in != 36 || ws_size < WS_END) { fprintf(stderr, "kernel_launch: need 36 inputs and >= %zu bytes of workspace; got %d, %zu\n", (size_t)WS_END, n_in, ws_size); grid = -1; return; }
        int dev = 0, cus = 0, per_cu = 0;
        if (hipGetDevice(&dev) != hipSuccess || hipDeviceGetAttribute(&cus, hipDeviceAttributeMultiprocessorCount, dev) != hipSuccess) { grid = -1; return; }
        if (hipFuncSetAttribute((const void*)fwd_kernel, hipFuncAttributeMaxDynamicSharedMemorySize, LDS_BYTES) != hipSuccess) { fprintf(stderr, "kernel_launch: hipFuncSetAttribute failed\n"); grid = -1; return; }
        if (hipOccupancyMaxActiveBlocksPerMultiprocessor(&per_cu, (const void*)fwd_kernel, 512, LDS_BYTES) != hipSuccess || per_cu < 1) fprintf(stderr, "kernel_launch: occupancy query says %d\n", per_cu);
        (void)hipGetLastError();
        grid = cus;
    }
    if (grid < 0) return;
    (void)hipMemsetAsync((char*)d_ws + WS_CTL, 0, CTL_ZERO_BYTES, stream);
    Args a{};
    for (int i = 0; i < 36; ++i) a.in[i] = (const float*)d_in[i];
    a.out = (float*)d_out; a.ws = (unsigned char*)d_ws;
#ifndef MK_SPLIT
    a.ph_lo = 0; a.ph_hi = N_PHASES;
    hipLaunchKernelGGL(fwd_kernel, dim3(grid), dim3(512), LDS_BYTES, stream, a);
#else
    for (int p = 0; p < N_PHASES; ++p) { a.ph_lo = p; a.ph_hi = p + 1; hipLaunchKernelGGL(fwd_kernel, dim3(grid), dim3(512), LDS_BYTES, stream, a); }
#endif
}
```
